# Optimizing an MI355X kernel written in HIP

```python
import math
import jax, jax.numpy as jnp
from jax import lax
import numpy as np

D_MODEL = 2048
BATCH = 2
SEQ = 16384
DEPTH = 2

RET_HEADS = 6
RET_QK_DIM = 64
RET_V_DIM = 128
RET_CHUNK = 128
ATT_HEADS = 6
ATT_HEAD_DIM = 128
IDX_HEADS = 4
IDX_DIM = 64
TOPK_MAX = 256
Q_BLOCK = 128
SG_GROUPS = 4
SG_GROUP_DIM = 128
SG_CHUNK = 128
REL_BUCKETS = 32
REL_MAX_DIST = 128
D_FF = 5632
ROPE_BASE = 10000.0
EPS = 1e-6

RET_QK_W = RET_HEADS * RET_QK_DIM
RET_V_W = RET_HEADS * RET_V_DIM
ATT_W = ATT_HEADS * ATT_HEAD_DIM
IDX_Q_W = IDX_HEADS * IDX_DIM
SG_W = SG_GROUPS * SG_GROUP_DIM
SPLIT_SIZES = (RET_QK_W, RET_QK_W, RET_V_W, RET_V_W, ATT_W, ATT_W, ATT_W,
               IDX_Q_W, IDX_DIM, IDX_HEADS, SG_W, SG_W, D_MODEL, D_MODEL, D_MODEL)
D_IN = sum(SPLIT_SIZES)
SPLIT_POINTS = tuple(int(p) for p in np.cumsum(SPLIT_SIZES)[:-1])

kernel_name = 'hybrid_retention_dsa_sgmlp_block'


def rmsnorm(x, g):
    xf = x.astype(jnp.float32)
    y = xf * lax.rsqrt(jnp.mean(xf * xf, axis=-1, keepdims=True) + EPS)
    return (y * g.astype(jnp.float32)).astype(x.dtype)


def head_groupnorm(o, g):
    B, S, H, dv = o.shape
    of = o.astype(jnp.float32)
    mu = jnp.mean(of, axis=-1, keepdims=True)
    var = jnp.mean(jnp.square(of - mu), axis=-1, keepdims=True)
    y = ((of - mu) * lax.rsqrt(var + EPS)).reshape(B, S, H * dv)
    return (y * g.astype(jnp.float32)).astype(o.dtype)


def swiglu(x, w_gate, w_up, w_down):
    return (jax.nn.silu(x @ w_gate) * (x @ w_up)) @ w_down


def rope(x, positions):
    d = x.shape[-1]
    inv_freq = ROPE_BASE ** (-jnp.arange(0, d, 2, dtype=jnp.float32) / d)
    ang = positions.astype(jnp.float32)[..., None] * inv_freq
    cos = jnp.cos(ang)[:, :, None, :]
    sin = jnp.sin(ang)[:, :, None, :]
    xf = x.astype(jnp.float32)
    x1, x2 = xf[..., : d // 2], xf[..., d // 2:]
    return jnp.concatenate([x1 * cos - x2 * sin, x1 * sin + x2 * cos], axis=-1).astype(x.dtype)


def retention(q, k, v):
    B, S, H, dk = q.shape
    dv = v.shape[-1]
    C = RET_CHUNK
    n = S // C
    dt = q.dtype
    log_g = jnp.log(1.0 - 2.0 ** (-5.0 - jnp.arange(H, dtype=jnp.float32)))
    idx = jnp.arange(C, dtype=jnp.float32)
    rel = idx[:, None] - idx[None, :]
    decay_intra = jnp.where(rel >= 0, jnp.exp(jnp.maximum(rel, 0.0) * log_g[:, None, None]), 0.0).astype(dt)
    k_decay = jnp.exp((C - 1 - idx)[None, :] * log_g[:, None]).astype(dt)
    q_decay = jnp.exp((idx + 1)[None, :] * log_g[:, None]).astype(dt)
    chunk_decay = jnp.exp(C * log_g).astype(dt)

    qc = q.reshape(B, n, C, H, dk) * (dk ** -0.5)
    kc = k.reshape(B, n, C, H, dk)
    vc = v.reshape(B, n, C, H, dv)
    scores = jnp.einsum('bnthd,bnshd->bnhts', qc, kc) * decay_intra
    o_intra = jnp.einsum('bnhts,bnshv->bnthv', scores, vc)
    chunk_kv = jnp.einsum('bnshd,hs,bnshv->bnhdv', kc, k_decay, vc)

    def step(state, kv):
        return state * chunk_decay[None, :, None, None] + kv, state

    init = jnp.zeros((B, H, dk, dv), chunk_kv.dtype)
    _, prev = lax.scan(step, init, jnp.moveaxis(chunk_kv, 1, 0))
    prev = jnp.moveaxis(prev, 0, 1)
    o_cross = jnp.einsum('bnthd,bnhdv,ht->bnthv', qc, prev, q_decay)
    return (o_intra + o_cross).reshape(B, S, H, dv)


def t5_bucket(dist):
    max_exact = REL_BUCKETS // 2
    dist = jnp.maximum(dist, 0)
    df = jnp.maximum(dist, 1).astype(jnp.float32)
    large = max_exact + (jnp.log(df / max_exact) / math.log(REL_MAX_DIST / max_exact)
                         * (REL_BUCKETS - max_exact)).astype(jnp.int32)
    large = jnp.minimum(large, REL_BUCKETS - 1)
    return jnp.where(dist < max_exact, dist, large)


def sparse_attention(q, k, v, q_idx, k_idx, w_idx, positions, rel_table):
    B, S, H, dh = q.shape
    n_keep = min(TOPK_MAX, S // 4)
    nb = S // Q_BLOCK
    key_pos = jnp.arange(S)
    w_scaled = w_idx * (IDX_HEADS ** -0.5)

    def block(bi):
        t0 = bi * Q_BLOCK
        qb = lax.dynamic_slice_in_dim(q, t0, Q_BLOCK, axis=1)
        qib = lax.dynamic_slice_in_dim(q_idx, t0, Q_BLOCK, axis=1)
        wib = lax.dynamic_slice_in_dim(w_scaled, t0, Q_BLOCK, axis=1)
        posb = lax.dynamic_slice_in_dim(positions, t0, Q_BLOCK, axis=1)
        tq = t0 + jnp.arange(Q_BLOCK)
        s_h = jax.nn.relu(jnp.einsum('bthd,bsd->bths', qib, k_idx).astype(jnp.float32) * (IDX_DIM ** -0.5))
        score = jnp.einsum('bths,bth->bts', s_h, wib.astype(jnp.float32))
        causal = key_pos[None, :] <= tq[:, None]
        score = jnp.where(causal[None], score, -jnp.inf)
        _, sel = lax.top_k(score, n_keep)
        k_sel = jax.vmap(lambda kb, ib: kb[ib])(k, sel)
        v_sel = jax.vmap(lambda vb, ib: vb[ib])(v, sel)
        pos_sel = jax.vmap(lambda pb, ib: pb[ib])(positions, sel)
        logits = jnp.einsum('bthd,btkhd->bthk', qb, k_sel).astype(jnp.float32) * (dh ** -0.5)
        bias = rel_table[t5_bucket(posb[:, :, None] - pos_sel)].astype(jnp.float32)
        logits = logits + jnp.transpose(bias, (0, 1, 3, 2))
        valid = sel <= tq[None, :, None]
        logits = jnp.where(valid[:, :, None, :], logits, -jnp.inf)
        p = jax.nn.softmax(logits, axis=-1).astype(v.dtype)
        return jnp.einsum('bthk,btkhd->bthd', p, v_sel)

    out = lax.map(block, jnp.arange(nb))
    return jnp.moveaxis(out, 0, 1).reshape(B, S, H * dh)


def spatial_gating(u, v, w_s, b_s):
    B, S, _ = u.shape
    n = S // SG_CHUNK
    vr = v.reshape(B, n, SG_CHUNK, SG_GROUPS, SG_GROUP_DIM)
    mask = jnp.tril(jnp.ones((SG_CHUNK, SG_CHUNK), w_s.dtype))
    mixed = jnp.einsum('gts,bnsgd->bntgd', w_s * mask, vr) + b_s.T[None, None, :, :, None]
    return u * mixed.reshape(B, S, SG_W)


def setup_inputs(seed: int = 0) -> dict:
    key = jax.random.key(seed)
    ks = jax.random.split(key, 24)
    f32 = jnp.float32

    def nrm(k, shape, fan_in, scale=1.0):
        return jax.random.normal(k, shape, f32) * (scale * fan_in ** -0.5)

    def gain(k, shape):
        return 1.0 + 0.02 * jax.random.normal(k, shape, f32)

    res_scale = (2.0 * DEPTH) ** -0.5
    return {
        'x': jax.random.normal(ks[0], (BATCH, SEQ, D_MODEL), f32),
        'positions': jnp.tile(jnp.arange(SEQ, dtype=jnp.int32)[None, :], (BATCH, 1)),
        'rel_table': 0.5 * jax.random.normal(ks[1], (REL_BUCKETS, ATT_HEADS), f32),
        'ffn1_norm': gain(ks[2], (DEPTH, D_MODEL)),
        'ffn1_w_gate': nrm(ks[3], (DEPTH, D_MODEL, D_FF), D_MODEL),
        'ffn1_w_up': nrm(ks[4], (DEPTH, D_MODEL, D_FF), D_MODEL),
        'ffn1_w_down': nrm(ks[5], (DEPTH, D_FF, D_MODEL), D_FF, res_scale),
        'mix_norm': gain(ks[6], (DEPTH, D_MODEL)),
        'w_in': nrm(ks[7], (DEPTH, D_MODEL, D_IN), D_MODEL),
        'ret_norm': gain(ks[8], (DEPTH, RET_V_W)),
        'sg_norm': gain(ks[9], (DEPTH, SG_W)),
        'sg_w': nrm(ks[10], (DEPTH, SG_GROUPS, SG_CHUNK, SG_CHUNK), SG_CHUNK, 0.5),
        'sg_b': 1.0 + 0.01 * jax.random.normal(ks[11], (DEPTH, SG_GROUPS, SG_CHUNK), f32),
        'w_br_ret': nrm(ks[12], (DEPTH, RET_V_W, D_MODEL), RET_V_W),
        'w_br_att': nrm(ks[13], (DEPTH, ATT_W, D_MODEL), ATT_W),
        'w_br_sg': nrm(ks[14], (DEPTH, SG_W, D_MODEL), SG_W),
        'w_out': nrm(ks[15], (DEPTH, D_MODEL, D_MODEL), D_MODEL, res_scale),
        'ffn2_norm': gain(ks[16], (DEPTH, D_MODEL)),
        'ffn2_w_gate': nrm(ks[17], (DEPTH, D_MODEL, D_FF), D_MODEL),
        'ffn2_w_up': nrm(ks[18], (DEPTH, D_MODEL, D_FF), D_MODEL),
        'ffn2_w_down': nrm(ks[19], (DEPTH, D_FF, D_MODEL), D_FF, res_scale),
        'final_norm': gain(ks[20], (D_MODEL,)),
    }


def reference(x, positions, rel_table, ffn1_norm, ffn1_w_gate, ffn1_w_up, ffn1_w_down,
              mix_norm, w_in, ret_norm, sg_norm, sg_w, sg_b, w_br_ret, w_br_att, w_br_sg,
              w_out, ffn2_norm, ffn2_w_gate, ffn2_w_up, ffn2_w_down, final_norm):
    B, S, _ = x.shape
    for l in range(DEPTH):
        x = x + 0.5 * swiglu(rmsnorm(x, ffn1_norm[l]), ffn1_w_gate[l], ffn1_w_up[l], ffn1_w_down[l])

        h = rmsnorm(x, mix_norm[l])
        proj = h @ w_in[l]
        (q_r, k_r, v_r, g_r, q_a, k_a, v_a, q_i, k_i, w_i,
         u_s, v_s, gate_r, gate_a, gate_s) = jnp.split(proj, SPLIT_POINTS, axis=-1)

        q_r = rope(q_r.reshape(B, S, RET_HEADS, RET_QK_DIM), positions)
        k_r = rope(k_r.reshape(B, S, RET_HEADS, RET_QK_DIM), positions)
        o_r = retention(q_r, k_r, v_r.reshape(B, S, RET_HEADS, RET_V_DIM))
        o_r = head_groupnorm(o_r, ret_norm[l]) * jax.nn.silu(g_r)

        o_a = sparse_attention(q_a.reshape(B, S, ATT_HEADS, ATT_HEAD_DIM),
                               k_a.reshape(B, S, ATT_HEADS, ATT_HEAD_DIM),
                               v_a.reshape(B, S, ATT_HEADS, ATT_HEAD_DIM),
                               q_i.reshape(B, S, IDX_HEADS, IDX_DIM), k_i, w_i,
                               positions, rel_table)

        u_s = jax.nn.gelu(u_s)
        v_s = rmsnorm(jax.nn.gelu(v_s), sg_norm[l])
        o_s = spatial_gating(u_s, v_s, sg_w[l], sg_b[l])

        merged = (jax.nn.sigmoid(gate_r) * (o_r @ w_br_ret[l])
                  + jax.nn.sigmoid(gate_a) * (o_a @ w_br_att[l])
                  + jax.nn.sigmoid(gate_s) * (o_s @ w_br_sg[l]))
        x = x + merged @ w_out[l]

        x = x + 0.5 * swiglu(rmsnorm(x, ffn2_norm[l]), ffn2_w_gate[l], ffn2_w_up[l], ffn2_w_down[l])
    return rmsnorm(x, final_norm)
```

```cpp
#include <hip/hip_runtime.h>
#include <cstdio>
#include <cstdint>

#ifndef PG8_WGM
#define PG8_WGM 8
#endif
#ifndef MK_PER_PHASE
#define MK_PER_PHASE 0
#endif

namespace pg8 {
#define PG8_LAS __attribute__((address_space(3)))
typedef unsigned short bf16_t;
typedef short bf16x8 __attribute__((ext_vector_type(8)));
typedef float f32x4 __attribute__((ext_vector_type(4)));
typedef unsigned u32x4 __attribute__((ext_vector_type(4)));
constexpr int BM = 256, BK = 64, HALF = 128, HTB = HALF * BK * 2  , STAGE_BYTES = 8 * HTB, NXCD = 8, WGM = PG8_WGM;

__host__ __device__ __forceinline__ int lds_byte(int r, int c) { const int st = (r >> 4) * 2 + (c >> 5), rr = r & 15, cc = c & 31, ob = rr * 64 + cc * 2; return st * 1024 + (ob ^ (((ob >> 9) & 1) << 5)); }
__host__ __device__ __forceinline__ void stage_rc(int b, int& R, int& C) { const int st = b / 1024, sb = b % 1024, swz = sb ^ (((sb >> 9) & 1) << 5); R = (st >> 1) * 16 + swz / 64; C = (st & 1) * 32 + (swz % 64) / 2; }
__host__ __device__ __forceinline__ int perm32(int rho) { const int n = rho >> 4, i = rho & 15; return 8 * (i >> 2) + 4 * n + (i & 3); }

struct Unit { int pm, pn; };
struct Gemm { const bf16_t* A; const bf16_t* Bt; int M, N, K; int kmul = 1; };

struct StaticOrder {
    int nM, nN, nwg, G, c, wgm;
    __host__ __device__ void init(int M, int N, int G_, int c_, int wgm_ = WGM) { nM = M / BM; nN = N / BM; nwg = nM * nN; G = G_; c = c_; wgm = wgm_; }
    __host__ __device__ bool next(int i, Unit& u) const {
        const long L = (long)i * G + c; if (L >= nwg) return false;
        int wgid = (int)L; { const int q = nwg / NXCD, r = nwg % NXCD, xcd = wgid % NXCD, off = wgid / NXCD; wgid = (xcd < r ? xcd * (q + 1) : r * (q + 1) + (xcd - r) * q) + off; }
        const int nig = wgm * nN, gid = wgid / nig, fm = gid * wgm, gsz = (nM - fm) < wgm ? (nM - fm) : wgm;
        u.pm = fm + ((wgid % nig) % gsz); u.pn = (wgid % nig) / gsz; return true;
    }
    __device__ __forceinline__ void a_ready(const Unit&) const {}
    __device__ __forceinline__ void done(const Unit&) const {}
    __device__ __forceinline__ int ktiles(const Unit&, int full) const { return full; }
};

template <class Epi, class Sched, bool ALIGN_EPI = false, bool SP2 = false, bool BLK = false>
__device__ __forceinline__ void gemm_phase(PG8_LAS unsigned char* lds, const Gemm g, const Sched& S, const Epi& E, const int wave_sgpr) {
    unsigned m_ = ~0u; asm volatile("" : "+s"(m_)); int tid_ = wave_sgpr * 64 + (int)__builtin_amdgcn_mbcnt_hi(m_, __builtin_amdgcn_mbcnt_lo(m_, 0u)); asm volatile("" : "+v"(tid_));
    const int tid = tid_, wid = __builtin_amdgcn_readfirstlane(tid >> 6), lane = tid & 63, wr = wid >> 2, wc = wid & 3, fr = lane & 15, fq = lane >> 4;
    const int K = g.K; int nt = K / BK;
    unsigned voffA[2], voffB[2];
#pragma unroll
    for (int i = 0; i < 2; ++i) { int R, C; stage_rc(tid * 16 + i * 8192, R, C); const int Rb = Epi::PERM ? ((R & ~31) + perm32(R & 31)) : R;
        voffA[i] = (unsigned)(R * (BLK ? BK : K) + C) * 2u; voffB[i] = (unsigned)(Rb * (BLK ? BK : K) + C) * 2u; }
    const size_t kstep = (BLK ? (size_t)(BM * BK * 2) : (size_t)(BK * 2)) * (size_t)g.kmul;
    const size_t hstep = BLK ? (size_t)(HALF * BK * 2) : (size_t)HALF * K * 2;
    const size_t tstep = (size_t)BM * K * 2;
    const unsigned ldsw = (unsigned)wid * 1024u;
    const int aoff = lds_byte(wr * 64 + fr, fq * 8), boff = lds_byte(wc * 32 + fr, fq * 8);
#define PG8_SA(b, h) (((b) * 2 + (h)) * HTB)
#define PG8_SB(b, h) ((4 + (b) * 2 + (h)) * HTB)
#define PG8_STAGE(bufoff, gbase, voff) do { _Pragma("unroll") for (int _i = 0; _i < 2; ++_i) \
        __builtin_amdgcn_global_load_lds((const unsigned*)((const char*)(gbase) + (voff)[_i]), (PG8_LAS unsigned*)(lds + (bufoff) + ldsw + _i * 8192), 16, 0, 0); } while (0)
#define PG8_LDA(dst, b, h) do { _Pragma("unroll") for (int m = 0; m < 4; ++m) _Pragma("unroll") for (int k = 0; k < 2; ++k) dst[m][k] = *(const PG8_LAS bf16x8*)(lds + PG8_SA(b, h) + aoff + m * 2048 + k * 1024); } while (0)
#define PG8_LDB(dst, b, h) do { _Pragma("unroll") for (int n = 0; n < 2; ++n) _Pragma("unroll") for (int k = 0; k < 2; ++k) dst[n][k] = *(const PG8_LAS bf16x8*)(lds + PG8_SB(b, h) + boff + n * 2048 + k * 1024); } while (0)
#define PG8_MMA(ai, bj, At, Bt) do { __builtin_amdgcn_s_setprio(1); _Pragma("unroll") for (int m = 0; m < 4; ++m) _Pragma("unroll") for (int n = 0; n < 2; ++n) _Pragma("unroll") for (int k = 0; k < 2; ++k) \
        acc[ai][bj][m][n] = __builtin_amdgcn_mfma_f32_16x16x32_bf16(Bt[n][k], At[m][k], acc[ai][bj][m][n], 0, 0, 0); __builtin_amdgcn_s_setprio(0); } while (0)
#define PG8_WAIT_V(n) asm volatile("s_waitcnt vmcnt(" #n ")" ::: "memory")
#define PG8_WAIT_L(n) asm volatile("s_waitcnt lgkmcnt(" #n ")" ::: "memory")
#define PG8_BAR __builtin_amdgcn_s_barrier()
#define PG8_SCHED __builtin_amdgcn_sched_barrier(0)
    Unit cur, nxt; int ui = 0;
    if (!S.next(0, cur)) return;
    nt = S.ktiles(cur, K / BK);
    f32x4 acc[2][2][4][2];
#pragma unroll
    for (int a = 0; a < 2; ++a)
#pragma unroll
        for (int b = 0; b < 2; ++b)
#pragma unroll
            for (int m = 0; m < 4; ++m)
#pragma unroll
                for (int n = 0; n < 2; ++n) { float zf_ = 0.f; asm volatile("" : "+v"(zf_)); acc[a][b][m][n] = (f32x4){zf_, zf_, zf_, zf_}; }
    bf16x8 At[4][2], B0[2][2], B1[2][2];
    const char* cA = (const char*)g.A + (size_t)cur.pm * tstep; const char* cB = (const char*)g.Bt + (size_t)cur.pn * tstep;
    S.a_ready(cur);
    if constexpr (SP2) {
        PG8_STAGE(PG8_SB(0, 0), cB, voffB); PG8_STAGE(PG8_SB(0, 1), cB + hstep, voffB); PG8_STAGE(PG8_SA(0, 0), cA, voffA); PG8_STAGE(PG8_SA(0, 1), cA + hstep, voffA);
        if (wr == 1) PG8_BAR;
        PG8_WAIT_V(2); PG8_BAR;
        PG8_STAGE(PG8_SB(1, 0), cB + kstep, voffB); PG8_STAGE(PG8_SA(1, 0), cA + kstep, voffA); PG8_STAGE(PG8_SB(1, 1), cB + hstep + kstep, voffB);
        PG8_WAIT_V(6); PG8_BAR;
    } else {
        PG8_STAGE(PG8_SB(0, 0), cB, voffB); PG8_STAGE(PG8_SA(0, 0), cA, voffA); PG8_STAGE(PG8_SB(0, 1), cB + hstep, voffB); PG8_STAGE(PG8_SA(0, 1), cA + hstep, voffA);
        if (wr == 1) PG8_BAR;
        PG8_WAIT_V(4); PG8_BAR;
        PG8_STAGE(PG8_SB(1, 0), cB + kstep, voffB); PG8_STAGE(PG8_SA(1, 0), cA + kstep, voffA); PG8_STAGE(PG8_SB(1, 1), cB + hstep + kstep, voffB);
        PG8_WAIT_V(6); PG8_BAR;
    }
    for (;;) {
        const bool has_next = S.next(ui + 1, nxt);
        const char* nA = has_next ? (const char*)g.A + (size_t)nxt.pm * tstep : cA; const char* nB = has_next ? (const char*)g.Bt + (size_t)nxt.pn * tstep : cB;
        for (int t = 0; t < nt; t += 2) {
            const bool last = (t == nt - 2);
            const char* a1 = cA + (size_t)(t + 1) * kstep;
            const char* a2 = last ? nA : cA + (size_t)(t + 2) * kstep; const char* b2 = last ? nB : cB + (size_t)(t + 2) * kstep;
            const char* a3 = a2 + kstep; const char* b3 = b2 + kstep;
            if (last && has_next) S.a_ready(nxt);
            if constexpr (SP2) {
            PG8_LDB(B0, 0, 0); PG8_LDB(B1, 0, 1); PG8_SCHED; PG8_LDA(At, 0, 0); PG8_STAGE(PG8_SA(1, 1), a1 + hstep, voffA);
            PG8_WAIT_V(8); PG8_WAIT_L(0); PG8_BAR; PG8_MMA(0, 0, At, B0); PG8_MMA(0, 1, At, B1); PG8_BAR; PG8_SCHED;
            PG8_LDA(At, 0, 1); PG8_STAGE(PG8_SB(0, 0), b2, voffB); PG8_STAGE(PG8_SB(0, 1), b2 + hstep, voffB); PG8_STAGE(PG8_SA(0, 0), a2, voffA);
            PG8_WAIT_V(8); PG8_WAIT_L(0); PG8_BAR; PG8_MMA(1, 0, At, B0); PG8_MMA(1, 1, At, B1); PG8_BAR; PG8_SCHED;
            PG8_LDB(B0, 1, 0); PG8_LDB(B1, 1, 1); PG8_SCHED; PG8_LDA(At, 1, 0); PG8_STAGE(PG8_SA(0, 1), a2 + hstep, voffA);
            PG8_WAIT_V(8); PG8_WAIT_L(0); PG8_BAR; PG8_MMA(0, 0, At, B0); PG8_MMA(0, 1, At, B1); PG8_BAR; PG8_SCHED;
            PG8_LDA(At, 1, 1); PG8_STAGE(PG8_SB(1, 0), b3, voffB); PG8_STAGE(PG8_SB(1, 1), b3 + hstep, voffB); PG8_STAGE(PG8_SA(1, 0), a3, voffA);
            PG8_WAIT_V(8); PG8_WAIT_L(0); PG8_BAR; PG8_MMA(1, 0, At, B0); PG8_MMA(1, 1, At, B1); PG8_BAR; PG8_SCHED;
            } else {
            PG8_LDB(B0, 0, 0); PG8_SCHED; PG8_LDA(At, 0, 0); PG8_STAGE(PG8_SA(1, 1), a1 + hstep, voffA);
            PG8_WAIT_L(8); PG8_BAR; PG8_WAIT_L(0); PG8_MMA(0, 0, At, B0); PG8_BAR; PG8_SCHED;
            PG8_LDB(B1, 0, 1); PG8_STAGE(PG8_SB(0, 0), b2, voffB);
            PG8_BAR; PG8_WAIT_L(0); PG8_MMA(0, 1, At, B1); PG8_BAR;
            PG8_LDA(At, 0, 1); PG8_STAGE(PG8_SA(0, 0), a2, voffA);
            PG8_BAR; PG8_WAIT_L(0); PG8_MMA(1, 0, At, B0); PG8_BAR; PG8_SCHED;
            PG8_STAGE(PG8_SB(0, 1), b2 + hstep, voffB);
            PG8_WAIT_V(6); PG8_BAR; PG8_MMA(1, 1, At, B1); PG8_BAR;
            PG8_LDB(B0, 1, 0); PG8_SCHED; PG8_LDA(At, 1, 0); PG8_STAGE(PG8_SA(0, 1), a2 + hstep, voffA);
            PG8_WAIT_L(8); PG8_BAR; PG8_WAIT_L(0); PG8_MMA(0, 0, At, B0); PG8_BAR; PG8_SCHED;
            PG8_LDB(B1, 1, 1); PG8_STAGE(PG8_SB(1, 0), b3, voffB);
            PG8_BAR; PG8_WAIT_L(0); PG8_MMA(0, 1, At, B1); PG8_BAR;
            PG8_LDA(At, 1, 1); PG8_STAGE(PG8_SA(1, 0), a3, voffA);
            PG8_BAR; PG8_WAIT_L(0); PG8_MMA(1, 0, At, B0); PG8_BAR; PG8_SCHED;
            PG8_STAGE(PG8_SB(1, 1), b3 + hstep, voffB);
            PG8_WAIT_V(6); PG8_BAR; PG8_MMA(1, 1, At, B1); PG8_BAR;
            }
        }
        if constexpr (ALIGN_EPI) { if (wr == 0) PG8_BAR; }
        if constexpr (!Epi::AFTER_DRAIN) { E(acc, cur, wr, wc, fr, fq); S.done(cur); }
        if (!has_next) break;
        bool keep_acc = false; if constexpr (Epi::CHAIN) keep_acc = E.keep(cur);
        if (!keep_acc) {
#pragma unroll
        for (int a = 0; a < 2; ++a)
#pragma unroll
            for (int b = 0; b < 2; ++b)
#pragma unroll
                for (int m = 0; m < 4; ++m)
#pragma unroll
                    for (int n = 0; n < 2; ++n) { float zf_ = 0.f; asm volatile("" : "+v"(zf_)); acc[a][b][m][n] = (f32x4){zf_, zf_, zf_, zf_}; }
        }
        cur = nxt; cA = nA; cB = nB; ++ui; nt = S.ktiles(cur, K / BK);
        if constexpr (ALIGN_EPI) { if (wr == 1) PG8_BAR; }
    }
    PG8_WAIT_V(0);
    if constexpr (!ALIGN_EPI) { if (wr == 0) PG8_BAR; }
    PG8_BAR;
    if constexpr (Epi::AFTER_DRAIN) { E.fused(acc, cur, wr, wc, fr, fq, lds, wid, lane); S.done(cur); }
#undef PG8_SA
#undef PG8_SB
#undef PG8_STAGE
#undef PG8_LDA
#undef PG8_LDB
#undef PG8_MMA
#undef PG8_WAIT_V
#undef PG8_WAIT_L
#undef PG8_BAR
#undef PG8_SCHED
}
}

constexpr int NWAVES = 8, NTHR = 512;
constexpr int BATCH = 2, SEQ = 16384, DM = 2048, DEPTH = 2, MTOK = BATCH * SEQ, DFF = 5632;
constexpr int RH = 6, RDK = 64, RDV = 128, RCH = 128;
constexpr int AH = 6, AD = 128, IH = 4, IDIM = 64, TOPK = 256;
constexpr int SGG = 4, SGD = 128, SGC = 128;
constexpr int NPROJ = 12288;
constexpr int DIN = 12100;
constexpr float EPS = 1e-6f;
constexpr int HROWS = 16384;

constexpr size_t MiB = 1u << 20;
constexpr size_t WS_CTL = 0, CTL_ZERO_BYTES = 1 * MiB;
constexpr size_t WS_PART = 1 * MiB;
constexpr size_t WS_RSTD = 5 * MiB;
constexpr size_t WS_KMAX = 5 * MiB + 512 * 1024;
constexpr size_t WS_POS = 5 * MiB + 768 * 1024;
constexpr size_t WS_ROPE = 6 * MiB;
constexpr size_t WS_WGU1 = 16 * MiB, WS_WD1 = 60 * MiB, WS_WGU2 = 82 * MiB, WS_WD2 = 126 * MiB, WS_WIN = 148 * MiB, WS_WBR = 196 * MiB, WS_WOUT = 205 * MiB;
constexpr size_t WS_XB = 216 * MiB;
constexpr size_t WS_ACT = 344 * MiB;
constexpr size_t WS_HID = WS_ACT;
constexpr size_t WS_QKR = WS_ACT;
constexpr size_t WS_VR = WS_QKR + 24 * MiB, WS_GR = WS_VR + 24 * MiB, WS_QA = WS_GR + 24 * MiB, WS_KA = WS_QA + 24 * MiB, WS_VA = WS_KA + 24 * MiB;
constexpr size_t WS_QI = WS_VA + 24 * MiB;
constexpr size_t WS_KI = WS_QI + 8 * MiB;
constexpr size_t WS_WI = WS_KI + 2 * MiB;
constexpr size_t WS_US = WS_WI + 1 * MiB, WS_VS = WS_US + 16 * MiB;
constexpr size_t WS_GATE = WS_VS + 16 * MiB;
constexpr size_t WS_OBR = WS_GATE + 192 * MiB;
constexpr size_t WS_MRG = WS_OBR + 72 * MiB;
constexpr size_t WS_MASK = WS_MRG + 64 * MiB;
constexpr size_t WS_KVST = WS_MASK + 32 * MiB;
constexpr size_t WS_APART = WS_KVST + 24 * MiB;
constexpr size_t WS_AML = WS_APART + 24 * MiB;
constexpr size_t WS_END = WS_AML + 1 * MiB;
static_assert(WS_END <= 1030 * MiB, "workspace map");
static_assert(WS_HID + (size_t)HROWS * DFF * 2 <= WS_END, "hid overlay");
constexpr int CW_TMO = 0, CW_BAR = 4096;

constexpr int RING_OFF = 0, RING_BYTES = 131072;
constexpr int LDSCTL_OFF = RING_BYTES + 31744 + 128, MISC_OFF = LDSCTL_OFF;
constexpr int LDS_BYTES = LDSCTL_OFF + 256;
static_assert(LDS_BYTES <= 160 * 1024, "LDS");

#define GAS __attribute__((address_space(1)))
#define LAS __attribute__((address_space(3)))
typedef unsigned short bf16;
typedef unsigned v4u __attribute__((ext_vector_type(4)));
typedef unsigned v2u __attribute__((ext_vector_type(2)));
typedef float f32x4 __attribute__((ext_vector_type(4)));
typedef float f32x16 __attribute__((ext_vector_type(16)));
typedef short bf16x8 __attribute__((ext_vector_type(8)));
typedef _Float16 f16x8 __attribute__((ext_vector_type(8)));
typedef _Float16 f16x2 __attribute__((ext_vector_type(2)));
typedef GAS unsigned gu32;
#define RLX_AGENT __ATOMIC_RELAXED, __HIP_MEMORY_SCOPE_AGENT
#define LDS_WAIT() asm volatile("s_waitcnt lgkmcnt(0)" ::: "memory")
#define VM_WAIT() asm volatile("s_waitcnt vmcnt(0)" ::: "memory")
__device__ __forceinline__ unsigned f2bf(float f) { unsigned u = __builtin_bit_cast(unsigned, f); return (u + 0x7fffu + ((u >> 16) & 1u)) >> 16; }
__device__ __forceinline__ unsigned pk2(float lo, float hi) { unsigned r; asm volatile("v_cvt_pk_bf16_f32 %0, %1, %2" : "=v"(r) : "v"(lo), "v"(hi)); return r; }
__device__ __forceinline__ float bf2f(unsigned short b) { return __builtin_bit_cast(float, ((unsigned)b) << 16); }
__device__ __forceinline__ float bflo(unsigned w) { return __builtin_bit_cast(float, w << 16); }
__device__ __forceinline__ float bfhi(unsigned w) { return __builtin_bit_cast(float, w & 0xffff0000u); }
__device__ __forceinline__ unsigned pkh2(float lo, float hi) { f16x2 v = {(_Float16)lo, (_Float16)hi}; return __builtin_bit_cast(unsigned, v); }
__device__ __forceinline__ float fsigmoid(float x) { return __builtin_amdgcn_rcpf(1.0f + __builtin_amdgcn_exp2f(-1.4426950408889634f * x)); }
__device__ __forceinline__ float fsilu(float x) { return x * fsigmoid(x); }
__device__ __forceinline__ float fgelu_tanh(float x) { const float u = 1.5957691216057308f * (x + 0.044715f * x * x * x); return x * fsigmoid(u); }
__device__ __forceinline__ float wave_sum(float v) {
#pragma unroll
    for (int o = 1; o < 64; o <<= 1) v += __shfl_xor(v, o);
    return v;
}
__device__ __forceinline__ f32x4 zero4() { float z = 0.f; asm volatile("" : "+v"(z)); return (f32x4){z, z, z, z}; }
__device__ __forceinline__ f32x16 zero16() { float z = 0.f; asm volatile("" : "+v"(z)); return (f32x16){z, z, z, z, z, z, z, z, z, z, z, z, z, z, z, z}; }
__device__ __forceinline__ v4u zero4u() { unsigned z = 0u; asm volatile("" : "+v"(z)); return (v4u){z, z, z, z}; }
__device__ __forceinline__ int lane_id() { unsigned m = ~0u; asm volatile("" : "+s"(m)); return (int)__builtin_amdgcn_mbcnt_hi(m, __builtin_amdgcn_mbcnt_lo(m, 0u)); }
#ifndef PROBE_SGR1
#define PROBE_SGR1 1
#endif
#ifndef PROBE_R3
#define PROBE_R3 1
#endif
#ifndef PROBE_IDX
#define PROBE_IDX 1
#endif
__device__ __forceinline__ int rep_count(int k) { asm volatile("" : "+s"(k)); return k; }
#ifndef PROBE_IDXD
#define PROBE_IDXD 0
#endif
#define XB_TMO      128
#define XB_XCNT(j)  (256  + 64 * (j))
#define XB_XSUB(j)  (1280 + 64 * (j))
#define XB_XGEN(j)  (2304 + 64 * (j))
#define XB_TOP      3328
#define XB_TOPGEN   3392
#define XCD_BAR_WORDS 3456
#define XB_SPIN_CAP (1u << 18)

__device__ __forceinline__ unsigned xb_ld(unsigned* p)              { return __hip_atomic_load(p, __ATOMIC_RELAXED, __HIP_MEMORY_SCOPE_AGENT); }
__device__ __forceinline__ unsigned xb_add(unsigned* p, unsigned v) { return __hip_atomic_fetch_add(p, v, __ATOMIC_RELAXED, __HIP_MEMORY_SCOPE_AGENT); }
__device__ __forceinline__ unsigned xb_xcc_id() { return (unsigned)__builtin_amdgcn_s_getreg((3 << 11) | 20) & 0xFu; }
#define XB_SPIN(cond, bar) do { unsigned _sp = 0; while (cond) { __builtin_amdgcn_s_sleep(1); \
    if ((++_sp & 255u) == 0u) { if (xb_ld(&(bar)[XB_TMO])) break; if (_sp > XB_SPIN_CAP) { atomicAdd(&(bar)[XB_TMO], 1u); break; } } } } while (0)

struct XcdBarrier {
    unsigned* bar; unsigned x;
    volatile LAS unsigned* st;
};

__device__ __forceinline__ XcdBarrier xcd_barrier_post(unsigned* bar, volatile LAS unsigned* st) {
    XcdBarrier b; b.bar = bar; b.x = xb_xcc_id(); b.st = st;
    if (threadIdx.x == 0) (void)xb_add(&bar[XB_XCNT(b.x)], 1u);
    return b;
}
__device__ __forceinline__ void xcd_barrier_complete(unsigned* bar, unsigned x, unsigned& nloc, unsigned& nx) {
    const unsigned G = gridDim.x * gridDim.y * gridDim.z;
    unsigned sum, cnt, mine, sp = 0u;
    for (;;) {
        sum = 0u; cnt = 0u; mine = 0u;
#pragma unroll
        for (unsigned j = 0; j < 16; ++j) { const unsigned c = xb_ld(&bar[XB_XCNT(j)]); sum += c; cnt += (c > 0u) ? 1u : 0u; mine = (j == x) ? c : mine; }
        if (sum == G) break;
        __builtin_amdgcn_s_sleep(1);
        if ((++sp & 255u) == 0u) { if (xb_ld(&bar[XB_TMO])) break; if (sp > XB_SPIN_CAP) { atomicAdd(&bar[XB_TMO], 1u); break; } }
    }
    nloc = mine > 0u ? mine : 1u; nx = cnt > 0u ? cnt : 1u;
}

__device__ __forceinline__ void xcd_barrier(const XcdBarrier& b0, const int wave_sgpr) {
    XcdBarrier b = b0; asm volatile("" : "+s"(b.bar), "+s"(b.x));
    asm volatile("s_waitcnt vmcnt(0)" ::: "memory");
    __syncthreads();
    if (wave_sgpr == 0 && lane_id() == 0) {
        unsigned* bar = b.bar;
        __builtin_amdgcn_s_waitcnt(0);
        unsigned nloc = b.st[0], nx = b.st[1];
        if (nloc == 0u) { xcd_barrier_complete(bar, b.x, nloc, nx); b.st[0] = nloc; b.st[1] = nx; }
        const unsigned old = xb_add(&bar[XB_XSUB(b.x)], 1u);
        const unsigned gen = old / nloc;
        if (old + 1u == (gen + 1u) * nloc) {
            __builtin_amdgcn_fence(__ATOMIC_RELEASE, "agent");
            asm volatile("s_waitcnt vmcnt(0)" ::: "memory");
            const unsigned og = xb_add(&bar[XB_TOP], 1u);
            const unsigned tg = og / nx;
            if (og + 1u == (tg + 1u) * nx) xb_add(&bar[XB_TOPGEN], 1u);
            else XB_SPIN(xb_ld(&bar[XB_TOPGEN]) == tg, bar);
            __builtin_amdgcn_fence(__ATOMIC_ACQUIRE, "agent");
            xb_add(&bar[XB_XGEN(b.x)], 1u);
            asm volatile("s_waitcnt vmcnt(0)" ::: "memory");
        } else {
            XB_SPIN(xb_ld(&bar[XB_XGEN(b.x)]) == gen, bar);
            __builtin_amdgcn_fence(__ATOMIC_ACQUIRE, "agent");
            asm volatile("s_waitcnt vmcnt(0)" ::: "memory");
        }
    }
    __syncthreads();
}

using pg8::Unit; using pg8::HALF; using pg8::BM;
#ifndef NT_PROJ
#define NT_PROJ 0
#endif
#ifndef HID_BLK
#define HID_BLK 0
#endif
#ifndef RESID_GROUP
#define RESID_GROUP 1
#endif
#ifndef NT_GATE
#define NT_GATE 1
#endif
#ifndef NT_X
#define NT_X 0
#endif
__device__ __forceinline__ v4u pack8bf(const f32x4 a, const f32x4 b) { v4u w; w.x = pk2(a[0], a[1]); w.y = pk2(a[2], a[3]); w.z = pk2(b[0], b[1]); w.w = pk2(b[2], b[3]); return w; }
__device__ __forceinline__ v4u pack8h(const f32x4 a, const f32x4 b) { v4u w; w.x = pkh2(a[0], a[1]); w.y = pkh2(a[2], a[3]); w.z = pkh2(b[0], b[1]); w.w = pkh2(b[2], b[3]); return w; }

struct EpiSwiGLU {
    static constexpr bool PERM = true, AFTER_DRAIN = false, CHAIN = false;
    bf16* H; const float* rstd; int skip;
    __device__ __forceinline__ void operator()(const f32x4 (&acc)[2][2][4][2], const Unit& u, int wr, int wc, int fr, int fq) const {
        if (skip) {
#pragma unroll
            for (int a = 0; a < 2; ++a)
#pragma unroll
                for (int b = 0; b < 2; ++b)
#pragma unroll
                    for (int m = 0; m < 4; ++m) asm volatile("" :: "v"(acc[a][b][m][0]), "v"(acc[a][b][m][1]));
            return; }
        const int row0 = u.pm * BM + wr * 64 + fr, col0 = u.pn * 128 + wc * 32 + 8 * fq;
#pragma unroll
        for (int ai = 0; ai < 2; ++ai)
#pragma unroll
            for (int m = 0; m < 4; ++m) { const int r = row0 + ai * HALF + m * 16; const float rs = rstd[r];
                f32x4 h0, h1;
                typedef float f2 __attribute__((ext_vector_type(2)));
                const float rn = rs * -1.4426950408889634f, r2 = rs * rs;
#pragma unroll
                for (int n = 0; n < 2; ++n)
#pragma unroll
                    for (int j = 0; j < 2; ++j) { const f2 g = {acc[ai][0][m][n][2 * j], acc[ai][0][m][n][2 * j + 1]}, uu = {acc[ai][1][m][n][2 * j], acc[ai][1][m][n][2 * j + 1]};
                        const f2 t = g * rn; f2 d = {__builtin_amdgcn_exp2f(t.x), __builtin_amdgcn_exp2f(t.y)}; d = d + 1.0f;
                        const f2 rc = {__builtin_amdgcn_rcpf(d.x), __builtin_amdgcn_rcpf(d.y)}; const f2 o = (g * uu) * (rc * r2);
                        if (n == 0) { h0[2 * j] = o.x; h0[2 * j + 1] = o.y; } else { h1[2 * j] = o.x; h1[2 * j + 1] = o.y; } }
                if (HID_BLK) *(v4u*)(H + (((size_t)(r >> 8) * (DFF / 64) + (col0 >> 6)) * 256 + (r & 255)) * 64 + (col0 & 63)) = pack8bf(h0, h1);
                else *(v4u*)(H + (size_t)r * DFF + col0) = pack8bf(h0, h1); }
    }
};
#ifndef RESID_BF16
#define RESID_BF16 1
#endif
struct EpiResid {
    static constexpr bool PERM = false, AFTER_DRAIN = false, CHAIN = false;
    const float* base; float* X; bf16* XB; float* part; float coef; int skip = 0;
    __device__ __forceinline__ void operator()(const f32x4 (&acc)[2][2][4][2], const Unit& u, int wr, int wc, int fr, int fq) const {
        if (skip) {
#pragma unroll
            for (int a = 0; a < 2; ++a)
#pragma unroll
                for (int b = 0; b < 2; ++b)
#pragma unroll
                    for (int m = 0; m < 4; ++m) asm volatile("" :: "v"(acc[a][b][m][0]), "v"(acc[a][b][m][1]));
            return; }
        const int row0 = u.pm * BM + wr * 64 + fr, col0 = u.pn * BM + wc * 32 + 4 * fq;
#pragma unroll
        for (int ai = 0; ai < 2; ++ai)
#pragma unroll
            for (int m = 0; m < 4; ++m) { const int r = row0 + ai * HALF + m * 16; float ss = 0.f;
#pragma unroll
                for (int bj = 0; bj < 2; ++bj)
#pragma unroll
                    for (int n = 0; n < 2; ++n) { const size_t o = (size_t)r * DM + col0 + bj * HALF + n * 16;
#if RESID_BF16
                        f32x4 b; if (base) b = *(const f32x4*)(base + o); else { const v2u bw = *(const v2u*)(XB + o); b = (f32x4){bflo(bw.x), bfhi(bw.x), bflo(bw.y), bfhi(bw.y)}; }
                        const f32x4 v = b + acc[ai][bj][m][n] * coef;
                        v2u w; w.x = pk2(v[0], v[1]); w.y = pk2(v[2], v[3]); *(v2u*)(XB + o) = w;
#else
                        const f32x4 b = NT_X ? __builtin_nontemporal_load((const f32x4*)(base + o)) : *(const f32x4*)(base + o); const f32x4 v = b + acc[ai][bj][m][n] * coef;
                        if (NT_X) __builtin_nontemporal_store(v, (f32x4*)(X + o)); else *(f32x4*)(X + o) = v; v2u w; w.x = pk2(v[0], v[1]); w.y = pk2(v[2], v[3]); *(v2u*)(XB + o) = w;
#endif
                        ss += (v[0] * v[0] + v[1] * v[1]) + (v[2] * v[2] + v[3] * v[3]); }
                ss += __shfl_xor(ss, 16); ss += __shfl_xor(ss, 32);
                if (fq == 0) part[(size_t)r * 32 + u.pn * 4 + wc] = ss;
                if ((m & (RESID_GROUP - 1)) == RESID_GROUP - 1) asm volatile("" ::: "memory"); }
    }
};
struct EpiProj {
    static constexpr bool PERM = true, AFTER_DRAIN = false, CHAIN = false;
    const float* rstd; const float* rcos; const float* rsin;
    bf16 *QKR, *VR, *GR, *QA, *KA, *VA, *US, *VS, *GATE; unsigned short *QI, *KI; float* WI; int skip = 0;
    __device__ __forceinline__ void operator()(const f32x4 (&acc)[2][2][4][2], const Unit& u, int wr, int wc, int fr, int fq) const {
        if (skip) {
#pragma unroll
            for (int a = 0; a < 2; ++a)
#pragma unroll
                for (int b = 0; b < 2; ++b)
#pragma unroll
                    for (int m = 0; m < 4; ++m) asm volatile("" :: "v"(acc[a][b][m][0]), "v"(acc[a][b][m][1]));
            return; }
        const int row0 = u.pm * BM + wr * 64 + fr, pn = u.pn, cw = wc * 32 + 8 * fq;
        if (pn < 3) {
            const int slot = 4 * pn + wc;
#pragma unroll
            for (int ai = 0; ai < 2; ++ai)
#pragma unroll
                for (int m = 0; m < 4; ++m) { const int r = row0 + ai * HALF + m * 16; const float rs = rstd[r];
                    const f32x4 c0 = *(const f32x4*)(rcos + (size_t)r * 32 + 8 * fq), c1 = *(const f32x4*)(rcos + (size_t)r * 32 + 8 * fq + 4);
                    const f32x4 s0 = *(const f32x4*)(rsin + (size_t)r * 32 + 8 * fq), s1 = *(const f32x4*)(rsin + (size_t)r * 32 + 8 * fq + 4);
                    const f32x4 a0 = acc[ai][0][m][0] * rs, a1 = acc[ai][0][m][1] * rs, b0 = acc[ai][1][m][0] * rs, b1 = acc[ai][1][m][1] * rs;
                    const f32x4 o10 = a0 * c0 - b0 * s0, o11 = a1 * c1 - b1 * s1, o20 = a0 * s0 + b0 * c0, o21 = a1 * s1 + b1 * c1;
                    bf16* d = QKR + (size_t)r * 768 + slot * 64 + 8 * fq;
                    *(v4u*)d = pack8bf(o10, o11); *(v4u*)(d + 32) = pack8bf(o20, o21); }
            return;
        }
        if (pn == 19) {
#pragma unroll
            for (int ai = 0; ai < 2; ++ai)
#pragma unroll
                for (int m = 0; m < 4; ++m) { const int r = row0 + ai * HALF + m * 16; const float rs = rstd[r];
                    if (wc < 2) *(v4u*)(KI + (size_t)r * 64 + cw) = pack8h(acc[ai][0][m][0] * rs, acc[ai][0][m][1] * rs);
                    if (wc == 2 && fq == 0) *(f32x4*)(WI + (size_t)r * 4) = acc[ai][0][m][0] * (rs * 0.0625f); }
            return;
        }
        int mode; unsigned short* dst; int ld, c0;
        if (pn < 6) { mode = 0; dst = VR; ld = 768; c0 = (pn - 3) * 256; }
        else if (pn < 9) { mode = 1; dst = GR; ld = 768; c0 = (pn - 6) * 256; }
        else if (pn < 12) { mode = 0; dst = QA; ld = 768; c0 = (pn - 9) * 256; }
        else if (pn < 15) { mode = 0; dst = KA; ld = 768; c0 = (pn - 12) * 256; }
        else if (pn < 18) { mode = 0; dst = VA; ld = 768; c0 = (pn - 15) * 256; }
        else if (pn == 18) { mode = 4; dst = QI; ld = 256; c0 = 0; }
        else if (pn < 22) { mode = 2; dst = US; ld = 512; c0 = (pn - 20) * 256; }
        else if (pn < 24) { mode = 2; dst = VS; ld = 512; c0 = (pn - 22) * 256; }
        else { mode = 3; dst = GATE; ld = 6144; c0 = (pn - 24) * 256; }
#pragma unroll
        for (int ai = 0; ai < 2; ++ai)
#pragma unroll
            for (int m = 0; m < 4; ++m) { const int r = row0 + ai * HALF + m * 16; const float rs = rstd[r];
#pragma unroll
                for (int bj = 0; bj < 2; ++bj) { f32x4 v0 = acc[ai][bj][m][0] * rs, v1 = acc[ai][bj][m][1] * rs;
                    if (mode == 1 || mode == 2) { typedef float f2 __attribute__((ext_vector_type(2)));
#pragma unroll
                        for (int j = 0; j < 4; ++j) { f2 x = (j < 2) ? (f2){v0[2 * j], v0[2 * j + 1]} : (f2){v1[2 * j - 4], v1[2 * j - 3]};
                            f2 t = (mode == 1) ? x * -1.4426950408889634f : (x * (x * x * 0.044715f + 1.0f)) * (-1.4426950408889634f * 1.5957691216057308f);
                            f2 d = {__builtin_amdgcn_exp2f(t.x), __builtin_amdgcn_exp2f(t.y)}; d = d + 1.0f; const f2 rc = {__builtin_amdgcn_rcpf(d.x), __builtin_amdgcn_rcpf(d.y)}; x = x * rc;
                            if (j < 2) { v0[2 * j] = x.x; v0[2 * j + 1] = x.y; } else { v1[2 * j - 4] = x.x; v1[2 * j - 3] = x.y; } } }
                    else if (mode == 3) { typedef float f2 __attribute__((ext_vector_type(2)));
#pragma unroll
                        for (int j = 0; j < 2; ++j) { f2 a = {v0[2 * j], v0[2 * j + 1]}, b = {v1[2 * j], v1[2 * j + 1]}; a = a * -1.4426950408889634f; b = b * -1.4426950408889634f;
                            f2 da = {__builtin_amdgcn_exp2f(a.x), __builtin_amdgcn_exp2f(a.y)}, db = {__builtin_amdgcn_exp2f(b.x), __builtin_amdgcn_exp2f(b.y)}; da = da + 1.0f; db = db + 1.0f;
                            v0[2 * j] = da.x; v0[2 * j + 1] = da.y; v1[2 * j] = db.x; v1[2 * j + 1] = db.y; } }
                    const v4u w = (mode == 4) ? pack8h(v0, v1) : pack8bf(v0, v1);
                    v4u* dp = (v4u*)(dst + (size_t)r * ld + c0 + bj * HALF + cw);
                    if ((NT_GATE && mode == 3) || NT_PROJ) __builtin_nontemporal_store(w, dp); else *dp = w; } }
    }
};
struct EpiMerge {
    static constexpr bool PERM = true, AFTER_DRAIN = false, CHAIN = true;
    const bf16* GATE; bf16* MRG;
    __device__ __forceinline__ bool keep(const Unit& u) const { return (u.pm >> 6) < 2; }
    static __device__ __forceinline__ void dens8(const v4u g, float (&o)[8]) { const float hi = 1152921504606846976.0f;
        o[0] = fminf(bflo(g.x), hi); o[1] = fminf(bfhi(g.x), hi); o[2] = fminf(bflo(g.y), hi); o[3] = fminf(bfhi(g.y), hi); o[4] = fminf(bflo(g.z), hi); o[5] = fminf(bfhi(g.z), hi); o[6] = fminf(bflo(g.w), hi); o[7] = fminf(bfhi(g.w), hi); }
    __device__ __forceinline__ void operator()(f32x4 (&acc)[2][2][4][2], const Unit& u, int wr, int wc, int fr, int fq) const {
        const int br = u.pm >> 6, pm = u.pm & 63, pn = u.pn & 7;
        const int row0 = pm * BM + wr * 64 + fr, col0 = pn * BM + wc * 32 + 8 * fq;
#pragma unroll
        for (int ai = 0; ai < 2; ++ai)
#pragma unroll
            for (int m = 0; m < 4; ++m) { const int r = row0 + ai * HALF + m * 16;
#pragma unroll
                for (int bj = 0; bj < 2; ++bj) { const int c = col0 + bj * HALF;
                    const bf16* gp = GATE + (size_t)r * 6144 + br * 2048 + c;
                    float f[8]; dens8(*(const v4u*)gp, f);
#pragma unroll
                    for (int j = 0; j < 8; ++j) f[j] = __builtin_amdgcn_rcpf(f[j]);
                    if (br < 2) { float d[8]; dens8(*(const v4u*)(gp + 2048), d);
#pragma unroll
                        for (int j = 0; j < 8; ++j) f[j] *= d[j]; }
                    f32x4 v0 = acc[ai][bj][m][0], v1 = acc[ai][bj][m][1];
                    v0[0] *= f[0]; v0[1] *= f[1]; v0[2] *= f[2]; v0[3] *= f[3]; v1[0] *= f[4]; v1[1] *= f[5]; v1[2] *= f[6]; v1[3] *= f[7];
                    if (br < 2) { acc[ai][bj][m][0] = v0; acc[ai][bj][m][1] = v1; }
                    else *(v4u*)(MRG + (size_t)r * DM + c) = pack8bf(v0, v1); } }
    }
};
struct MergeOrder {
    pg8::StaticOrder so;
    __device__ void init(int G, int c, int wgm) { so.init(HROWS, DM, G, c, wgm); }
    __device__ bool next(int i, Unit& u) const { Unit t; if (!so.next(i / 3, t)) return false; const int br = i % 3; u.pm = 64 * br + t.pm; u.pn = 8 * br + t.pn; return true; }
    __device__ __forceinline__ void a_ready(const Unit&) const {}
    __device__ __forceinline__ void done(const Unit&) const {}
    __device__ __forceinline__ int ktiles(const Unit& u, int full) const { return (u.pm >> 6) == 2 ? 512 / 64 : full; }
};

struct Args { const void* in[22]; float* out; unsigned char* ws; int ph_lo, ph_hi; };
struct Frame {
    LAS unsigned char* lds; volatile LAS unsigned* MISC; gu32* ctl;
    int tid, lane, wave, vcu, G;
    unsigned char* ws;
    const float* xin; const int* pos; const float* rel;
    float* X;
};

__device__ __forceinline__ void conv_item(const float* W, int ldw, int sc, int cnt, int k0, int kvalid, const float* gain, bf16* WT, int drow0, int Kd, LAS float* scr, int lane, bool blk = false) {
#define WT_AT(n_, k_) (blk ? (WT + ((((size_t)((n_) >> 8) * (Kd / 64) + ((k_) >> 6)) * 256 + ((n_) & 255)) * 64 + ((k_) & 63))) : (WT + (size_t)(n_) * Kd + (k_)))
    const int c8 = lane & 7;
    if (k0 >= kvalid || cnt <= 0) {
#pragma unroll
        for (int j = 0; j < 4; ++j) { const int n = (lane >> 3) + 8 * j; *(GAS v4u*)WT_AT(drow0 + n, k0 + 8 * c8) = zero4u(); }
        return;
    }
    const int c4 = (lane & 7) * 4, kr = lane >> 3; const bool cok = c4 < cnt; const int cc = cok ? c4 : 0;
    f32x4 v[8];
#pragma unroll
    for (int i = 0; i < 8; ++i) v[i] = *(const f32x4*)(W + (size_t)(k0 + 8 * i + kr) * ldw + sc + cc);
#pragma unroll
    for (int i = 0; i < 8; ++i) { const int kk = 8 * i + kr; f32x4 x = cok ? v[i] : (f32x4){0.f, 0.f, 0.f, 0.f}; if (gain) x = x * gain[k0 + kk];
        LAS float* d = scr + kk * 33 + c4; d[0] = x[0]; d[1] = x[1]; d[2] = x[2]; d[3] = x[3]; }
    LDS_WAIT(); asm volatile("" ::: "memory");
#pragma unroll
    for (int j = 0; j < 4; ++j) { const int n = (lane >> 3) + 8 * j; const LAS float* s = scr + (8 * c8) * 33 + n;
        v4u o; o.x = pk2(s[0 * 33], s[1 * 33]); o.y = pk2(s[2 * 33], s[3 * 33]); o.z = pk2(s[4 * 33], s[5 * 33]); o.w = pk2(s[6 * 33], s[7 * 33]);
        *(GAS v4u*)WT_AT(drow0 + n, k0 + 8 * c8) = o; }
    LDS_WAIT(); asm volatile("" ::: "memory");
#undef WT_AT
}
__device__ __forceinline__ void proj_src_group(int g, int& sc, int& cnt) {
    const int r0 = 32 * g; cnt = 32;
    if (r0 < 768) { const int t = r0 / 256, w = r0 % 256, bj = w / 128, wcq = (w % 128) / 32; sc = (4 * t + wcq) * 64 + 32 * bj; }
    else if (r0 < 4864) sc = r0;
    else if (r0 < 5120) { const int w = r0 - 4864; if (w < 64) sc = 4864 + w; else if (w == 64) { sc = 4928; cnt = 4; } else { sc = 0; cnt = 0; } }
    else if (r0 < 6144) sc = 4932 + (r0 - 5120);
    else sc = 5956 + (r0 - 6144);
}
__device__ __forceinline__ void p_convert(Frame& F0, const Args& a, int l) {
    Frame F = F0; { GAS unsigned char* wsg_ = (GAS unsigned char*)F.ws; F.tid = F.wave * 64 + lane_id(); asm volatile("" : "+v"(F.tid), "+s"(wsg_), "+s"(F.vcu), "+s"(F.G)); F.lane = F.tid & 63; F.ws = (unsigned char*)wsg_; }
    LAS float* scr = (LAS float*)(F.lds + RING_OFF + F.wave * 16384);
    const int gw = F.vcu * NWAVES + F.wave, NGW = F.G * NWAVES;
    constexpr int I_GU = 352 * 32, I_D = 64 * 88, I_IN = 384 * 32, I_BR = 192 * 12, I_OUT = 64 * 32;
    constexpr int NITEMS = 2 * (I_GU + I_D) + I_IN + I_BR + I_OUT;
#pragma unroll 1
    for (int it = gw; it < NITEMS; it += NGW) {
        int r = it;
        int src_idx, ldw, sc, cnt = 32, k0, kvalid, gain_idx = -1, drow0, Kd; size_t src_off, dst_off; bool blk = false;
        if (r < 2 * (I_GU + I_D)) {
            const int which = r / (I_GU + I_D); r -= which * (I_GU + I_D);
            if (r < I_GU) { const int g = r / 32, kb = r % 32, pn = g / 8, w = g % 8, bj = w / 4;
                src_idx = (which ? 18 : 4) + bj; src_off = (size_t)l * DM * DFF; ldw = DFF; sc = 128 * pn + (w % 4) * 32; k0 = 64 * kb; kvalid = DM; gain_idx = which ? 17 : 3;
                dst_off = which ? WS_WGU2 : WS_WGU1; drow0 = 32 * g; Kd = DM; }
            else { r -= I_GU; const int g = r / 88, kb = r % 88;
                src_idx = which ? 20 : 6; src_off = (size_t)l * DFF * DM; ldw = DM; sc = 32 * g; k0 = 64 * kb; kvalid = DFF;
                dst_off = which ? WS_WD2 : WS_WD1; drow0 = 32 * g; Kd = DFF; blk = HID_BLK; }
        } else {
            r -= 2 * (I_GU + I_D);
            if (r < I_IN) { const int g = r / 32, kb = r % 32; proj_src_group(g, sc, cnt);
                src_idx = 8; src_off = (size_t)l * DM * DIN; ldw = DIN; k0 = 64 * kb; kvalid = DM; gain_idx = 7; dst_off = WS_WIN; drow0 = 32 * g; Kd = DM; }
            else { r -= I_IN;
                if (r < I_BR) { const int g = r / 12, kb = r % 12, br = g / 64; const int kbr = br == 2 ? 512 : 768;
                    src_idx = 13 + br; src_off = (size_t)l * kbr * DM; ldw = DM; sc = 32 * (g % 64); k0 = 64 * kb; kvalid = kbr; dst_off = WS_WBR; drow0 = 32 * g; Kd = 768; }
                else { r -= I_BR; const int g = r / 32, kb = r % 32;
                    src_idx = 16; src_off = (size_t)l * DM * DM; ldw = DM; sc = 32 * g; k0 = 64 * kb; kvalid = DM; dst_off = WS_WOUT; drow0 = 32 * g; Kd = DM; } }
        }
        const float* W = (const float*)a.in[src_idx] + src_off;
        const float* gain = gain_idx >= 0 ? (const float*)a.in[gain_idx] + (size_t)l * DM : nullptr;
        conv_item(W, ldw, sc, cnt, k0, kvalid, gain, (bf16*)(F.ws + dst_off), drow0, Kd, scr, F.lane, blk);
    }
}
__device__ __forceinline__ void p_prologue(Frame& F0) {
    Frame F = F0; { GAS unsigned char* wsg_ = (GAS unsigned char*)F.ws; F.tid = F.wave * 64 + lane_id(); asm volatile("" : "+v"(F.tid), "+s"(wsg_), "+s"(F.vcu), "+s"(F.G)); F.lane = F.tid & 63; F.ws = (unsigned char*)wsg_; }
    const int gw = F.vcu * NWAVES + F.wave, NGW = F.G * NWAVES;
    float* rcos = (float*)(F.ws + WS_ROPE); float* rsin = rcos + (size_t)MTOK * 32;
    const int j = F.lane & 31;
    const float invf = powf(10000.0f, -(float)(2 * j) / 64.0f);
    for (int t2 = gw; t2 < MTOK / 2; t2 += NGW) { const int t = 2 * t2 + (F.lane >> 5);
        const float ang = (float)F.pos[t] * invf;
        double rev = (double)ang * 0.15915494309189533577; rev -= __builtin_rint(rev);
        const float fr = (float)rev;
        rcos[(size_t)t * 32 + j] = __builtin_amdgcn_cosf(fr); rsin[(size_t)t * 32 + j] = __builtin_amdgcn_sinf(fr); }
    { int* pc = (int*)(F.ws + WS_POS); for (int i = F.vcu * NTHR + F.tid; i < MTOK; i += F.G * NTHR) pc[i] = F.pos[i]; }
    int* kmax = (int*)(F.ws + WS_KMAX);
    for (int kt = gw; kt < BATCH * 256; kt += NGW) { const int p0 = F.pos[kt * 64 + F.lane]; int p = p0, q0 = p0;
#pragma unroll
        for (int o = 1; o < 64; o <<= 1) { const int q = __shfl_xor(p, o); p = q > p ? q : p; }
#pragma unroll
        for (int o = 1; o < 32; o <<= 1) { const int q = __shfl_xor(q0, o); q0 = q < q0 ? q : q0; }
        if (F.lane == 0) kmax[kt] = p;
        if ((F.lane & 31) == 0) kmax[1024 + 2 * kt + (F.lane >> 5)] = q0; }
    bf16* XB = (bf16*)(F.ws + WS_XB); float* part = (float*)(F.ws + WS_PART);
    for (int m = gw; m < MTOK; m += NGW) {
        const GAS f32x4* xr = (const GAS f32x4*)(F.xin + (size_t)m * DM) + F.lane; float ss = 0.f;
#pragma unroll
        for (int jj = 0; jj < 8; ++jj) { const f32x4 v = xr[64 * jj]; ss += (v[0] * v[0] + v[1] * v[1]) + (v[2] * v[2] + v[3] * v[3]);
            v2u w; w.x = pk2(v[0], v[1]); w.y = pk2(v[2], v[3]); *((GAS v2u*)(XB + (size_t)m * DM) + F.lane + 64 * jj) = w; }
        ss = wave_sum(ss);
        if (F.lane < 32) part[(size_t)m * 32 + F.lane] = F.lane == 0 ? ss : 0.f; }
}
__device__ __forceinline__ void p_rowstat(Frame& F0) {
    Frame F = F0; { GAS unsigned char* wsg_ = (GAS unsigned char*)F.ws; F.tid = F.wave * 64 + lane_id(); asm volatile("" : "+v"(F.tid), "+s"(wsg_), "+s"(F.vcu), "+s"(F.G)); F.lane = F.tid & 63; F.ws = (unsigned char*)wsg_; }
    const float* part = (const float*)(F.ws + WS_PART); float* rstd = (float*)(F.ws + WS_RSTD);
    for (int r = F.vcu * NTHR + F.tid; r < MTOK; r += F.G * NTHR) { const f32x4* p = (const f32x4*)(part + (size_t)r * 32); float s = 0.f;
#pragma unroll
        for (int jj = 0; jj < 8; ++jj) { const f32x4 v = p[jj]; s += (v[0] + v[1]) + (v[2] + v[3]); }
        rstd[r] = 1.0f / sqrtf(s * (1.0f / DM) + EPS); }
}
__device__ __forceinline__ void p_final(Frame& F0, const float* gfin) {
    Frame F = F0; { GAS unsigned char* wsg_ = (GAS unsigned char*)F.ws; F.tid = F.wave * 64 + lane_id(); asm volatile("" : "+v"(F.tid), "+s"(wsg_), "+s"(F.vcu), "+s"(F.G)); F.lane = F.tid & 63; F.ws = (unsigned char*)wsg_; }
    const int gw = F.vcu * NWAVES + F.wave, NGW = F.G * NWAVES; const float* rstd = (const float*)(F.ws + WS_RSTD);
    const float* part = (const float*)(F.ws + WS_PART); (void)rstd;
    for (int m = gw; m < MTOK; m += NGW) { GAS f32x4* xr = (GAS f32x4*)(F.X + (size_t)m * DM) + F.lane;
        const float rs = 1.0f / sqrtf(wave_sum(F.lane < 32 ? part[(size_t)m * 32 + F.lane] : 0.f) * (1.0f / DM) + EPS);
#if RESID_BF16
        const GAS v2u* xb = (const GAS v2u*)((const bf16*)(F.ws + WS_XB) + (size_t)m * DM) + F.lane;
#pragma unroll
        for (int jj = 0; jj < 8; ++jj) { const f32x4 g = *((const f32x4*)gfin + F.lane + 64 * jj); const v2u w = xb[64 * jj];
            xr[64 * jj] = (f32x4){bflo(w.x), bfhi(w.x), bflo(w.y), bfhi(w.y)} * rs * g; } }
#else
#pragma unroll
        for (int jj = 0; jj < 8; ++jj) { const f32x4 g = *((const f32x4*)gfin + F.lane + 64 * jj); xr[64 * jj] = xr[64 * jj] * rs * g; } }
#endif
}

namespace idx {
constexpr int IDX_STATE = 131072 + 128;
typedef LAS unsigned* lhist_t;
__device__ __forceinline__ int crow16(int r, int hi) { return (r & 3) + 8 * (r >> 2) + 4 * hi; }
struct QState { f16x8 qf[4][4]; f32x4 wv; };
struct KFrag { f16x8 k[4]; };
__device__ __forceinline__ void load_k(const GAS char* ws, int kt, int c, int hi, KFrag& K) {
    const GAS char* p = ws + (unsigned)((unsigned)WS_KI + (unsigned)((32 * kt + c) * 64 + 8 * hi) * 2u);
#pragma unroll
    for (int ks = 0; ks < 4; ++ks) K.k[ks] = *(const GAS f16x8*)(p + ks * 32);
}
typedef float f32x2 __attribute__((ext_vector_type(2)));
__device__ __forceinline__ void relu_fma(const f32x16& a, float w, f32x2 (&s2)[8]) {
    const f32x2 w2 = (f32x2){w, w};
#pragma unroll
    for (int i = 0; i < 8; ++i) { f32x2 p; { const float f0 = a[2 * i], f1 = a[2 * i + 1]; const int x0 = __builtin_bit_cast(int, f0), x1 = __builtin_bit_cast(int, f1);
            p.x = __builtin_bit_cast(float, x0 > 0 ? x0 : 0); p.y = __builtin_bit_cast(float, x1 > 0 ? x1 : 0); } s2[i] = p * w2 + s2[i]; }
}
__device__ __forceinline__ void score_tile2(const KFrag& Ka, const KFrag& Kb, const LAS char* qlds, const f32x4 wv, f32x16& sa, f32x16& sb) {
    f32x2 a2[8], b2[8];
#pragma unroll
    for (int i = 0; i < 8; ++i) { a2[i] = (f32x2){0.f, 0.f}; b2[i] = (f32x2){0.f, 0.f}; }
#pragma unroll
    for (int h = 0; h < 4; ++h) { f32x16 aa = {}, ab = {};
#pragma unroll
        for (int ks = 0; ks < 4; ++ks) { const f16x8 qf = *(const LAS f16x8*)(qlds + (h * 4 + ks) * 1024);
            aa = __builtin_amdgcn_mfma_f32_32x32x16_f16(Ka.k[ks], qf, aa, 0, 0, 0); ab = __builtin_amdgcn_mfma_f32_32x32x16_f16(Kb.k[ks], qf, ab, 0, 0, 0); }
        relu_fma(aa, wv[h], a2); relu_fma(ab, wv[h], b2); }
#pragma unroll
    for (int i = 0; i < 8; ++i) { sa[2 * i] = a2[i].x; sa[2 * i + 1] = a2[i].y; sb[2 * i] = b2[i].x; sb[2 * i + 1] = b2[i].y; }
}
__device__ __forceinline__ void score_tile1(const KFrag& Ka, const LAS char* qlds, const f32x4 wv, f32x16& sa) {
    f32x2 a2[8];
#pragma unroll
    for (int i = 0; i < 8; ++i) a2[i] = (f32x2){0.f, 0.f};
#pragma unroll
    for (int h = 0; h < 4; ++h) { f32x16 aa = {};
#pragma unroll
        for (int ks = 0; ks < 4; ++ks) aa = __builtin_amdgcn_mfma_f32_32x32x16_f16(Ka.k[ks], *(const LAS f16x8*)(qlds + (h * 4 + ks) * 1024), aa, 0, 0, 0);
        relu_fma(aa, wv[h], a2); }
#pragma unroll
    for (int i = 0; i < 8; ++i) { sa[2 * i] = a2[i].x; sa[2 * i + 1] = a2[i].y; }
}
__device__ __forceinline__ unsigned skey22(float s) { unsigned u = __builtin_bit_cast(unsigned, s); u ^= (unsigned)((int)u >> 31) | 0x80000000u; return u >> 10; }

template <int PASS, bool CAUSAL>
__device__ __forceinline__ void hist_tile(const f32x16& sc, int kt, int q, int c, int hi, lhist_t hrow, unsigned pfx) {
#pragma unroll
    for (int r = 0; r < 16; ++r) { const unsigned k22 = skey22(sc[r]); unsigned bin, inc;
        if (PASS == 0) { bin = k22 >> 11; inc = 1u; } else { bin = k22 & 2047u; inc = (k22 >> 11) == pfx ? 1u : 0u; }
        if (CAUSAL) { const int s = 32 * kt + crow16(r, hi); inc = s <= q ? inc : 0u; }
        __hip_atomic_fetch_add(hrow + ((bin >> 1) ^ (unsigned)c), inc << ((bin & 1u) * 16u), __ATOMIC_RELAXED, __HIP_MEMORY_SCOPE_WORKGROUP);
        if ((r & 3) == 3) __builtin_amdgcn_sched_barrier(0); }
}
template <int PASS>
__device__ __forceinline__ void hist_pass(const GAS char* ws, int q0, int qb32, int wave, int c, int hi, const LAS char* qlds, const f32x4 wv, lhist_t hist, unsigned pfx) {
    const int q = q0 + c; lhist_t hrow = hist + c * 1024;
    KFrag Ka, Kb;
    if (wave < qb32) { load_k(ws, wave, c, hi, Ka); load_k(ws, wave + 8 < qb32 ? wave + 8 : wave, c, hi, Kb); }
#pragma unroll 1
    for (int kt = wave; kt < qb32; kt += 16) { const bool has2 = kt + 8 < qb32;
        f32x16 sa, sb; score_tile2(Ka, Kb, qlds, wv, sa, sb);
        { const int kn = kt + 16 < qb32 ? kt + 16 : kt, kn2 = kn + 8 < qb32 ? kn + 8 : kn; load_k(ws, kn, c, hi, Ka); load_k(ws, kn2, c, hi, Kb); }
        hist_tile<PASS, false>(sa, kt, q, c, hi, hrow, pfx);
        if (has2) hist_tile<PASS, false>(sb, kt + 8, q, c, hi, hrow, pfx); }
    if (wave == (qb32 & 7)) { load_k(ws, qb32, c, hi, Ka); f32x16 sa; score_tile1(Ka, qlds, wv, sa); hist_tile<PASS, true>(sa, qb32, q, c, hi, hrow, pfx); }
}
constexpr int LROW = 1025;
template <bool CAUSAL>
__device__ __forceinline__ void lhist_tile(const f32x16& sc, int kt, int q, int c, int hi, lhist_t hrow, float ka, float kc) {
#pragma unroll
    for (int r = 0; r < 16; ++r) { const int b = (int)__builtin_amdgcn_fmed3f(__builtin_fmaf(sc[r], ka, kc), 0.f, 1023.f); unsigned inc = 1u;
        if (CAUSAL) { const int s = 32 * kt + crow16(r, hi); inc = s <= q ? 1u : 0u; }
        __hip_atomic_fetch_add(hrow + b, inc, __ATOMIC_RELAXED, __HIP_MEMORY_SCOPE_WORKGROUP);
        if ((r & 3) == 3) __builtin_amdgcn_sched_barrier(0); }
}
__device__ __forceinline__ void lhist_pass(const GAS char* ws, int q0, int qb32, int wave, int c, int hi, const LAS char* qlds, const f32x4 wv, lhist_t hist, float ka, float kc, int step, bool diag) {
    const int q = q0 + c; lhist_t hrow = hist + c * LROW;
    KFrag Ka, Kb;
    if (wave < qb32) { load_k(ws, wave, c, hi, Ka); load_k(ws, wave + 8 < qb32 ? wave + 8 : wave, c, hi, Kb); }
#pragma unroll 1
    for (int kt = wave; kt < qb32; kt += step) { const bool has2 = kt + 8 < qb32;
        f32x16 sa, sb; score_tile2(Ka, Kb, qlds, wv, sa, sb);
        { const int kn = kt + step < qb32 ? kt + step : kt, kn2 = kn + 8 < qb32 ? kn + 8 : kn; load_k(ws, kn, c, hi, Ka); load_k(ws, kn2, c, hi, Kb); }
        lhist_tile<false>(sa, kt, q, c, hi, hrow, ka, kc);
        if (has2) lhist_tile<false>(sb, kt + 8, q, c, hi, hrow, ka, kc); }
    if (diag && wave == (qb32 & 7)) { load_k(ws, qb32, c, hi, Ka); f32x16 sa; score_tile1(Ka, qlds, wv, sa); lhist_tile<true>(sa, qb32, q, c, hi, hrow, ka, kc); }
}
__device__ __forceinline__ void lin_scan(const LAS unsigned* hrow, int cq, int lane, unsigned& sl_out, unsigned& T_out) {
    unsigned sl = 0;
#pragma unroll
    for (int j = 0; j < 16; ++j) sl += hrow[16 * lane + j];
    unsigned T = sl;
#pragma unroll
    for (int o = 1; o < 64; o <<= 1) { const unsigned v = __shfl_down(T, o); T += (lane + o < 64) ? v : 0u; }
    sl_out = sl; T_out = T;
}
__device__ __forceinline__ int lin_locate(const LAS unsigned* hrow, int cq, int lane, unsigned sl, unsigned T, unsigned need, unsigned& need_out, unsigned& cnt_out) {
    const unsigned long long bal = __ballot(T >= need);
    if (bal == 0ull) { need_out = need; cnt_out = 0u; return -1; }
    const int L = 63 - __builtin_clzll(bal);
    int bin = -1; unsigned nn = need, cb = 0u;
    if (lane == L) { unsigned cum = T - sl;
#pragma unroll 1
        for (int j = 15; j >= 0 && bin < 0; --j) { const unsigned w = hrow[16 * lane + j];
            if (cum + w >= need) { bin = 16 * lane + j; nn = need - cum; cb = w; } else cum += w; } }
    bin = __shfl(bin, L); nn = __shfl(nn, L); cb = __shfl(cb, L); need_out = nn; cnt_out = cb; return bin;
}
__device__ __forceinline__ f32x4 load_wv(const GAS char* ws, int q) {
    unsigned o = (unsigned)WS_WI + (unsigned)q * 16u; asm volatile("" : "+v"(o));
    const f32x4 w = *(const GAS f32x4*)(ws + o);
    const float sa = fmaxf((__builtin_fabsf(w[0]) + __builtin_fabsf(w[1])) + (__builtin_fabsf(w[2]) + __builtin_fabsf(w[3])), 1e-30f);
    const float sc = __uint_as_float(__float_as_uint(40.0f / sa) & 0x7f800000u);
    return w * sc;
}
__device__ __forceinline__ int select_bin(const LAS unsigned* hrow, int cq, int lane, unsigned need, unsigned& need_out) {
    unsigned sl = 0;
#pragma unroll
    for (int j = 0; j < 16; ++j) { const unsigned w = hrow[(16 * lane + j) ^ cq]; sl += (w & 0xffffu) + (w >> 16); }
    unsigned T = sl;
#pragma unroll
    for (int o = 1; o < 64; o <<= 1) { const unsigned v = __shfl_down(T, o); T += (lane + o < 64) ? v : 0u; }
    const unsigned long long bal = __ballot(T >= need);
    if (bal == 0ull) { need_out = need; return -1; }
    const int L = 63 - __builtin_clzll(bal);
    int bin = -1; unsigned nn = need;
    if (lane == L) { unsigned cum = T - sl;
#pragma unroll 1
        for (int j = 15; j >= 0 && bin < 0; --j) { const unsigned w = hrow[(16 * lane + j) ^ cq]; const unsigned chi = w >> 16, clo = w & 0xffffu;
            if (cum + chi >= need) { bin = 32 * lane + 2 * j + 1; nn = need - cum; } else { cum += chi;
                if (cum + clo >= need) { bin = 32 * lane + 2 * j; nn = need - cum; } else cum += clo; } } }
    bin = __shfl(bin, L); nn = __shfl(nn, L); need_out = nn; return bin;
}
__device__ __forceinline__ void item(const Frame& F, int qb32) {
    lhist_t hist = (lhist_t)(F.lds); LAS unsigned* sta = (LAS unsigned*)(F.lds + IDX_STATE); LAS unsigned* need = sta + 32;
    LAS unsigned* Gw = (LAS unsigned*)(F.lds); LAS unsigned* Tw = (LAS unsigned*)(F.lds + 65536);
    const GAS char* ws = (const GAS char*)F.ws;
    int lane_ = lane_id();
    int wave_ = F.wave; asm volatile("" : "+s"(wave_));
    const int lane = lane_, wave = wave_, tid = wave * 64 + lane, c = lane & 31, hi = lane >> 5, q0 = 32 * qb32, q = q0 + c;
    LAS char* qall = (LAS char*)(F.lds + IDX_STATE + 1024);
    const LAS char* qlds = qall + lane * 16;
    if (wave == 0) {
#pragma unroll
        for (int h = 0; h < 4; ++h)
#pragma unroll
            for (int ks = 0; ks < 4; ++ks) *(LAS f16x8*)(qall + (h * 4 + ks) * 1024 + lane * 16) = *(const GAS f16x8*)(ws + (unsigned)((unsigned)WS_QI + (unsigned)(q * 256 + 8 * hi) * 2u) + (h * 64 + 16 * ks) * 2); }
    LAS unsigned* lcnt = sta + 96; LAS unsigned* slowf = sta + 128;
    LAS unsigned* lists = (LAS unsigned*)(F.lds + IDX_STATE + 1024 + 16384);
    constexpr unsigned LCAP = 56;
    if (tid < 32) { sta[tid] = 0u; need[tid] = (unsigned)TOPK; lcnt[tid] = 0u; } if (tid >= 32 && tid < 35) slowf[tid - 32] = 0u;
    const bool sel_needed = q0 + 31 >= TOPK;
    bool fast = false;
    if (sel_needed) {
        LAS float* kaf = (LAS float*)(sta + 160); LAS float* kcf = (LAS float*)(sta + 192);
        #ifndef IDX_CBCAP
#define IDX_CBCAP LCAP
#endif
#ifndef IDX_FORCEZOOM
#define IDX_FORCEZOOM 0
#endif
#ifndef IDX_SMAX
#define IDX_SMAX 16
#endif
#ifndef IDX_BRK_A
#define IDX_BRK_A 3.5f
#define IDX_BRK_B 5.0f
#endif
        const int S_ = qb32 >> 4, pstep = 16 * (S_ < 1 ? 1 : (S_ > IDX_SMAX ? IDX_SMAX : S_));
        LAS float* kza = (LAS float*)(sta + 224); LAS float* kzc = (LAS float*)(sta + 64);
        int nlp = 2;
#pragma unroll 1
        for (int lp = 0; lp < nlp; ++lp) {
#pragma unroll
            for (int i = 0; i < 64; ++i) hist[tid + 512 * i] = 0u;
            if (tid < 32) hist[32768 + tid] = 0u;
            LDS_WAIT(); __syncthreads();
            { float ka_ = 1.0f, kc_ = 256.0f; if (lp >= 1) { ka_ = kaf[c]; kc_ = kcf[c]; }
              const f32x4 wv = load_wv(ws, q); lhist_pass(ws, q0, qb32, wave, c, hi, qlds, wv, hist, ka_, kc_, lp == 0 ? pstep : 16, lp >= 1); }
            LDS_WAIT(); __syncthreads();
#pragma unroll 1
            for (int i = 0; i < 4; ++i) { const int cq = 4 * wave + i; unsigned sl, T; lin_scan(hist + cq * LROW, cq, lane, sl, T);
                if (lp == 0) {
                    const unsigned total = (unsigned)__builtin_amdgcn_readfirstlane((int)T);
                    const float rmid = 256.0f * (float)total / (float)(q0 + cq + 1), sq = __builtin_sqrtf(rmid);
                    const float fa = __builtin_floorf(rmid - IDX_BRK_A * sq - 2.0f), fb = __builtin_ceilf(rmid + IDX_BRK_B * sq + 8.0f);
                    const unsigned ra = fa < 1.0f ? 1u : (unsigned)fa, rb = (unsigned)fb; unsigned n0, n1;
                    const int ba = lin_locate(hist + cq * LROW, cq, lane, sl, T, ra, n0, n1); int bb = lin_locate(hist + cq * LROW, cq, lane, sl, T, rb, n0, n1);
                    if (bb < 0) bb = 0;
                    if (lane == 0) { const float lo = (float)(bb - 256), hiw = (float)(ba - 255); const float ka_ = 1022.0f / (hiw - lo); kaf[cq] = ka_; kcf[cq] = 1.0f - lo * ka_; } }
                else { unsigned nn, cb; const int bin = lin_locate(hist + cq * LROW, cq, lane, sl, T, (unsigned)TOPK, nn, cb);
                    if (lane == 0) { sta[cq] = (unsigned)bin; need[cq] = nn;
                        const float kc0 = kcf[cq]; const int zb = (int)__builtin_floorf(__builtin_amdgcn_fmed3f(kc0, 0.f, 1023.f));
                        if (!(bin >= 1 && bin <= 1022)) __hip_atomic_fetch_or(slowf + (lp - 1), 1u, __ATOMIC_RELAXED, __HIP_MEMORY_SCOPE_WORKGROUP);
                        else if (!(bin == zb || cb <= IDX_CBCAP)) __hip_atomic_fetch_or(slowf + (lp - 1), lp == 1 ? 8u : 2u, __ATOMIC_RELAXED, __HIP_MEMORY_SCOPE_WORKGROUP);
                        if (lp == 1) { const float Z = 1022.0f / 3.0f; kza[cq] = kaf[cq] * Z; kzc[cq] = (kc0 - (float)(bin - 1)) * Z + 1.0f; } } } }
            LDS_WAIT(); __syncthreads();
            if (lp == 1) { const int f1 = __builtin_amdgcn_readfirstlane((int)slowf[0]);
                if (f1 == 8 || (IDX_FORCEZOOM && f1 == 0)) { nlp = 3; if (tid < 32) { kaf[tid] = kza[tid]; kcf[tid] = kzc[tid]; } } }
        }
        { const int f1 = __builtin_amdgcn_readfirstlane((int)slowf[0]), f2 = __builtin_amdgcn_readfirstlane((int)slowf[1]); fast = nlp == 2 ? f1 == 0 : f2 == 0; }
        if (fast) {
            const f32x4 wv = load_wv(ws, q);
            const float loT = (float)(int)sta[c], hiT = loT + 1.0f, ka_ = kaf[c], kc_ = kcf[c];
#define MASK_TILE_F(SC, KT, CAUSAL) do { unsigned gb = 0u, eb = 0u, tb = 0u; \
            _Pragma("unroll") for (int r = 15; r >= 0; --r) { const float u2_ = __builtin_fmaf(SC[r], ka_, kc_); \
                bool g_ = u2_ >= hiT, e_ = u2_ >= loT; if (CAUSAL) { const bool ok_ = 32 * (KT) + crow16(r, hi) <= q; g_ = g_ && ok_; e_ = e_ && ok_; } \
                gb = gb + gb + (g_ ? 1u : 0u); eb = eb + eb + (e_ ? 1u : 0u); \
                if ((r & 3) == 0) __builtin_amdgcn_sched_barrier(0); } \
            eb &= ~gb;                                              \
            if (eb != 0u) { \
                _Pragma("unroll") for (int r = 0; r < 16; ++r) if (eb & (1u << r)) { const float t_ = SC[r]; \
                    if (t_ == 0.f) tb |= 1u << ((r & 3) + 8 * (r >> 2)); \
                    else { const unsigned p_ = __hip_atomic_fetch_add(lcnt + c, 1u, __ATOMIC_RELAXED, __HIP_MEMORY_SCOPE_WORKGROUP); \
                           if (p_ < LCAP) { unsigned u_ = __float_as_uint(t_); u_ ^= (unsigned)((int)u_ >> 31) | 0x80000000u; \
                               *(LAS v2u*)(lists + 2 * (c * LCAP + p_)) = (v2u){16383u - (unsigned)(32 * (KT) + crow16(r, hi)), u_}; } } } } \
            gb = (gb | (gb << 8)) & 0x00ff00ffu; gb = (gb | (gb << 4)) & 0x0f0f0f0fu;     \
            gb <<= 4 * hi; tb <<= 4 * hi; gb |= (unsigned)__shfl_xor((int)gb, 32); tb |= (unsigned)__shfl_xor((int)tb, 32); \
            if (hi == 0) { Gw[c * 512 + (KT)] = gb; Tw[c * 512 + (KT)] = tb; } } while (0)
            KFrag Ka, Kb;
            if (wave < qb32) { load_k(ws, wave, c, hi, Ka); load_k(ws, wave + 8 < qb32 ? wave + 8 : wave, c, hi, Kb); }
#pragma unroll 1
            for (int kt = wave; kt < qb32; kt += 16) { const bool has2 = kt + 8 < qb32;
                f32x16 sa, sb; score_tile2(Ka, Kb, qlds, wv, sa, sb);
                { const int kn = kt + 16 < qb32 ? kt + 16 : kt, kn2 = kn + 8 < qb32 ? kn + 8 : kn; load_k(ws, kn, c, hi, Ka); load_k(ws, kn2, c, hi, Kb); }
                MASK_TILE_F(sa, kt, false);
                if (has2) MASK_TILE_F(sb, kt + 8, false); }
            if (wave == (qb32 & 7)) { load_k(ws, qb32, c, hi, Ka); f32x16 sa; score_tile1(Ka, qlds, wv, sa); MASK_TILE_F(sa, qb32, true); }
#undef MASK_TILE_F
            LDS_WAIT(); __syncthreads();
#pragma unroll 1
            for (int i = 0; i < 4; ++i) { const int cq = 4 * wave + i; const unsigned n = lcnt[cq], rk = need[cq];
                if (n > LCAP) { if (lane == 0) slowf[2] = 1u; }
                else { v2u e = (v2u){0u, 0u}; if (lane < (int)n) e = *(const LAS v2u*)(lists + 2 * (cq * LCAP + lane));
                    const unsigned long long ev = ((unsigned long long)e.y << 32) | e.x; unsigned above = 0u;
#pragma unroll 1
                    for (unsigned j = 0; j < n; ++j) { const unsigned long long ej = ((unsigned long long)(unsigned)__builtin_amdgcn_readlane((int)e.y, (int)j) << 32) | (unsigned)__builtin_amdgcn_readlane((int)e.x, (int)j);
                        above += ej > ev ? 1u : 0u; }
                    if (lane < (int)n && above < rk) { const unsigned sidx = 16383u - e.x;
                        __hip_atomic_fetch_or(Gw + cq * 512 + (sidx >> 5), 1u << (sidx & 31u), __ATOMIC_RELAXED, __HIP_MEMORY_SCOPE_WORKGROUP); }
                    if (lane == 0) need[cq] = rk > n ? rk - n : 0u; } }
            LDS_WAIT(); __syncthreads();
            fast = __builtin_amdgcn_readfirstlane((int)slowf[2]) == 0;
        }
    } else { LDS_WAIT(); __syncthreads(); }
#ifndef PROBE_IDXFB
#define PROBE_IDXFB 1
#endif
#ifndef PROBE_IDXFB_MASK
#define PROBE_IDXFB_MASK 7
#endif
    const int slow_reason = 7;
    if (!fast)
#pragma unroll 1
    for (int fbrep_ = 0, fbn_ = rep_count((sel_needed && (slow_reason & PROBE_IDXFB_MASK)) ? PROBE_IDXFB : 1); fbrep_ < fbn_; ++fbrep_) {
        __syncthreads();
        if (tid < 32) { sta[tid] = 0u; need[tid] = (unsigned)TOPK; }
        const f32x4 wv = load_wv(ws, q);
        const bool all = q < TOPK; lhist_t hrow = hist + c * 1024;
#pragma unroll 1
        for (int mode = sel_needed ? 0 : 2; mode < 3; ++mode) {
            if (mode < 2) {
#pragma unroll 1
                for (int i = 0; i < 64; ++i) hist[tid + 512 * i] = 0u; }
            LDS_WAIT(); __syncthreads();
            unsigned a = sta[c]; if (all) a = 0u;
#pragma unroll 1
            for (int kt = wave; kt <= qb32; kt += 8) { KFrag Ka; load_k(ws, kt, c, hi, Ka); f32x16 sa; score_tile1(Ka, qlds, wv, sa);
                unsigned gb = 0u, tb = 0u;
#pragma unroll
                for (int r = 15; r >= 0; --r) { const int c0 = (r & 3) + 8 * (r >> 2); const unsigned k22 = skey22(sa[r]); const bool ok = 32 * kt + c0 + 4 * hi <= q;
                    if (mode == 2) { gb = gb + gb + ((ok && (all || k22 > a)) ? 1u : 0u); tb = tb + tb + ((ok && !all && k22 == a) ? 1u : 0u); }
                    else { const unsigned bin = mode == 0 ? k22 >> 11 : k22 & 2047u; const unsigned inc = (ok && (mode == 0 || (k22 >> 11) == a)) ? 1u : 0u;
                        __hip_atomic_fetch_add(hrow + ((bin >> 1) ^ (unsigned)c), inc << ((bin & 1u) * 16u), __ATOMIC_RELAXED, __HIP_MEMORY_SCOPE_WORKGROUP); }
                    if ((r & 3) == 0) __builtin_amdgcn_sched_barrier(0); }
                if (mode == 2) { gb = (gb | (gb << 8)) & 0x00ff00ffu; gb = (gb | (gb << 4)) & 0x0f0f0f0fu; tb = (tb | (tb << 8)) & 0x00ff00ffu; tb = (tb | (tb << 4)) & 0x0f0f0f0fu;
                    gb <<= 4 * hi; tb <<= 4 * hi; gb |= (unsigned)__shfl_xor((int)gb, 32); tb |= (unsigned)__shfl_xor((int)tb, 32);
                    if (hi == 0) { Gw[c * 512 + kt] = gb; Tw[c * 512 + kt] = tb; } } }
            LDS_WAIT(); __syncthreads();
            if (mode < 2) {
#pragma unroll 1
                for (int i = 0; i < 4; ++i) { const int cq = 4 * wave + i; unsigned nn; const int bin = select_bin(hist + cq * 1024, cq, lane, need[cq], nn);
                    if (lane == 0 && bin >= 0) { sta[cq] = mode == 0 ? (unsigned)bin : ((sta[cq] << 11) | (unsigned)bin); need[cq] = nn; } }
                LDS_WAIT(); __syncthreads(); }
        }
    }
    LDS_WAIT(); __syncthreads();
    const int kt_end = 8 * (q0 / 256 + 1);
    GAS unsigned* MK = (GAS unsigned*)(F.ws + WS_MASK);
#pragma unroll 1
    for (int i = 0; i < 4; ++i) { const int cq = 4 * wave + i; const unsigned r = need[cq]; unsigned base = 0u;
#pragma unroll 1
        for (int k0 = 0; k0 < kt_end; k0 += 64) { const int kt = k0 + lane; const bool live = kt <= qb32;
            const unsigned g = live ? Gw[cq * 512 + kt] : 0u, t = live ? Tw[cq * 512 + kt] : 0u; const unsigned p = __builtin_popcount(t);
            unsigned C = p;
#pragma unroll
            for (int o = 1; o < 64; o <<= 1) { const unsigned v = __shfl_up(C, o); C += (lane >= o) ? v : 0u; }
            const unsigned before = base + C - p;
            unsigned keep = t;
            if (before >= r) keep = 0u;
            else if (before + p > r) { unsigned left = r - before, m = 0u, tt = t;
#pragma unroll 1
                while (left) { const unsigned lowbit = tt & (0u - tt); m |= lowbit; tt ^= lowbit; --left; }
                keep = m; }
            if (kt < kt_end) MK[((size_t)(kt >> 1) * HROWS + (q0 + cq)) * 2 + (kt & 1)] = g | keep;
            base += __shfl(C, 63); } }
    __syncthreads();
}
}

namespace att {
constexpr int D = 128, NW = 8, QBLK = 32, KVBLK = 64, QB = 256, STR = 768;
constexpr float SCALE = 0.08838834764831845f, THR = 8.f;
constexpr int SHM_V = KVBLK * D * 2, SHM_K = KVBLK * D * 2;
constexpr int ATT_LDS = 2 * SHM_V + 2 * SHM_K + NW * 64 * 4;
constexpr int BIAS_OFF = ATT_LDS;
constexpr int QL_OFF = ATT_LDS + 3200;
typedef short s16x4 __attribute__((ext_vector_type(4)));
typedef LAS char* lp_t;
#define KSWZ(row, colB) ((row) * 256 + ((colB) ^ (((row) & 7) << 4)))
#define SBAR() __builtin_amdgcn_sched_barrier(0)
__device__ __forceinline__ int v_st(int k, int c) { const int kk = (k & ~0xC) | ((k & 4) << 1) | ((k & 8) >> 1); return ((kk >> 3) * 4 + (c >> 5)) * 512 + ((kk & 7) * 32 + (c & 31)) * 2; }
__device__ __forceinline__ int v_rd_base(int lane) { return ((lane & 3) << 3) | (((lane >> 2) & 3) << 6) | (((lane >> 4) & 1) << 5) | (((lane >> 5) & 1) << 8); }
constexpr int v_rd_off(int d0, int ks, int half) { return d0 * 512 + ks * 4096 + half * 2048; }
__device__ __forceinline__ int crow(int r, int hi) { return (r & 3) + 8 * (r >> 2) + 4 * hi; }
__device__ __forceinline__ unsigned cvtpk(float lo, float hi) { unsigned r; asm volatile("v_cvt_pk_bf16_f32 %0, %1, %2" : "=v"(r) : "v"(lo), "v"(hi)); return r; }
__device__ __forceinline__ bf16x8 load8(const unsigned short* p) { return *reinterpret_cast<const bf16x8*>(p); }

__device__ __forceinline__ void partialSM(f32x16& p0, f32x16& p1, float& m_reg, float& mn, float& alpha) {
    float pmax = p0[0]; for (int r = 1; r < 16; ++r) pmax = fmaxf(pmax, p0[r]); for (int r = 0; r < 16; ++r) pmax = fmaxf(pmax, p1[r]);
    { auto rr = __builtin_amdgcn_permlane32_swap(__float_as_uint(pmax), __float_as_uint(pmax), false, false);
      pmax = fmaxf(__uint_as_float(rr[0]), __uint_as_float(rr[1])); }
    constexpr float C2 = 1.4426950408889634f * SCALE;
    if (__builtin_expect(__all((pmax - m_reg) * SCALE <= THR), 1)) { mn = m_reg; alpha = 1.f; }
    else { mn = fmaxf(m_reg, pmax); alpha = __builtin_amdgcn_exp2f((m_reg - mn) * C2); m_reg = mn; }
    const float mnL = -mn * C2;
    for (int r = 0; r < 16; ++r) p0[r] = fmaf(p0[r], C2, mnL); for (int r = 0; r < 16; ++r) p1[r] = fmaf(p1[r], C2, mnL);
    for (int r = 0; r < 16; ++r) p0[r] = __builtin_amdgcn_exp2f(p0[r]);
}
__device__ __forceinline__ void finishSM(f32x16& p0, f32x16& p1, float alpha, float& l_reg, bf16x8& pa0, bf16x8& pa1, bf16x8& pa2, bf16x8& pa3) {
    for (int r = 0; r < 16; ++r) p1[r] = __builtin_amdgcn_exp2f(p1[r]);
    float ps = 0; for (int r = 0; r < 16; ++r) ps += p0[r]; for (int r = 0; r < 16; ++r) ps += p1[r];
    { auto rr = __builtin_amdgcn_permlane32_swap(__float_as_uint(ps), __float_as_uint(ps), false, false);
      ps = __uint_as_float(rr[0]) + __uint_as_float(rr[1]); }
    l_reg = l_reg * alpha + ps;
#define PK4(P, B_, OUT) do { unsigned a0 = cvtpk(P[B_+0], P[B_+1]), a1 = cvtpk(P[B_+2], P[B_+3]);                          \
        unsigned b0 = cvtpk(P[B_+4], P[B_+5]), b1 = cvtpk(P[B_+6], P[B_+7]);                                             \
        auto r0 = __builtin_amdgcn_permlane32_swap(a0, b0, false, false); auto r1 = __builtin_amdgcn_permlane32_swap(a1, b1, false, false); \
        v4u w = {r0[0], r1[0], r0[1], r1[1]}; OUT = *reinterpret_cast<bf16x8*>(&w); } while (0)
    PK4(p0, 0, pa0); PK4(p0, 8, pa1); PK4(p1, 0, pa2); PK4(p1, 8, pa3);
#undef PK4
}
template <int KB>
__device__ __forceinline__ void qkt(f32x16& p0, f32x16& p1, const LAS char* K_lds, int r32, int hi, const bf16x8* qr) {
    p0 = f32x16{}; p1 = f32x16{};
    const LAS char* kb[4];
#pragma unroll
    for (int dd = 0; dd < 4; ++dd) kb[dd] = K_lds + KB * SHM_K + KSWZ(r32, (dd * 16 + hi * 8) * 2);
#pragma unroll
    for (int d0 = 0; d0 < 8; ++d0) { const LAS char* a = kb[d0 & 3] + (d0 >> 2) * 128;
        bf16x8 b0 = *reinterpret_cast<const LAS bf16x8*>(a);
        bf16x8 b1 = *reinterpret_cast<const LAS bf16x8*>(a + 32 * 256);
        p0 = __builtin_amdgcn_mfma_f32_32x32x16_bf16(b0, qr[d0], p0, 0, 0, 0);
        p1 = __builtin_amdgcn_mfma_f32_32x32x16_bf16(b1, qr[d0], p1, 0, 0, 0); }
}
template <int VB>
__device__ __forceinline__ void pv_tile(f32x16* o, int vb0, bf16x8 pa0, bf16x8 pa1, bf16x8 pa2, bf16x8 pa3) {
#define TRRD(dst, off) asm volatile("ds_read_b64_tr_b16 %0, %1 offset:%2" : "=&v"(dst) : "v"(vb0), "i"(off) : "memory")
#define PV_D0(d0) do { s16x4 l0, l1, l2, l3, h0, h1, h2, h3; constexpr int b_ = VB * SHM_V + v_rd_off(d0, 0, 0); \
        TRRD(l0, b_); TRRD(h0, b_ + 2048); TRRD(l1, b_ + 4096); TRRD(h1, b_ + 6144); TRRD(l2, b_ + 8192); TRRD(h2, b_ + 10240); TRRD(l3, b_ + 12288); TRRD(h3, b_ + 14336); \
        asm volatile("s_waitcnt lgkmcnt(0)" ::: "memory"); SBAR();   \
        o[d0] = __builtin_amdgcn_mfma_f32_32x32x16_bf16(pa0, (bf16x8){l0[0], l0[1], l0[2], l0[3], h0[0], h0[1], h0[2], h0[3]}, o[d0], 0, 0, 0);   \
        o[d0] = __builtin_amdgcn_mfma_f32_32x32x16_bf16(pa1, (bf16x8){l1[0], l1[1], l1[2], l1[3], h1[0], h1[1], h1[2], h1[3]}, o[d0], 0, 0, 0);   \
        o[d0] = __builtin_amdgcn_mfma_f32_32x32x16_bf16(pa2, (bf16x8){l2[0], l2[1], l2[2], l2[3], h2[0], h2[1], h2[2], h2[3]}, o[d0], 0, 0, 0);   \
        o[d0] = __builtin_amdgcn_mfma_f32_32x32x16_bf16(pa3, (bf16x8){l3[0], l3[1], l3[2], l3[3], h3[0], h3[1], h3[2], h3[3]}, o[d0], 0, 0, 0); } while (0)
    PV_D0(0); PV_D0(1); PV_D0(2); PV_D0(3);
#undef PV_D0
#undef TRRD
}
__device__ __forceinline__ void apply_mask(f32x16& p0, f32x16& p1, v2u mw, int hi) {
    const int m0 = (int)(mw.x >> (4 * hi)), m1 = (int)(mw.y >> (4 * hi)); const unsigned NEG = 0xff800000u;
#pragma unroll
    for (int r = 0; r < 16; ++r) { const int c = (r & 3) + 8 * (r >> 2);
        const unsigned a0 = (unsigned)((m0 << (31 - c)) >> 31), a1 = (unsigned)((m1 << (31 - c)) >> 31);
        p0[r] = __uint_as_float((__float_as_uint(p0[r]) & a0) | (NEG & ~a0)); p1[r] = __uint_as_float((__float_as_uint(p1[r]) & a1) | (NEG & ~a1)); }
}
__device__ __forceinline__ void bias_tile(f32x16& p0, f32x16& p1, const GAS char* ws, unsigned pko  , int pq, const LAS float* bT, int hi) {
    const unsigned ho = pko + (unsigned)hi * 16u;
#pragma unroll
    for (int r = 0; r < 16; ++r) { const int c = (r & 3) + 8 * (r >> 2);
        int d0 = pq - *(const GAS int*)(ws + (unsigned)(ho + c * 4)); d0 = d0 < 0 ? 0 : (d0 > 128 ? 128 : d0); p0[r] += bT[d0];
        int d1 = pq - *(const GAS int*)(ws + (unsigned)(ho + (c + 32) * 4)); d1 = d1 < 0 ? 0 : (d1 > 128 ? 128 : d1); p1[r] += bT[d1];
        if ((r & 3) == 3) asm volatile("" ::: "memory"); }
}
struct BlockRef { int P0, h, t0, nt, pidx; };
struct Seam { bf16x8 qr[8]; bf16x8 st_v0, st_v1, st_k0, st_k1; };
typedef const GAS char* gp_t;
#define VMW() asm volatile("s_waitcnt vmcnt(0)" ::: "memory")
#define LD8W(off) (*reinterpret_cast<const GAS bf16x8*>(ws + (unsigned)(off)))
#define SLOAD_H(ko_, k0) do { const unsigned so0_ = so0, so1_ = so1; \
        const unsigned t_ = (unsigned)(k0) * (STR * 2u) + (ko_); \
        S.st_v0 = LD8W(t_ + (unsigned)(WS_VA - WS_KA) + so0_); S.st_v1 = LD8W(t_ + (unsigned)(WS_VA - WS_KA) + so1_); S.st_k0 = LD8W(t_ + so0_); S.st_k1 = LD8W(t_ + so1_); } while (0)
#define SWRITE_HK(bf) do { const int kws_ = kws; \
        *(LAS bf16x8*)(K_lds + (bf) * SHM_K + kws_) = S.st_k0; *(LAS bf16x8*)(K_lds + (bf) * SHM_K + kws_ + 32 * 256) = S.st_k1; } while (0)
#define SWRITE_HV(bf) do { const int vs0_ = vst0, vs1_ = vst1; \
        *(LAS bf16x8*)(V_lds + (bf) * SHM_V + vs0_) = S.st_v0; *(LAS bf16x8*)(V_lds + (bf) * SHM_V + vs1_) = S.st_v1; } while (0)
#define SWRITE_H(bf) do { SWRITE_HV(bf); SWRITE_HK(bf); } while (0)
__device__ __forceinline__ unsigned q_off(const BlockRef& r) { return (unsigned)WS_QA + (unsigned)(r.P0 * STR + r.h * 128) * 2u; }
__device__ __forceinline__ unsigned k_off(const BlockRef& r) { return (unsigned)WS_KA + (unsigned)(r.h * 128) * 2u; }
__device__ __forceinline__ void prime(const BlockRef& cur, gp_t ws, lp_t lds, Seam& S, int tid) {
    const int wid = __builtin_amdgcn_readfirstlane(tid >> 6), lane = tid & 63, r32 = lane & 31, hi = lane >> 5;
    lp_t K_lds = lds + 2 * SHM_V;
    const unsigned qo = (unsigned)((wid * QBLK + r32) * STR + hi * 8) * 2u;
    const unsigned so0 = (unsigned)((tid >> 4) * STR + (tid & 15) * 8) * 2u, so1 = so0 + 32u * STR * 2u; const int kws = KSWZ(tid >> 4, (tid & 15) * 16);
    const unsigned qb_ = q_off(cur) + qo, ko_ = k_off(cur);
#pragma unroll
    for (int d0 = 0; d0 < 8; ++d0) S.qr[d0] = LD8W(qb_ + d0 * 32);
    SLOAD_H(ko_, cur.t0 * KVBLK); VMW(); SWRITE_HK(0);
    __syncthreads();
}
__device__ __forceinline__ void block(const BlockRef& cur, const BlockRef& nxt, gp_t ws, lp_t lds, Seam& S, int b, int tid) {
    const int wid = __builtin_amdgcn_readfirstlane(tid >> 6), lane = tid & 63, r32 = lane & 31, hi = lane >> 5;
    const int NT = cur.nt, T0 = cur.t0, NTA = cur.P0 / KVBLK + QB / KVBLK;
    const int qrow = cur.P0 + wid * QBLK + r32;
    lp_t V_lds = lds; lp_t K_lds = lds + 2 * SHM_V;
    LAS float* wsf = (LAS float*)(lds + 2 * SHM_V + 2 * SHM_K) + wid * 64; LAS float* li_l = wsf; LAS float* al_l = wsf + 32;
    const LAS float* bT = (const LAS float*)(lds + BIAS_OFF) + cur.h * 132;
    float m_reg = -1e30f, l_reg = 0; f32x16 o[4]; o[0] = zero16(); o[1] = zero16(); o[2] = zero16(); o[3] = zero16();
    const int vb0 = (int)(unsigned)(uintptr_t)V_lds + v_rd_base(lane);
    const unsigned so0 = (unsigned)((tid >> 4) * STR + (tid & 15) * 8) * 2u, so1 = so0 + 32u * STR * 2u; const int kws = KSWZ(tid >> 4, (tid & 15) * 16), vst0 = v_st(tid >> 4, (tid & 15) * 8), vst1 = v_st(32 + (tid >> 4), (tid & 15) * 8);
    const unsigned ko_ = k_off(cur);
    const unsigned pbo = (unsigned)WS_POS + (unsigned)b * (SEQ * 4u);
    const int pq = *(const GAS int*)(ws + (unsigned)(pbo + (unsigned)qrow * 4u));
    const int qmin = *(const GAS int*)(ws + (unsigned)((unsigned)WS_KMAX + (unsigned)(1024 + b * 512 + (cur.P0 >> 5) + wid) * 4u));
    const unsigned mo = (unsigned)WS_MASK + (unsigned)qrow * 8u;
    int nearfirst = NTA;
    { const unsigned kmo = (unsigned)WS_KMAX + (unsigned)b * 1024u;
#pragma unroll 1
      for (int t0 = 0; t0 < NTA; t0 += 64) { const int t_ = t0 + lane; const int km = *(const GAS int*)(ws + (unsigned)(kmo + (unsigned)(t_ < NTA ? t_ : NTA - 1) * 4u));
          const unsigned long long bal = __ballot(t_ < NTA && qmin - km < 128);
          if (bal) { nearfirst = t0 + (int)__builtin_ctzll(bal); break; } } }
#define MLOAD(t) (*(const GAS v2u*)(ws + (unsigned)((unsigned)(T0 + (t)) * (HROWS * 8u) + mo)))
#define RESC(a) do { if (__any((a) < 1.f)) { if (hi == 0) al_l[r32] = (a); asm volatile("s_waitcnt lgkmcnt(0)" ::: "memory");              \
                     for (int d_ = 0; d_ < 4; ++d_) for (int r = 0; r < 16; ++r) o[d_][r] *= al_l[crow(r, hi)]; } } while (0)
#define KBASE(t) ((T0 + (t)) * KVBLK)
#define MASKT(P0_, P1_, t, MW) do { if (T0 + (t) >= nearfirst) bias_tile(P0_, P1_, ws, pbo + (unsigned)KBASE(t) * 4u, pq, bT, hi); apply_mask(P0_, P1_, MW, hi); } while (0)
    f32x16 pA0, pA1, pB0, pB1; float mnA, mnB, alA, alB; bf16x8 pa0, pa1, pa2, pa3;
    v2u mwc = MLOAD(0);
    SWRITE_HV(0); SBAR();
    if (NT > 1) { SLOAD_H(ko_, KBASE(1)); }
    SBAR(); qkt<0>(pA0, pA1, K_lds, r32, hi, S.qr);
    MASKT(pA0, pA1, 0, mwc); partialSM(pA0, pA1, m_reg, mnA, alA);
    if (NT > 1) { VMW(); SWRITE_H(1); }
    __syncthreads();
#define HALF_STEP(PX0, PX1, mnX, alX, PY0, PY1, alY, t, KB, VB, SB) do {                                                      \
        mwc = MLOAD(t);                                                                                                        \
        SBAR(); qkt<KB>(PX0, PX1, K_lds, r32, hi, S.qr);                                                                      \
        finishSM(PY0, PY1, alY, l_reg, pa0, pa1, pa2, pa3); SBAR();                                                           \
        if ((t) + 1 < NT) { SLOAD_H(ko_, KBASE((t) + 1)); SBAR(); }                                                           \
        pv_tile<VB>(o, vb0, pa0, pa1, pa2, pa3); MASKT(PX0, PX1, (t), mwc); partialSM(PX0, PX1, m_reg, mnX, alX);             \
        __syncthreads();                                                                                                      \
        if ((t) + 1 < NT) { VMW(); SWRITE_H(SB); }                                                                            \
        RESC(alX); __syncthreads(); } while (0)
#pragma unroll 1
    for (int t = 1; t + 1 < NT; t += 2) {
        HALF_STEP(pB0, pB1, mnB, alB, pA0, pA1, alA, t, 1, 0, 0);
        HALF_STEP(pA0, pA1, mnA, alA, pB0, pB1, alB, t + 1, 0, 1, 1);
    }
    mwc = MLOAD(NT - 1);
    SBAR(); qkt<1>(pB0, pB1, K_lds, r32, hi, S.qr); SBAR();
    { const unsigned kn_ = k_off(nxt); SLOAD_H(kn_, nxt.t0 * KVBLK); } SBAR();
    int lane_t = lane; asm volatile("" : "+v"(lane_t));
    { const unsigned qn_ = q_off(nxt) + (unsigned)((wid * QBLK + (lane_t & 31)) * STR + (lane_t >> 5) * 8) * 2u;
#pragma unroll
      for (int d0 = 0; d0 < 8; ++d0) S.qr[d0] = LD8W(qn_ + d0 * 32); }
    SBAR();
    finishSM(pA0, pA1, alA, l_reg, pa0, pa1, pa2, pa3); SBAR();
    pv_tile<0>(o, vb0, pa0, pa1, pa2, pa3);
    MASKT(pB0, pB1, NT - 1, mwc); partialSM(pB0, pB1, m_reg, mnB, alB); __syncthreads(); RESC(alB);
    finishSM(pB0, pB1, alB, l_reg, pa0, pa1, pa2, pa3); SBAR(); pv_tile<1>(o, vb0, pa0, pa1, pa2, pa3);
    SBAR(); VMW(); SWRITE_HK(0); SBAR();
    if (cur.pidx >= 0) {
        const unsigned po = (unsigned)WS_APART + (unsigned)cur.pidx * (QB * 128u * 4u) + (unsigned)((wid * QBLK + 4 * (lane_t >> 5)) * 128 + (lane_t & 31)) * 4u;
#pragma unroll
        for (int r = 0; r < 16; ++r) { const int orc = (r & 3) + 8 * (r >> 2);
#pragma unroll
            for (int d0 = 0; d0 < 4; ++d0) *(GAS float*)((GAS char*)ws + (unsigned)(po + (unsigned)(orc * 128 + d0 * 32) * 4u)) = o[d0][r]; }
        if ((lane_t >> 5) == 0) { typedef float f2_t __attribute__((ext_vector_type(2)));
            *(GAS f2_t*)((GAS char*)ws + (unsigned)((unsigned)WS_AML + (unsigned)(cur.pidx * QB + wid * QBLK + (lane_t & 31)) * 8u)) = (f2_t){m_reg, l_reg}; }
    } else {
    if (hi == 0) li_l[r32] = l_reg; asm volatile("s_waitcnt lgkmcnt(0)" ::: "memory");
    float rli[16];
#pragma unroll
    for (int r = 0; r < 16; ++r) rli[r] = __builtin_amdgcn_rcpf(li_l[crow(r, hi)]);
    const unsigned oo = (unsigned)WS_OBR + (unsigned)HROWS * 768u * 2u + (unsigned)((cur.P0 + wid * QBLK + 4 * (lane_t >> 5)) * STR + cur.h * 128 + (lane_t & 31)) * 2u;
#pragma unroll
    for (int r = 0; r < 16; ++r) { const int orc = (r & 3) + 8 * (r >> 2);
#pragma unroll
        for (int d0 = 0; d0 < 4; ++d0) { const float v = o[d0][r] * rli[r];
            const float vn = __uint_as_float((unsigned)__builtin_amdgcn_update_dpp(0, (int)__float_as_uint(v), 0xB1, 0xF, 0xF, false));
            if ((r32 & 1) == 0) *(GAS unsigned*)((GAS char*)ws + (unsigned)(oo + (unsigned)(orc * STR + d0 * 32) * 2u)) = cvtpk(v, vn); } }
    }
    __syncthreads();
#undef MLOAD
#undef RESC
#undef KBASE
#undef MASKT
#undef HALF_STEP
}
#undef LD8W
#undef VMW
#undef SLOAD_H
#undef SWRITE_HK
#undef SWRITE_HV
#undef SWRITE_H
}

constexpr int ATT_NIT = 480, ATT_QSPLIT = 48;
__device__ __forceinline__ att::BlockRef att_ref(int i) { att::BlockRef r; int qb, h, part = -1;
    if (i < 96) { qb = 47 - i / 6; h = i % 6; }
    else if (i < 336) { const int j = i - 96, p = j / 30, q = j % 30;
        if (q < 12) { qb = 63 - 2 * p; part = q / 6; h = q % 6; } else if (q < 18) { qb = 31 - p; h = q - 12; } else { qb = 62 - 2 * p; part = (q - 18) / 6; h = (q - 18) % 6; } }
    else { const int j = i - 336; qb = 23 - j / 6; h = j % 6; }
    r.P0 = qb * 256; r.h = h; const int nta = 4 * (qb + 1);
    if (part < 0) { r.t0 = 0; r.nt = nta; r.pidx = -1; } else { r.t0 = part * (nta / 2); r.nt = nta / 2; r.pidx = ((qb - ATT_QSPLIT) * 6 + h) * 2 + part; }
    return r; }
__device__ __forceinline__ int att_item(int k, int G, int c) { return (k & 1) ? (k + 1) * G - 1 - c : k * G + c; }
__device__ __forceinline__ int att_head_item(int h, int j) {
    if (j < 16) return 6 * j + h;
    if (j < 56) { const int jj = j - 16, p = jj / 5, q5 = jj % 5; const int q = q5 == 0 ? h : q5 == 1 ? 6 + h : q5 == 2 ? 12 + h : q5 == 3 ? 18 + h : 24 + h; return 96 + 30 * p + q; }
    return 336 + 6 * (j - 56) + h;
}
__device__ __forceinline__ int att_xcd_item(int x, int n) { const int g = 3 * x + n % 3, h = g >> 2, j = (g & 3) + 4 * (n / 3); return att_head_item(h, j); }
__device__ __forceinline__ void p_attn(Frame& F0, int b) {
    Frame F = F0; GAS unsigned char* wsg_ = (GAS unsigned char*)F.ws; F.tid = F.wave * 64 + lane_id(); asm volatile("" : "+v"(F.tid), "+s"(wsg_), "+s"(F.vcu), "+s"(F.G)); F.lane = F.tid & 63;
    att::gp_t ws = (att::gp_t)wsg_;
    att::lp_t lds = (att::lp_t)F.lds;
    { LAS float* bT = (LAS float*)(lds + att::BIAS_OFF);
        for (int i = F.tid; i < 6 * 129; i += NTHR) { const int h = i / 129, d = i % 129;
            const int bk = d < 16 ? d : 16 + (d >= 19) + (d >= 21) + (d >= 24) + (d >= 27) + (d >= 31) + (d >= 35) + (d >= 40) + (d >= 46) + (d >= 52) + (d >= 59) + (d >= 67) + (d >= 77) + (d >= 87) + (d >= 99) + (d >= 113);
            bT[h * 132 + d] = (F.rel[bk * 6 + h] - F.rel[31 * 6 + h]) * (1.0f / att::SCALE); } }
    LDS_WAIT(); __syncthreads();
    const bool xcd = F.G == 256; const int x = F.vcu >> 5, rk = F.vcu & 31;
    int k = 0, i = xcd ? att_xcd_item(x, rk) : att_item(0, F.G, F.vcu);
    if (i >= ATT_NIT) return;
    att::BlockRef cur = att_ref(i); att::Seam S;
    att::prime(cur, ws, lds, S, F.tid);
#pragma unroll 1
    for (;;) { int in;
        if (xcd) in = (k == 0 && 63 - rk < 60) ? att_xcd_item(x, 63 - rk) : ATT_NIT; else in = att_item(k + 1, F.G, F.vcu);
        const bool last = in >= ATT_NIT;
        const att::BlockRef nxt = last ? cur : att_ref(in);
        att::block(cur, nxt, ws, lds, S, b, F.tid);
        if (last) break;
        cur = nxt; ++k; }
}
__device__ __forceinline__ void p_attn_combine(Frame& F0) {
    Frame F = F0; { GAS unsigned char* wsg_ = (GAS unsigned char*)F.ws; F.tid = F.wave * 64 + lane_id(); asm volatile("" : "+v"(F.tid), "+s"(wsg_), "+s"(F.vcu), "+s"(F.G)); F.lane = F.tid & 63; F.ws = (unsigned char*)wsg_; }
    typedef float f2_t __attribute__((ext_vector_type(2)));
    const float* AP = (const float*)(F.ws + WS_APART); const f2_t* ML = (const f2_t*)(F.ws + WS_AML); bf16* OA = (bf16*)(F.ws + WS_OBR) + (size_t)HROWS * 768;
    constexpr float C2 = 1.4426950408889634f * att::SCALE;
    const int total = 96 * 256 * 16;
#pragma unroll 1
    for (int i = F.vcu * NTHR + F.tid; i < total; i += F.G * NTHR) { const int c8 = (i & 15) * 8, row = (i >> 4) & 255, blk = i >> 12;
        const f2_t a = ML[(size_t)(2 * blk) * 256 + row], bq = ML[(size_t)(2 * blk + 1) * 256 + row];
        const float m = fmaxf(a.x, bq.x), f0 = __builtin_amdgcn_exp2f((a.x - m) * C2), f1 = __builtin_amdgcn_exp2f((bq.x - m) * C2), inv = 1.0f / (a.y * f0 + bq.y * f1);
        const f32x4* p0 = (const f32x4*)(AP + ((size_t)(2 * blk) * 256 + row) * 128 + c8); const f32x4* p1 = (const f32x4*)(AP + ((size_t)(2 * blk + 1) * 256 + row) * 128 + c8);
        const f32x4 x0 = (p0[0] * f0 + p1[0] * f1) * inv, x1 = (p0[1] * f0 + p1[1] * f1) * inv;
        const int qb = ATT_QSPLIT + blk / 6, h = blk % 6;
        *(v4u*)(OA + (size_t)(qb * 256 + row) * 768 + h * 128 + c8) = pack8bf(x0, x1); }
}

constexpr int PT128 = 136, PT64 = 72;
#define MFMA16(a, b, c) __builtin_amdgcn_mfma_f32_16x16x32_bf16((a), (b), (c), 0, 0, 0)
__device__ __forceinline__ bf16x8 ldsfrag(const LAS unsigned short* base, int row, int pitch, int k) { return *(const LAS bf16x8*)(base + row * pitch + k); }
__device__ __forceinline__ float log2_gamma(int h) {
    const float x = __builtin_amdgcn_exp2f(-5.0f - (float)h);
    return -x * (1.0f + x * (0.5f + x * (0.33333334f + x * (0.25f + x * (0.2f + x * 0.16666667f))))) * 1.4426950408889634f;
}
__device__ __forceinline__ void unpack8(const v4u w, float (&f)[8]) { f[0] = bflo(w.x); f[1] = bfhi(w.x); f[2] = bflo(w.y); f[3] = bfhi(w.y); f[4] = bflo(w.z); f[5] = bfhi(w.z); f[6] = bflo(w.w); f[7] = bfhi(w.w); }
__device__ __forceinline__ v4u pack8f(const float (&f)[8]) { v4u w; w.x = pk2(f[0], f[1]); w.y = pk2(f[2], f[3]); w.z = pk2(f[4], f[5]); w.w = pk2(f[6], f[7]); return w; }

__device__ __forceinline__ void mix_sg_item(const Frame& F, const float* sgn, const float* sgw, const float* sgb, int n, int g) {
    LAS unsigned short* Wm = (LAS unsigned short*)(F.lds);
    LAS unsigned short* vnT = (LAS unsigned short*)(F.lds + 34816);
    LAS unsigned short* strip = (LAS unsigned short*)(F.lds + 69632) + F.wave * (16 * PT128);
    LAS float* rs = (LAS float*)(F.lds + 104448);
    const bf16* VS = (const bf16*)(F.ws + WS_VS); const bf16* US = (const bf16*)(F.ws + WS_US); bf16* OS = (bf16*)(F.ws + WS_OBR) + (size_t)2 * HROWS * 768;
    int lane_ = lane_id();
    const int r0 = n * 128, lane = lane_, w = F.wave, tid = w * 64 + lane, fr = lane & 15, fq = lane >> 4;
#pragma unroll 4
    for (int i = 0; i < 16; ++i) { const int t = w * 16 + i; const v4u x = *(const v4u*)(VS + (size_t)(r0 + t) * 512 + lane * 8); float f[8]; unpack8(x, f); float ss = 0.f;
#pragma unroll
        for (int j = 0; j < 8; ++j) ss += f[j] * f[j];
        ss = wave_sum(ss); if (lane == 0) rs[t] = 1.0f / sqrtf(ss * (1.0f / 512.0f) + EPS); }
    { const int t = tid >> 2, s0 = (tid & 3) * 32; const float* wr = sgw + ((size_t)g * 128 + t) * 128 + s0;
#pragma unroll
        for (int q = 0; q < 4; ++q) { const f32x4 a = *(const f32x4*)(wr + 8 * q), b = *(const f32x4*)(wr + 8 * q + 4); float f[8] = {a[0], a[1], a[2], a[3], b[0], b[1], b[2], b[3]};
#pragma unroll
            for (int j = 0; j < 8; ++j) f[j] = (s0 + 8 * q + j <= t) ? f[j] : 0.f;
            *(LAS v4u*)(Wm + t * PT128 + s0 + 8 * q) = pack8f(f); } }
    LDS_WAIT(); __syncthreads();
    { const int s = tid >> 2, d0 = (tid & 3) * 32; const float r = rs[s];
#pragma unroll
        for (int q = 0; q < 4; ++q) { const v4u x = *(const v4u*)(VS + (size_t)(r0 + s) * 512 + g * 128 + d0 + 8 * q); float f[8]; unpack8(x, f);
            const f32x4 ga = *(const f32x4*)(sgn + g * 128 + d0 + 8 * q), gb = *(const f32x4*)(sgn + g * 128 + d0 + 8 * q + 4); const float gg[8] = {ga[0], ga[1], ga[2], ga[3], gb[0], gb[1], gb[2], gb[3]};
#pragma unroll
            for (int j = 0; j < 8; ++j) vnT[(d0 + 8 * q + j) * PT128 + s] = (unsigned short)f2bf(f[j] * r * gg[j]); } }
    LDS_WAIT(); __syncthreads();
    f32x4 acc[8];
#pragma unroll
    for (int cb = 0; cb < 8; ++cb) acc[cb] = zero4();
    const int nks = (16 * w + 15) / 32 + 1;
#pragma unroll 1
    for (int ks = 0; ks < nks; ++ks) { const bf16x8 a = ldsfrag(Wm, 16 * w + fr, PT128, 32 * ks + 8 * fq);
#pragma unroll
        for (int cb = 0; cb < 8; ++cb) acc[cb] = MFMA16(a, ldsfrag(vnT, 16 * cb + fr, PT128, 32 * ks + 8 * fq), acc[cb]); }
#pragma unroll
    for (int reg = 0; reg < 4; ++reg) { const int tl = 4 * fq + reg; const float bias = sgb[g * 128 + 16 * w + tl];
#pragma unroll
        for (int cb = 0; cb < 8; ++cb) strip[tl * PT128 + 16 * cb + fr] = (unsigned short)f2bf(acc[cb][reg] + bias); }
    LDS_WAIT(); asm volatile("" ::: "memory");
#pragma unroll
    for (int i = 0; i < 4; ++i) { const int c = lane + 64 * i, row = c >> 4, col = (c & 15) * 8; const size_t r = (size_t)(r0 + 16 * w + row);
        const v4u m = *(const LAS v4u*)(strip + row * PT128 + col); const v4u u = *(const v4u*)(US + r * 512 + g * 128 + col); float fm[8], fu[8]; unpack8(m, fm); unpack8(u, fu);
#pragma unroll
        for (int j = 0; j < 8; ++j) fm[j] *= fu[j];
        *(v4u*)(OS + r * 768 + g * 128 + col) = pack8f(fm); }
    { const int i0 = tid * 2;
#pragma unroll
        for (int i = i0; i < i0 + 2; ++i) { const int row = i >> 3, c8 = (i & 7) * 8; *(v4u*)(OS + (size_t)(r0 + row) * 768 + 512 + g * 64 + c8) = zero4u(); } }
    __syncthreads();
}
__device__ __forceinline__ void mix_r1_item(const Frame& F, int h, int n) {
    LAS unsigned short* VT = (LAS unsigned short*)(F.lds);
    LAS unsigned short* KdT = (LAS unsigned short*)(F.lds + 34816);
    const bf16* QKR = (const bf16*)(F.ws + WS_QKR); const bf16* VR = (const bf16*)(F.ws + WS_VR); float* KV = (float*)(F.ws + WS_KVST) + ((size_t)h * 128 + n) * 8192;
    int lane_ = lane_id();
    const int r0 = n * 128, lane = lane_, w = F.wave, tid = w * 64 + lane, fr = lane & 15, fq = lane >> 4; const float lg2 = log2_gamma(h);
    { const int s = tid >> 2, v0 = (tid & 3) * 32;
#pragma unroll
        for (int q = 0; q < 4; ++q) { const v4u x = *(const v4u*)(VR + (size_t)(r0 + s) * 768 + h * 128 + v0 + 8 * q);
            const unsigned xs[4] = {x.x, x.y, x.z, x.w};
#pragma unroll
            for (int j = 0; j < 4; ++j) { VT[(v0 + 8 * q + 2 * j) * PT128 + s] = (unsigned short)(xs[j] & 0xffffu); VT[(v0 + 8 * q + 2 * j + 1) * PT128 + s] = (unsigned short)(xs[j] >> 16); } } }
    { const int s = tid >> 2, d0 = (tid & 3) * 16; const float dec = __builtin_amdgcn_exp2f((float)(127 - s) * lg2);
#pragma unroll
        for (int q = 0; q < 2; ++q) { const v4u x = *(const v4u*)(QKR + (size_t)(r0 + s) * 768 + 384 + h * 64 + d0 + 8 * q); float f[8]; unpack8(x, f);
#pragma unroll
            for (int j = 0; j < 8; ++j) KdT[(d0 + 8 * q + j) * PT128 + s] = (unsigned short)f2bf(f[j] * dec); } }
    LDS_WAIT(); __syncthreads();
    f32x4 acc[4];
#pragma unroll
    for (int cb = 0; cb < 4; ++cb) acc[cb] = zero4();
#pragma unroll
    for (int ks = 0; ks < 4; ++ks) { const bf16x8 a = ldsfrag(VT, 16 * w + fr, PT128, 32 * ks + 8 * fq);
#pragma unroll
        for (int cb = 0; cb < 4; ++cb) acc[cb] = MFMA16(a, ldsfrag(KdT, 16 * cb + fr, PT128, 32 * ks + 8 * fq), acc[cb]); }
#pragma unroll
    for (int cb = 0; cb < 4; ++cb)
#pragma unroll
        for (int reg = 0; reg < 4; ++reg) KV[(16 * w + 4 * fq + reg) * 64 + 16 * cb + fr] = acc[cb][reg];
    __syncthreads();
}
__device__ __forceinline__ void mix_r2(const Frame& F) {
    float* KVb = (float*)(F.ws + WS_KVST); LAS float* car = (LAS float*)(F.lds);
    const int tid = F.wave * 64 + lane_id(), el = tid & 63, seg = tid >> 6;
#pragma unroll 1
    for (int blk = F.vcu; blk < RH * 8192 / 64; blk += F.G) { const int e0 = blk * 64 + el, h = e0 >> 13, e = e0 & 8191;
        const float cd = __builtin_amdgcn_exp2f(128.0f * log2_gamma(h));
        float* p = KVb + (size_t)h * 128 * 8192 + (size_t)(seg * 16) * 8192 + e; float kv[16];
#pragma unroll
        for (int n = 0; n < 16; ++n) kv[n] = p[(size_t)n * 8192];
        float st = 0.f;
#pragma unroll
        for (int n = 0; n < 16; ++n) { const float t = kv[n]; kv[n] = st; st = st * cd + t; }
        car[seg * 64 + el] = st; LDS_WAIT(); __syncthreads();
        float cin = 0.f, cd16 = cd; cd16 *= cd16; cd16 *= cd16; cd16 *= cd16; cd16 *= cd16;
#pragma unroll 1
        for (int s2 = 0; s2 < seg; ++s2) cin = cin * cd16 + car[s2 * 64 + el];
        float f = 1.f;
#pragma unroll
        for (int n = 0; n < 16; ++n) { p[(size_t)n * 8192] = kv[n] + cin * f; f *= cd; }
        __syncthreads(); }
}
__device__ __forceinline__ void mix_r3_item(const Frame& F, const float* retn, int h, int n) {
    LAS unsigned short* Qs = (LAS unsigned short*)(F.lds);
    LAS unsigned short* Ks = (LAS unsigned short*)(F.lds + 18432);
    LAS unsigned short* VT = (LAS unsigned short*)(F.lds + 36864);
    LAS unsigned short* PT = (LAS unsigned short*)(F.lds + 71680);
    LAS unsigned short* strip = (LAS unsigned short*)(F.lds + 90112) + F.wave * (16 * PT128);
    const bf16* QKR = (const bf16*)(F.ws + WS_QKR); const bf16* VR = (const bf16*)(F.ws + WS_VR); const bf16* GR = (const bf16*)(F.ws + WS_GR); bf16* OR = (bf16*)(F.ws + WS_OBR);
    const float* KV = (const float*)(F.ws + WS_KVST) + ((size_t)h * 128 + n) * 8192;
    int lane_ = lane_id();
    const int r0 = n * 128, lane = lane_, w = F.wave, tid = w * 64 + lane, fr = lane & 15, fq = lane >> 4; const float lg2 = log2_gamma(h);
    { const int s = tid >> 2, d0 = (tid & 3) * 16; const bf16* src = QKR + (size_t)(r0 + s) * 768 + h * 64 + d0;
#pragma unroll
        for (int q = 0; q < 2; ++q) { *(LAS v4u*)(Qs + s * PT64 + d0 + 8 * q) = *(const v4u*)(src + 8 * q); *(LAS v4u*)(Ks + s * PT64 + d0 + 8 * q) = *(const v4u*)(src + 384 + 8 * q); } }
    { const int s = tid >> 2, v0 = (tid & 3) * 32;
#pragma unroll
        for (int q = 0; q < 4; ++q) { const v4u x = *(const v4u*)(VR + (size_t)(r0 + s) * 768 + h * 128 + v0 + 8 * q);
            const unsigned xs[4] = {x.x, x.y, x.z, x.w};
#pragma unroll
            for (int j = 0; j < 4; ++j) { VT[(v0 + 8 * q + 2 * j) * PT128 + s] = (unsigned short)(xs[j] & 0xffffu); VT[(v0 + 8 * q + 2 * j + 1) * PT128 + s] = (unsigned short)(xs[j] >> 16); } } }
    { const int v = tid >> 2, d0 = (tid & 3) * 16; const float* src = KV + v * 64 + d0;
#pragma unroll
        for (int q = 0; q < 2; ++q) *(LAS v4u*)(PT + v * PT64 + d0 + 8 * q) = pack8bf(*(const f32x4*)(src + 8 * q), *(const f32x4*)(src + 8 * q + 4)); }
    LDS_WAIT(); __syncthreads();
    const bf16x8 qa0 = ldsfrag(Qs, 16 * w + fr, PT64, 8 * fq), qa1 = ldsfrag(Qs, 16 * w + fr, PT64, 32 + 8 * fq);
    f32x4 acc[8];
#pragma unroll
    for (int cb = 0; cb < 8; ++cb) { acc[cb] = zero4();
        acc[cb] = MFMA16(qa0, ldsfrag(PT, 16 * cb + fr, PT64, 8 * fq), acc[cb]); acc[cb] = MFMA16(qa1, ldsfrag(PT, 16 * cb + fr, PT64, 32 + 8 * fq), acc[cb]); }
#pragma unroll
    for (int reg = 0; reg < 4; ++reg) { const float f = 0.125f * __builtin_amdgcn_exp2f((float)(16 * w + 4 * fq + reg + 1) * lg2);
#pragma unroll
        for (int cb = 0; cb < 8; ++cb) acc[cb][reg] *= f; }
    const int nb = (w | 1) + 1;
#pragma unroll 1
    for (int cb = 0; cb < nb; ++cb) { f32x4 sa = zero4();
        sa = MFMA16(qa0, ldsfrag(Ks, 16 * cb + fr, PT64, 8 * fq), sa); sa = MFMA16(qa1, ldsfrag(Ks, 16 * cb + fr, PT64, 32 + 8 * fq), sa);
        const int s = 16 * cb + fr;
#pragma unroll
        for (int reg = 0; reg < 4; ++reg) { const int t = 16 * w + 4 * fq + reg; const float p = (s <= t) ? sa[reg] * 0.125f * __builtin_amdgcn_exp2f((float)(t - s) * lg2) : 0.f;
            strip[(4 * fq + reg) * PT128 + s] = (unsigned short)f2bf(p); } }
    LDS_WAIT(); asm volatile("" ::: "memory");
    const int nks = (w >> 1) + 1;
#pragma unroll 1
    for (int ks = 0; ks < nks; ++ks) { const bf16x8 a = ldsfrag(strip, fr, PT128, 32 * ks + 8 * fq);
#pragma unroll
        for (int cb = 0; cb < 8; ++cb) acc[cb] = MFMA16(a, ldsfrag(VT, 16 * cb + fr, PT128, 32 * ks + 8 * fq), acc[cb]); }
    LDS_WAIT(); asm volatile("" ::: "memory");
#pragma unroll
    for (int reg = 0; reg < 4; ++reg) { float sum = 0.f;
#pragma unroll
        for (int cb = 0; cb < 8; ++cb) sum += acc[cb][reg];
        sum += __shfl_xor(sum, 1); sum += __shfl_xor(sum, 2); sum += __shfl_xor(sum, 4); sum += __shfl_xor(sum, 8);
        const float mu = sum * (1.0f / 128.0f); float q = 0.f;
#pragma unroll
        for (int cb = 0; cb < 8; ++cb) { const float d = acc[cb][reg] - mu; q += d * d; }
        q += __shfl_xor(q, 1); q += __shfl_xor(q, 2); q += __shfl_xor(q, 4); q += __shfl_xor(q, 8);
        const float rsd = 1.0f / sqrtf(q * (1.0f / 128.0f) + EPS);
#pragma unroll
        for (int cb = 0; cb < 8; ++cb) strip[(4 * fq + reg) * PT128 + 16 * cb + fr] = (unsigned short)f2bf((acc[cb][reg] - mu) * rsd); }
    LDS_WAIT(); asm volatile("" ::: "memory");
#pragma unroll
    for (int i = 0; i < 4; ++i) { const int c = lane + 64 * i, row = c >> 4, col = (c & 15) * 8; const size_t r = (size_t)(r0 + 16 * w + row);
        const v4u y = *(const LAS v4u*)(strip + row * PT128 + col); const v4u gg = *(const v4u*)(GR + r * 768 + h * 128 + col); float fy[8], fg[8]; unpack8(y, fy); unpack8(gg, fg);
        const f32x4 na = *(const f32x4*)(retn + h * 128 + col), nb2 = *(const f32x4*)(retn + h * 128 + col + 4); const float nn[8] = {na[0], na[1], na[2], na[3], nb2[0], nb2[1], nb2[2], nb2[3]};
#pragma unroll
        for (int j = 0; j < 8; ++j) fy[j] = fy[j] * nn[j] * fg[j];
        *(v4u*)(OR + r * 768 + h * 128 + col) = pack8f(fy); }
    __syncthreads();
}
__device__ __forceinline__ void p_mix2(Frame& F0, const Args& a, int l) {
    Frame F = F0; { GAS unsigned char* wsg_ = (GAS unsigned char*)F.ws; F.tid = F.wave * 64 + lane_id(); asm volatile("" : "+v"(F.tid), "+s"(wsg_), "+s"(F.vcu), "+s"(F.G)); F.lane = F.tid & 63; F.ws = (unsigned char*)wsg_; }
    const float* sgn = (const float*)a.in[10] + (size_t)l * 512; const float* sgw = (const float*)a.in[11] + (size_t)l * 4 * 128 * 128; const float* sgb = (const float*)a.in[12] + (size_t)l * 512;
#pragma unroll 1
    for (int rp = 0, nr = rep_count(PROBE_SGR1); rp < nr; ++rp) {
#pragma unroll 1
    for (int it = F.vcu; it < 512; it += F.G) mix_sg_item(F, sgn, sgw, sgb, it >> 2, it & 3);
#pragma unroll 1
    for (int it = F.vcu; it < 768; it += F.G) mix_r1_item(F, it % 6, it / 6);
    }
#pragma unroll 1
    for (int rp = 0, nr = rep_count(PROBE_IDX); rp < nr; ++rp)
#pragma unroll 1
    for (int pq = F.vcu; pq < 256; pq += F.G) {
#pragma unroll 1
        for (int hh = 0; hh < 2; ++hh) idx::item(F, hh ? 511 - pq : pq); }
}
__device__ __forceinline__ void p_mix3(Frame& F0) {
    Frame F = F0; { GAS unsigned char* wsg_ = (GAS unsigned char*)F.ws; F.tid = F.wave * 64 + lane_id(); asm volatile("" : "+v"(F.tid), "+s"(wsg_), "+s"(F.vcu), "+s"(F.G)); F.lane = F.tid & 63; F.ws = (unsigned char*)wsg_; }
    mix_r2(F);
}
__device__ __forceinline__ void p_mix4(Frame& F0, const Args& a, int l) {
    Frame F = F0; { GAS unsigned char* wsg_ = (GAS unsigned char*)F.ws; F.tid = F.wave * 64 + lane_id(); asm volatile("" : "+v"(F.tid), "+s"(wsg_), "+s"(F.vcu), "+s"(F.G)); F.lane = F.tid & 63; F.ws = (unsigned char*)wsg_; }
    const float* retn = (const float*)a.in[9] + (size_t)l * 768;
#pragma unroll 1
    for (int rp = 0, nr = rep_count(PROBE_R3); rp < nr; ++rp)
#pragma unroll 1
    for (int it = F.vcu; it < 768; it += F.G) mix_r3_item(F, retn, it % 6, it / 6);
}
#ifndef PROBE_GU
#define PROBE_GU 1
#endif
#ifndef PROBE_GU_SKIP
#define PROBE_GU_SKIP 0
#endif
#ifndef PROBE_BARS
#define PROBE_BARS 0
#endif
#ifndef PROBE_RS
#define PROBE_RS 0
#endif
#ifndef WGM_GU
#define WGM_GU 4
#endif
#ifndef WGM_DOWN
#define WGM_DOWN 4
#endif
#ifndef WGM_PROJ
#define WGM_PROJ 8
#endif
#ifndef WGM_OUT
#define WGM_OUT 4
#endif
#ifndef WGM_MERGE
#define WGM_MERGE 4
#endif
#ifndef OUT_SPLIT
#define OUT_SPLIT 1
#endif
#ifndef DOWN_SEAM
#define DOWN_SEAM 0
#endif
#ifndef DOWN_REV
#define DOWN_REV 0
#endif
#ifndef DOWN_SPLIT
#define DOWN_SPLIT 2
#endif
#ifndef FFN_PARTS
#define FFN_PARTS 2
#endif
constexpr int FROWS = MTOK / FFN_PARTS;
#ifndef PROBE_PROJ_SKIP
#define PROBE_PROJ_SKIP 0
#endif
#ifndef PROBE_DOWN_SKIP
#define PROBE_DOWN_SKIP 0
#endif
#ifndef PROBE_DOWN
#define PROBE_DOWN 1
#endif
#ifndef PROBE_PROJ
#define PROBE_PROJ 1
#endif
#ifndef PROBE_MIX2
#define PROBE_MIX2 1
#endif
#ifndef PROBE_MIX4
#define PROBE_MIX4 1
#endif
#ifndef PROBE_MERGE
#define PROBE_MERGE 1
#endif
#ifndef PROBE_CONV
#define PROBE_CONV 1
#endif
#define REP(K) _Pragma("unroll 1") for (int rep_ = 0, nrep_ = rep_count(K); rep_ < nrep_; ++rep_)
#ifndef EN_GU
#define EN_GU 1
#endif
#ifndef EN_DOWN
#define EN_DOWN 1
#endif
#ifndef EN_PROJ
#define EN_PROJ 1
#endif
#ifndef EN_MERGE
#define EN_MERGE 1
#endif
#ifndef EN_OUT
#define EN_OUT 1
#endif

#ifndef PG8_SP2
#define PG8_SP2 true
#endif
#ifndef PG8_ALIGN
#define PG8_ALIGN true
#endif
__global__ void __launch_bounds__(NTHR, 2) mega_fwd(Args args) {
    extern __shared__ __attribute__((aligned(16))) unsigned char lds[];
    Frame F;
    F.lds = (LAS unsigned char*)lds; F.MISC = (volatile LAS unsigned*)(F.lds + MISC_OFF);
    F.tid = threadIdx.x; F.lane = F.tid & 63; F.wave = __builtin_amdgcn_readfirstlane(F.tid >> 6);
    F.G = gridDim.x; { const int bx = blockIdx.x; F.vcu = (F.G % 8 == 0) ? (bx % 8) * (F.G / 8) + bx / 8 : bx; }
    F.ws = args.ws; F.ctl = (gu32*)(args.ws + WS_CTL);
    F.xin = (const float*)args.in[0]; F.pos = (const int*)args.in[1]; F.rel = (const float*)args.in[2]; F.X = args.out;
    for (int u = F.tid; u < (LDS_BYTES - LDSCTL_OFF) / 4; u += NTHR) ((LAS unsigned*)(F.lds + LDSCTL_OFF))[u] = 0u;
    __syncthreads();
    XcdBarrier bar; bar.bar = (unsigned*)(F.ctl + CW_BAR); bar.x = 0; bar.st = nullptr;
    if (!MK_PER_PHASE) bar = xcd_barrier_post((unsigned*)(F.ctl + CW_BAR), F.MISC + 8);
    const int lo = args.ph_lo, hi = args.ph_hi; int ph = 0;
#define IN() (lo <= ph && ph < hi)
#define SEAM() do { if (!MK_PER_PHASE && lo <= ph && ph + 1 < hi) xcd_barrier(bar, F.wave); ++ph; } while (0)
#define SITE_PTRS() GAS unsigned char* wsg_ = (GAS unsigned char*)args.ws; int sG_ = F.G, sB_ = (int)blockIdx.x; asm volatile("" : "+s"(wsg_), "+s"(sG_), "+s"(sB_)); unsigned char* ws = (unsigned char*)wsg_; float* const part = (float*)(ws + WS_PART); const float* const rstd = (const float*)(ws + WS_RSTD); bf16* const XB = (bf16*)(ws + WS_XB); (void)part; (void)rstd; (void)XB

    if (IN()) p_prologue(F);
    SEAM();
#pragma unroll 1
    for (int l = 0; l < DEPTH; ++l) {
        if (IN()) REP(PROBE_CONV) p_convert(F, args, l);
#pragma unroll 1
        for (int s = 0; s < 3; ++s) {
            if (IN()) p_rowstat(F);
            SEAM();
            if (s != 1) {
#pragma unroll 1
                for (int h = 0; h < FFN_PARTS; ++h) {
                    const size_t r0 = (size_t)h * FROWS;
                    if (IN()) { SITE_PTRS(); const bf16* Wgu = (const bf16*)(ws + (s ? WS_WGU2 : WS_WGU1)); pg8::Gemm g{XB + r0 * DM, Wgu, FROWS, 2 * DFF, DM}; pg8::StaticOrder S; S.init(FROWS, 2 * DFF, sG_, sB_, WGM_GU);
#if EN_GU
                        REP(PROBE_GU) { EpiSwiGLU E{(bf16*)(ws + WS_HID), rstd + r0, (PROBE_GU_SKIP && rep_ + 1 < nrep_) ? 1 : 0};
                        if (PROBE_GU_SKIP == 2 && rep_ + 1 < nrep_) g.kmul = 0; else g.kmul = 1;
                        pg8::gemm_phase<EpiSwiGLU, pg8::StaticOrder, PG8_ALIGN, PG8_SP2>(F.lds + RING_OFF, g, S, E, F.wave); }
#endif
                    }
                    SEAM();
#pragma unroll 1
                    for (int dp = 0; dp < DOWN_SPLIT; ++dp) {
                    const int dq = DOWN_REV ? DOWN_SPLIT - 1 - dp : dp;
                    const size_t rd = r0 + (size_t)dq * (FROWS / DOWN_SPLIT), rl = (size_t)dq * (FROWS / DOWN_SPLIT);
                    if (IN()) { SITE_PTRS(); const bf16* Wd = (const bf16*)(ws + (s ? WS_WD2 : WS_WD1)); pg8::Gemm g{(const bf16*)(ws + WS_HID) + rl * DFF, Wd, FROWS / DOWN_SPLIT, DM, DFF}; pg8::StaticOrder S; S.init(FROWS / DOWN_SPLIT, DM, sG_, sB_, WGM_DOWN);
                        const float* base = (l == 0 && s == 0) ? F.xin : (RESID_BF16 ? (const float*)nullptr : (const float*)F.X);
#if EN_DOWN
                        REP(PROBE_DOWN) { EpiResid E{base ? base + rd * DM : base, F.X + rd * DM, XB + rd * DM, part + rd * 32, rep_ + 1 == nrep_ ? 0.5f : 0.0f, (PROBE_DOWN_SKIP && rep_ + 1 < nrep_) ? 1 : 0};
                        pg8::gemm_phase<EpiResid, pg8::StaticOrder, PG8_ALIGN, PG8_SP2, HID_BLK != 0>(F.lds + RING_OFF, g, S, E, F.wave); }
#endif
                    }
                    if (dp + 1 == DOWN_SPLIT) SEAM(); else if (DOWN_SEAM) SEAM();
                    }
                }
            } else {
#pragma unroll 1
                for (int b = 0; b < BATCH; ++b) {
                    const size_t r0 = (size_t)b * HROWS;
                    if (IN()) { SITE_PTRS(); pg8::Gemm g{XB + r0 * DM, (const bf16*)(ws + WS_WIN), HROWS, NPROJ, DM}; pg8::StaticOrder S; S.init(HROWS, NPROJ, sG_, sB_, WGM_PROJ);
                        const float* rc = (const float*)(ws + WS_ROPE) + r0 * 32;
                        EpiProj E{rstd + r0, rc, rc + (size_t)MTOK * 32, (bf16*)(ws + WS_QKR), (bf16*)(ws + WS_VR), (bf16*)(ws + WS_GR), (bf16*)(ws + WS_QA), (bf16*)(ws + WS_KA), (bf16*)(ws + WS_VA),
                                  (bf16*)(ws + WS_US), (bf16*)(ws + WS_VS), (bf16*)(ws + WS_GATE), (unsigned short*)(ws + WS_QI), (unsigned short*)(ws + WS_KI), (float*)(ws + WS_WI)};
#if EN_PROJ
                        REP(PROBE_PROJ) { E.skip = (PROBE_PROJ_SKIP && rep_ + 1 < nrep_) ? 1 : 0;
                        pg8::gemm_phase<EpiProj, pg8::StaticOrder, PG8_ALIGN, PG8_SP2>(F.lds + RING_OFF, g, S, E, F.wave); }
#endif
                    }
                    SEAM();
                    if (IN()) REP(PROBE_MIX2) p_mix2(F, args, l);
                    SEAM();
                    if (IN()) p_mix3(F);
                    SEAM();
                    if (IN()) REP(PROBE_MIX4) { p_mix4(F, args, l); p_attn(F, b); }
                    SEAM();
                    if (IN()) p_attn_combine(F);
                    SEAM();
                    if (IN()) { SITE_PTRS(); pg8::Gemm g{(const bf16*)(ws + WS_OBR), (const bf16*)(ws + WS_WBR), 3 * HROWS, 3 * DM, 768}; MergeOrder S; S.init(sG_, sB_, WGM_MERGE);
                        EpiMerge E{(const bf16*)(ws + WS_GATE), (bf16*)(ws + WS_MRG)};
#if EN_MERGE
                        REP(PROBE_MERGE)
                        pg8::gemm_phase<EpiMerge, MergeOrder, PG8_ALIGN, PG8_SP2>(F.lds + RING_OFF, g, S, E, F.wave);
#endif
                    }
                    SEAM();
#pragma unroll 1
                    for (int op = 0; op < OUT_SPLIT; ++op) {
                    const size_t ro = r0 + (size_t)op * (HROWS / OUT_SPLIT), rl = (size_t)op * (HROWS / OUT_SPLIT);
                    if (IN()) { SITE_PTRS(); pg8::Gemm g{(const bf16*)(ws + WS_MRG) + rl * DM, (const bf16*)(ws + WS_WOUT), HROWS / OUT_SPLIT, DM, DM}; pg8::StaticOrder S; S.init(HROWS / OUT_SPLIT, DM, sG_, sB_, WGM_OUT);
                        EpiResid E{RESID_BF16 ? (const float*)nullptr : (const float*)(F.X + ro * DM), F.X + ro * DM, XB + ro * DM, part + ro * 32, 1.0f};
#if EN_OUT
                        pg8::gemm_phase<EpiResid, pg8::StaticOrder, PG8_ALIGN, PG8_SP2>(F.lds + RING_OFF, g, S, E, F.wave);
#endif
                    }
                    SEAM();
                    }
                }
            }
        }
    }
#if PROBE_BARS
    if (!MK_PER_PHASE) {
#pragma unroll 1
        for (int rp = 0, nr = rep_count(PROBE_BARS); rp < nr; ++rp) xcd_barrier(bar, F.wave); }
#endif
#if PROBE_RS
#pragma unroll 1
    for (int rp = 0, nr = rep_count(PROBE_RS); rp < nr; ++rp) if (lo == 0) { p_rowstat(F); xcd_barrier(bar, F.wave); }
#endif
    if (IN()) p_final(F, (const float*)args.in[21]);
#undef IN
#undef SEAM
}
constexpr int N_PHASES = 1 + DEPTH * (3 + 2 * (1 + (DOWN_SEAM ? DOWN_SPLIT : 1)) * FFN_PARTS + BATCH * (6 + OUT_SPLIT)) + 1;

extern "C" void kernel_launch(void* const* d_in, const int* in_sizes, int n_in, void* d_out, int out_size, void* d_ws, size_t ws_size, hipStream_t stream) {
    static int grid = 0;
    if (grid == 0) {
        if (n_in != 22 || in_sizes[0] != MTOK * DM || out_size != MTOK * DM || ws_size < WS_END) { fprintf(stderr, "kernel_launch: unexpected shapes (n_in %d, in0 %d, out %d, ws %zu)\n", n_in, n_in > 0 ? in_sizes[0] : -1, out_size, ws_size); grid = -1; return; }
        int dev = 0, cus = 0, per_cu = 0;
        if (hipGetDevice(&dev) != hipSuccess || hipDeviceGetAttribute(&cus, hipDeviceAttributeMultiprocessorCount, dev) != hipSuccess) { grid = -1; return; }
        if (hipFuncSetAttribute((const void*)mega_fwd, hipFuncAttributeMaxDynamicSharedMemorySize, LDS_BYTES) != hipSuccess) { fprintf(stderr, "kernel_launch: hipFuncSetAttribute failed\n"); grid = -1; return; }
        if (hipOccupancyMaxActiveBlocksPerMultiprocessor(&per_cu, (const void*)mega_fwd, NTHR, LDS_BYTES) != hipSuccess || per_cu < 1) fprintf(stderr, "kernel_launch: occupancy query says %d\n", per_cu);
        (void)hipGetLastError();
        grid = cus;
    }
    if (grid < 0) return;
    if (hipMemsetAsync((char*)d_ws + WS_CTL, 0, CTL_ZERO_BYTES, stream) != hipSuccess) return;
    Args a{};
    for (int i = 0; i < 22; ++i) a.in[i] = d_in[i];
    a.out = (float*)d_out; a.ws = (unsigned char*)d_ws;
#if MK_PER_PHASE
    for (int p = 0; p < N_PHASES; ++p) { a.ph_lo = p; a.ph_hi = p + 1; hipLaunchKernelGGL(mega_fwd, dim3(grid), dim3(NTHR), LDS_BYTES, stream, a); }
#else
    a.ph_lo = 0; a.ph_hi = N_PHASES; hipLaunchKernelGGL(mega_fwd, dim3(grid), dim3(NTHR), LDS_BYTES, stream, a);
#endif
}
```

```cpp
#include <hip/hip_runtime.h>
#include <cstdio>
#include <cstdint>

#ifndef PG8_WGM
#define PG8_WGM 8
#endif
#ifndef MK_PER_PHASE
#define MK_PER_PHASE 0
#endif

namespace pg8 {
#define PG8_LAS __attribute__((address_space(3)))
typedef unsigned short bf16_t;
typedef short bf16x8 __attribute__((ext_vector_type(8)));
typedef float f32x4 __attribute__((ext_vector_type(4)));
typedef unsigned u32x4 __attribute__((ext_vector_type(4)));
constexpr int BM = 256, BK = 64, HALF = 128, HTB = HALF * BK * 2  , STAGE_BYTES = 8 * HTB, NXCD = 8, WGM = PG8_WGM;

__host__ __device__ __forceinline__ int lds_byte(int r, int c) { const int st = (r >> 4) * 2 + (c >> 5), rr = r & 15, cc = c & 31, ob = rr * 64 + cc * 2; return st * 1024 + (ob ^ (((ob >> 9) & 1) << 5)); }
__host__ __device__ __forceinline__ void stage_rc(int b, int& R, int& C) { const int st = b / 1024, sb = b % 1024, swz = sb ^ (((sb >> 9) & 1) << 5); R = (st >> 1) * 16 + swz / 64; C = (st & 1) * 32 + (swz % 64) / 2; }
__host__ __device__ __forceinline__ int perm32(int rho) { const int n = rho >> 4, i = rho & 15; return 8 * (i >> 2) + 4 * n + (i & 3); }

struct Unit { int pm, pn; };
struct Gemm { const bf16_t* A; const bf16_t* Bt; int M, N, K; int kmul = 1; };

struct StaticOrder {
    int nM, nN, nwg, G, c, wgm;
    __host__ __device__ void init(int M, int N, int G_, int c_, int wgm_ = WGM) { nM = M / BM; nN = N / BM; nwg = nM * nN; G = G_; c = c_; wgm = wgm_; }
    __host__ __device__ bool next(int i, Unit& u) const {
        const long L = (long)i * G + c; if (L >= nwg) return false;
        int wgid = (int)L; { const int q = nwg / NXCD, r = nwg % NXCD, xcd = wgid % NXCD, off = wgid / NXCD; wgid = (xcd < r ? xcd * (q + 1) : r * (q + 1) + (xcd - r) * q) + off; }
        const int nig = wgm * nN, gid = wgid / nig, fm = gid * wgm, gsz = (nM - fm) < wgm ? (nM - fm) : wgm;
        u.pm = fm + ((wgid % nig) % gsz); u.pn = (wgid % nig) / gsz; return true;
    }
    __device__ __forceinline__ void a_ready(const Unit&) const {}
    __device__ __forceinline__ void done(const Unit&) const {}
    __device__ __forceinline__ int ktiles(const Unit&, int full) const { return full; }
};

template <class Epi, class Sched, bool ALIGN_EPI = false, bool SP2 = false, bool BLK = false>
__device__ __forceinline__ void gemm_phase(PG8_LAS unsigned char* lds, const Gemm g, const Sched& S, const Epi& E, const int wave_sgpr) {
    unsigned m_ = ~0u; asm volatile("" : "+s"(m_)); int tid_ = wave_sgpr * 64 + (int)__builtin_amdgcn_mbcnt_hi(m_, __builtin_amdgcn_mbcnt_lo(m_, 0u)); asm volatile("" : "+v"(tid_));
    const int tid = tid_, wid = __builtin_amdgcn_readfirstlane(tid >> 6), lane = tid & 63, wr = wid >> 2, wc = wid & 3, fr = lane & 15, fq = lane >> 4;
    const int K = g.K; int nt = K / BK;
    unsigned voffA[2], voffB[2];
#pragma unroll
    for (int i = 0; i < 2; ++i) { int R, C; stage_rc(tid * 16 + i * 8192, R, C); const int Rb = Epi::PERM ? ((R & ~31) + perm32(R & 31)) : R;
        voffA[i] = (unsigned)(R * (BLK ? BK : K) + C) * 2u; voffB[i] = (unsigned)(Rb * (BLK ? BK : K) + C) * 2u; }
    const size_t kstep = (BLK ? (size_t)(BM * BK * 2) : (size_t)(BK * 2)) * (size_t)g.kmul;
    const size_t hstep = BLK ? (size_t)(HALF * BK * 2) : (size_t)HALF * K * 2;
    const size_t tstep = (size_t)BM * K * 2;
    const unsigned ldsw = (unsigned)wid * 1024u;
    const int aoff = lds_byte(wr * 64 + fr, fq * 8), boff = lds_byte(wc * 32 + fr, fq * 8);
#define PG8_SA(b, h) (((b) * 2 + (h)) * HTB)
#define PG8_SB(b, h) ((4 + (b) * 2 + (h)) * HTB)
#define PG8_STAGE(bufoff, gbase, voff) do { _Pragma("unroll") for (int _i = 0; _i < 2; ++_i) \
        __builtin_amdgcn_global_load_lds((const unsigned*)((const char*)(gbase) + (voff)[_i]), (PG8_LAS unsigned*)(lds + (bufoff) + ldsw + _i * 8192), 16, 0, 0); } while (0)
#define PG8_LDA(dst, b, h) do { _Pragma("unroll") for (int m = 0; m < 4; ++m) _Pragma("unroll") for (int k = 0; k < 2; ++k) dst[m][k] = *(const PG8_LAS bf16x8*)(lds + PG8_SA(b, h) + aoff + m * 2048 + k * 1024); } while (0)
#define PG8_LDB(dst, b, h) do { _Pragma("unroll") for (int n = 0; n < 2; ++n) _Pragma("unroll") for (int k = 0; k < 2; ++k) dst[n][k] = *(const PG8_LAS bf16x8*)(lds + PG8_SB(b, h) + boff + n * 2048 + k * 1024); } while (0)
#define PG8_MMA(ai, bj, At, Bt) do { __builtin_amdgcn_s_setprio(1); _Pragma("unroll") for (int m = 0; m < 4; ++m) _Pragma("unroll") for (int n = 0; n < 2; ++n) _Pragma("unroll") for (int k = 0; k < 2; ++k) \
        acc[ai][bj][m][n] = __builtin_amdgcn_mfma_f32_16x16x32_bf16(Bt[n][k], At[m][k], acc[ai][bj][m][n], 0, 0, 0); __builtin_amdgcn_s_setprio(0); } while (0)
#define PG8_WAIT_V(n) asm volatile("s_waitcnt vmcnt(" #n ")" ::: "memory")
#define PG8_WAIT_L(n) asm volatile("s_waitcnt lgkmcnt(" #n ")" ::: "memory")
#define PG8_BAR __builtin_amdgcn_s_barrier()
#define PG8_SCHED __builtin_amdgcn_sched_barrier(0)
    Unit cur, nxt; int ui = 0;
    if (!S.next(0, cur)) return;
    nt = S.ktiles(cur, K / BK);
    f32x4 acc[2][2][4][2];
#pragma unroll
    for (int a = 0; a < 2; ++a)
#pragma unroll
        for (int b = 0; b < 2; ++b)
#pragma unroll
            for (int m = 0; m < 4; ++m)
#pragma unroll
                for (int n = 0; n < 2; ++n) { float zf_ = 0.f; asm volatile("" : "+v"(zf_)); acc[a][b][m][n] = (f32x4){zf_, zf_, zf_, zf_}; }
    bf16x8 At[4][2], B0[2][2], B1[2][2];
    const char* cA = (const char*)g.A + (size_t)cur.pm * tstep; const char* cB = (const char*)g.Bt + (size_t)cur.pn * tstep;
    S.a_ready(cur);
    if constexpr (SP2) {
        PG8_STAGE(PG8_SB(0, 0), cB, voffB); PG8_STAGE(PG8_SB(0, 1), cB + hstep, voffB); PG8_STAGE(PG8_SA(0, 0), cA, voffA); PG8_STAGE(PG8_SA(0, 1), cA + hstep, voffA);
        if (wr == 1) PG8_BAR;
        PG8_WAIT_V(2); PG8_BAR;
        PG8_STAGE(PG8_SB(1, 0), cB + kstep, voffB); PG8_STAGE(PG8_SA(1, 0), cA + kstep, voffA); PG8_STAGE(PG8_SB(1, 1), cB + hstep + kstep, voffB);
        PG8_WAIT_V(6); PG8_BAR;
    } else {
        PG8_STAGE(PG8_SB(0, 0), cB, voffB); PG8_STAGE(PG8_SA(0, 0), cA, voffA); PG8_STAGE(PG8_SB(0, 1), cB + hstep, voffB); PG8_STAGE(PG8_SA(0, 1), cA + hstep, voffA);
        if (wr == 1) PG8_BAR;
        PG8_WAIT_V(4); PG8_BAR;
        PG8_STAGE(PG8_SB(1, 0), cB + kstep, voffB); PG8_STAGE(PG8_SA(1, 0), cA + kstep, voffA); PG8_STAGE(PG8_SB(1, 1), cB + hstep + kstep, voffB);
        PG8_WAIT_V(6); PG8_BAR;
    }
    for (;;) {
        const bool has_next = S.next(ui + 1, nxt);
        const char* nA = has_next ? (const char*)g.A + (size_t)nxt.pm * tstep : cA; const char* nB = has_next ? (const char*)g.Bt + (size_t)nxt.pn * tstep : cB;
        for (int t = 0; t < nt; t += 2) {
            const bool last = (t == nt - 2);
            const char* a1 = cA + (size_t)(t + 1) * kstep;
            const char* a2 = last ? nA : cA + (size_t)(t + 2) * kstep; const char* b2 = last ? nB : cB + (size_t)(t + 2) * kstep;
            const char* a3 = a2 + kstep; const char* b3 = b2 + kstep;
            if (last && has_next) S.a_ready(nxt);
            if constexpr (SP2) {
            PG8_LDB(B0, 0, 0); PG8_LDB(B1, 0, 1); PG8_SCHED; PG8_LDA(At, 0, 0); PG8_STAGE(PG8_SA(1, 1), a1 + hstep, voffA);
            PG8_WAIT_V(8); PG8_WAIT_L(0); PG8_BAR; PG8_MMA(0, 0, At, B0); PG8_MMA(0, 1, At, B1); PG8_BAR; PG8_SCHED;
            PG8_LDA(At, 0, 1); PG8_STAGE(PG8_SB(0, 0), b2, voffB); PG8_STAGE(PG8_SB(0, 1), b2 + hstep, voffB); PG8_STAGE(PG8_SA(0, 0), a2, voffA);
            PG8_WAIT_V(8); PG8_WAIT_L(0); PG8_BAR; PG8_MMA(1, 0, At, B0); PG8_MMA(1, 1, At, B1); PG8_BAR; PG8_SCHED;
            PG8_LDB(B0, 1, 0); PG8_LDB(B1, 1, 1); PG8_SCHED; PG8_LDA(At, 1, 0); PG8_STAGE(PG8_SA(0, 1), a2 + hstep, voffA);
            PG8_WAIT_V(8); PG8_WAIT_L(0); PG8_BAR; PG8_MMA(0, 0, At, B0); PG8_MMA(0, 1, At, B1); PG8_BAR; PG8_SCHED;
            PG8_LDA(At, 1, 1); PG8_STAGE(PG8_SB(1, 0), b3, voffB); PG8_STAGE(PG8_SB(1, 1), b3 + hstep, voffB); PG8_STAGE(PG8_SA(1, 0), a3, voffA);
            PG8_WAIT_V(8); PG8_WAIT_L(0); PG8_BAR; PG8_MMA(1, 0, At, B0); PG8_MMA(1, 1, At, B1); PG8_BAR; PG8_SCHED;
            } else {
            PG8_LDB(B0, 0, 0); PG8_SCHED; PG8_LDA(At, 0, 0); PG8_STAGE(PG8_SA(1, 1), a1 + hstep, voffA);
            PG8_WAIT_L(8); PG8_BAR; PG8_WAIT_L(0); PG8_MMA(0, 0, At, B0); PG8_BAR; PG8_SCHED;
            PG8_LDB(B1, 0, 1); PG8_STAGE(PG8_SB(0, 0), b2, voffB);
            PG8_BAR; PG8_WAIT_L(0); PG8_MMA(0, 1, At, B1); PG8_BAR;
            PG8_LDA(At, 0, 1); PG8_STAGE(PG8_SA(0, 0), a2, voffA);
            PG8_BAR; PG8_WAIT_L(0); PG8_MMA(1, 0, At, B0); PG8_BAR; PG8_SCHED;
            PG8_STAGE(PG8_SB(0, 1), b2 + hstep, voffB);
            PG8_WAIT_V(6); PG8_BAR; PG8_MMA(1, 1, At, B1); PG8_BAR;
            PG8_LDB(B0, 1, 0); PG8_SCHED; PG8_LDA(At, 1, 0); PG8_STAGE(PG8_SA(0, 1), a2 + hstep, voffA);
            PG8_WAIT_L(8); PG8_BAR; PG8_WAIT_L(0); PG8_MMA(0, 0, At, B0); PG8_BAR; PG8_SCHED;
            PG8_LDB(B1, 1, 1); PG8_STAGE(PG8_SB(1, 0), b3, voffB);
            PG8_BAR; PG8_WAIT_L(0); PG8_MMA(0, 1, At, B1); PG8_BAR;
            PG8_LDA(At, 1, 1); PG8_STAGE(PG8_SA(1, 0), a3, voffA);
            PG8_BAR; PG8_WAIT_L(0); PG8_MMA(1, 0, At, B0); PG8_BAR; PG8_SCHED;
            PG8_STAGE(PG8_SB(1, 1), b3 + hstep, voffB);
            PG8_WAIT_V(6); PG8_BAR; PG8_MMA(1, 1, At, B1); PG8_BAR;
            }
        }
        if constexpr (ALIGN_EPI) { if (wr == 0) PG8_BAR; }
        if constexpr (!Epi::AFTER_DRAIN) { E(acc, cur, wr, wc, fr, fq); S.done(cur); }
        if (!has_next) break;
        bool keep_acc = false; if constexpr (Epi::CHAIN) keep_acc = E.keep(cur);
        if (!keep_acc) {
#pragma unroll
        for (int a = 0; a < 2; ++a)
#pragma unroll
            for (int b = 0; b < 2; ++b)
#pragma unroll
                for (int m = 0; m < 4; ++m)
#pragma unroll
                    for (int n = 0; n < 2; ++n) { float zf_ = 0.f; asm volatile("" : "+v"(zf_)); acc[a][b][m][n] = (f32x4){zf_, zf_, zf_, zf_}; }
        }
        cur = nxt; cA = nA; cB = nB; ++ui; nt = S.ktiles(cur, K / BK);
        if constexpr (ALIGN_EPI) { if (wr == 1) PG8_BAR; }
    }
    PG8_WAIT_V(0);
    if constexpr (!ALIGN_EPI) { if (wr == 0) PG8_BAR; }
    PG8_BAR;
    if constexpr (Epi::AFTER_DRAIN) { E.fused(acc, cur, wr, wc, fr, fq, lds, wid, lane); S.done(cur); }
#undef PG8_SA
#undef PG8_SB
#undef PG8_STAGE
#undef PG8_LDA
#undef PG8_LDB
#undef PG8_MMA
#undef PG8_WAIT_V
#undef PG8_WAIT_L
#undef PG8_BAR
#undef PG8_SCHED
}
}

constexpr int NWAVES = 8, NTHR = 512;
constexpr int BATCH = 2, SEQ = 16384, DM = 2048, DEPTH = 2, MTOK = BATCH * SEQ, DFF = 5632;
constexpr int RH = 6, RDK = 64, RDV = 128, RCH = 128;
constexpr int AH = 6, AD = 128, IH = 4, IDIM = 64, TOPK = 256;
constexpr int SGG = 4, SGD = 128, SGC = 128;
constexpr int NPROJ = 12288;
constexpr int DIN = 12100;
constexpr float EPS = 1e-6f;
constexpr int HROWS = 16384;

constexpr size_t MiB = 1u << 20;
constexpr size_t WS_CTL = 0, CTL_ZERO_BYTES = 1 * MiB;
constexpr size_t WS_PART = 1 * MiB;
constexpr size_t WS_RSTD = 5 * MiB;
constexpr size_t WS_KMAX = 5 * MiB + 512 * 1024;
constexpr size_t WS_POS = 5 * MiB + 768 * 1024;
constexpr size_t WS_ROPE = 6 * MiB;
constexpr size_t WS_WGU1 = 16 * MiB, WS_WD1 = 60 * MiB, WS_WGU2 = 82 * MiB, WS_WD2 = 126 * MiB, WS_WIN = 148 * MiB, WS_WBR = 196 * MiB, WS_WOUT = 205 * MiB;
constexpr size_t WS_XB = 216 * MiB;
constexpr size_t WS_ACT = 344 * MiB;
constexpr size_t WS_HID = WS_ACT;
constexpr size_t WS_QKR = WS_ACT;
constexpr size_t WS_VR = WS_QKR + 24 * MiB, WS_GR = WS_VR + 24 * MiB, WS_QA = WS_GR + 24 * MiB, WS_KA = WS_QA + 24 * MiB, WS_VA = WS_KA + 24 * MiB;
constexpr size_t WS_QI = WS_VA + 24 * MiB;
constexpr size_t WS_KI = WS_QI + 8 * MiB;
constexpr size_t WS_WI = WS_KI + 2 * MiB;
constexpr size_t WS_US = WS_WI + 1 * MiB, WS_VS = WS_US + 16 * MiB;
constexpr size_t WS_GATE = WS_VS + 16 * MiB;
constexpr size_t WS_OBR = WS_GATE + 192 * MiB;
constexpr size_t WS_MRG = WS_OBR + 72 * MiB;
constexpr size_t WS_MASK = WS_MRG + 64 * MiB;
constexpr size_t WS_KVST = WS_MASK + 32 * MiB;
constexpr size_t WS_APART = WS_KVST + 24 * MiB;
constexpr size_t WS_AML = WS_APART + 24 * MiB;
constexpr size_t WS_END = WS_AML + 1 * MiB;
static_assert(WS_END <= 1030 * MiB, "workspace map");
static_assert(WS_HID + (size_t)HROWS * DFF * 2 <= WS_END, "hid overlay");
constexpr int CW_TMO = 0, CW_BAR = 4096;

constexpr int RING_OFF = 0, RING_BYTES = 131072;
constexpr int LDSCTL_OFF = RING_BYTES + 31744 + 128, MISC_OFF = LDSCTL_OFF;
constexpr int LDS_BYTES = LDSCTL_OFF + 256;
static_assert(LDS_BYTES <= 160 * 1024, "LDS");

#define GAS __attribute__((address_space(1)))
#define LAS __attribute__((address_space(3)))
typedef unsigned short bf16;
typedef unsigned v4u __attribute__((ext_vector_type(4)));
typedef unsigned v2u __attribute__((ext_vector_type(2)));
typedef float f32x4 __attribute__((ext_vector_type(4)));
typedef float f32x16 __attribute__((ext_vector_type(16)));
typedef short bf16x8 __attribute__((ext_vector_type(8)));
typedef _Float16 f16x8 __attribute__((ext_vector_type(8)));
typedef _Float16 f16x2 __attribute__((ext_vector_type(2)));
typedef GAS unsigned gu32;
#define RLX_AGENT __ATOMIC_RELAXED, __HIP_MEMORY_SCOPE_AGENT
#define LDS_WAIT() asm volatile("s_waitcnt lgkmcnt(0)" ::: "memory")
#define VM_WAIT() asm volatile("s_waitcnt vmcnt(0)" ::: "memory")
__device__ __forceinline__ unsigned f2bf(float f) { unsigned u = __builtin_bit_cast(unsigned, f); return (u + 0x7fffu + ((u >> 16) & 1u)) >> 16; }
__device__ __forceinline__ unsigned pk2(float lo, float hi) { unsigned r; asm volatile("v_cvt_pk_bf16_f32 %0, %1, %2" : "=v"(r) : "v"(lo), "v"(hi)); return r; }
__device__ __forceinline__ float bf2f(unsigned short b) { return __builtin_bit_cast(float, ((unsigned)b) << 16); }
__device__ __forceinline__ float bflo(unsigned w) { return __builtin_bit_cast(float, w << 16); }
__device__ __forceinline__ float bfhi(unsigned w) { return __builtin_bit_cast(float, w & 0xffff0000u); }
__device__ __forceinline__ unsigned pkh2(float lo, float hi) { f16x2 v = {(_Float16)lo, (_Float16)hi}; return __builtin_bit_cast(unsigned, v); }
__device__ __forceinline__ float fsigmoid(float x) { return __builtin_amdgcn_rcpf(1.0f + __builtin_amdgcn_exp2f(-1.4426950408889634f * x)); }
__device__ __forceinline__ float fsilu(float x) { return x * fsigmoid(x); }
__device__ __forceinline__ float fgelu_tanh(float x) { const float u = 1.5957691216057308f * (x + 0.044715f * x * x * x); return x * fsigmoid(u); }
__device__ __forceinline__ float wave_sum(float v) {
#pragma unroll
    for (int o = 1; o < 64; o <<= 1) v += __shfl_xor(v, o);
    return v;
}
__device__ __forceinline__ f32x4 zero4() { float z = 0.f; asm volatile("" : "+v"(z)); return (f32x4){z, z, z, z}; }
__device__ __forceinline__ f32x16 zero16() { float z = 0.f; asm volatile("" : "+v"(z)); return (f32x16){z, z, z, z, z, z, z, z, z, z, z, z, z, z, z, z}; }
__device__ __forceinline__ v4u zero4u() { unsigned z = 0u; asm volatile("" : "+v"(z)); return (v4u){z, z, z, z}; }
__device__ __forceinline__ int lane_id() { unsigned m = ~0u; asm volatile("" : "+s"(m)); return (int)__builtin_amdgcn_mbcnt_hi(m, __builtin_amdgcn_mbcnt_lo(m, 0u)); }
#ifndef PROBE_SGR1
#define PROBE_SGR1 1
#endif
#ifndef PROBE_R3
#define PROBE_R3 1
#endif
#ifndef PROBE_IDX
#define PROBE_IDX 1
#endif
__device__ __forceinline__ int rep_count(int k) { asm volatile("" : "+s"(k)); return k; }
#ifndef PROBE_IDXD
#define PROBE_IDXD 0
#endif
#define XB_TMO      128
#define XB_XCNT(j)  (256  + 64 * (j))
#define XB_XSUB(j)  (1280 + 64 * (j))
#define XB_XGEN(j)  (2304 + 64 * (j))
#define XB_TOP      3328
#define XB_TOPGEN   3392
#define XCD_BAR_WORDS 3456
#define XB_SPIN_CAP (1u << 18)

__device__ __forceinline__ unsigned xb_ld(unsigned* p)              { return __hip_atomic_load(p, __ATOMIC_RELAXED, __HIP_MEMORY_SCOPE_AGENT); }
__device__ __forceinline__ unsigned xb_add(unsigned* p, unsigned v) { return __hip_atomic_fetch_add(p, v, __ATOMIC_RELAXED, __HIP_MEMORY_SCOPE_AGENT); }
__device__ __forceinline__ unsigned xb_xcc_id() { return (unsigned)__builtin_amdgcn_s_getreg((3 << 11) | 20) & 0xFu; }
#define XB_SPIN(cond, bar) do { unsigned _sp = 0; while (cond) { __builtin_amdgcn_s_sleep(1); \
    if ((++_sp & 255u) == 0u) { if (xb_ld(&(bar)[XB_TMO])) break; if (_sp > XB_SPIN_CAP) { atomicAdd(&(bar)[XB_TMO], 1u); break; } } } } while (0)

struct XcdBarrier {
    unsigned* bar; unsigned x;
    volatile LAS unsigned* st;
};

__device__ __forceinline__ XcdBarrier xcd_barrier_post(unsigned* bar, volatile LAS unsigned* st) {
    XcdBarrier b; b.bar = bar; b.x = xb_xcc_id(); b.st = st;
    if (threadIdx.x == 0) (void)xb_add(&bar[XB_XCNT(b.x)], 1u);
    return b;
}
__device__ __forceinline__ void xcd_barrier_complete(unsigned* bar, unsigned x, unsigned& nloc, unsigned& nx) {
    const unsigned G = gridDim.x * gridDim.y * gridDim.z;
    unsigned sum, cnt, mine, sp = 0u;
    for (;;) {
        sum = 0u; cnt = 0u; mine = 0u;
#pragma unroll
        for (unsigned j = 0; j < 16; ++j) { const unsigned c = xb_ld(&bar[XB_XCNT(j)]); sum += c; cnt += (c > 0u) ? 1u : 0u; mine = (j == x) ? c : mine; }
        if (sum == G) break;
        __builtin_amdgcn_s_sleep(1);
        if ((++sp & 255u) == 0u) { if (xb_ld(&bar[XB_TMO])) break; if (sp > XB_SPIN_CAP) { atomicAdd(&bar[XB_TMO], 1u); break; } }
    }
    nloc = mine > 0u ? mine : 1u; nx = cnt > 0u ? cnt : 1u;
}

__device__ __forceinline__ void xcd_barrier(const XcdBarrier& b0, const int wave_sgpr) {
    XcdBarrier b = b0; asm volatile("" : "+s"(b.bar), "+s"(b.x));
    asm volatile("s_waitcnt vmcnt(0)" ::: "memory");
    __syncthreads();
    if (wave_sgpr == 0 && lane_id() == 0) {
        unsigned* bar = b.bar;
        __builtin_amdgcn_s_waitcnt(0);
        unsigned nloc = b.st[0], nx = b.st[1];
        if (nloc == 0u) { xcd_barrier_complete(bar, b.x, nloc, nx); b.st[0] = nloc; b.st[1] = nx; }
        const unsigned old = xb_add(&bar[XB_XSUB(b.x)], 1u);
        const unsigned gen = old / nloc;
        if (old + 1u == (gen + 1u) * nloc) {
            __builtin_amdgcn_fence(__ATOMIC_RELEASE, "agent");
            asm volatile("s_waitcnt vmcnt(0)" ::: "memory");
            const unsigned og = xb_add(&bar[XB_TOP], 1u);
            const unsigned tg = og / nx;
            if (og + 1u == (tg + 1u) * nx) xb_add(&bar[XB_TOPGEN], 1u);
            else XB_SPIN(xb_ld(&bar[XB_TOPGEN]) == tg, bar);
            __builtin_amdgcn_fence(__ATOMIC_ACQUIRE, "agent");
            xb_add(&bar[XB_XGEN(b.x)], 1u);
            asm volatile("s_waitcnt vmcnt(0)" ::: "memory");
        } else {
            XB_SPIN(xb_ld(&bar[XB_XGEN(b.x)]) == gen, bar);
            __builtin_amdgcn_fence(__ATOMIC_ACQUIRE, "agent");
            asm volatile("s_waitcnt vmcnt(0)" ::: "memory");
        }
    }
    __syncthreads();
}

using pg8::Unit; using pg8::HALF; using pg8::BM;
#ifndef NT_PROJ
#define NT_PROJ 0
#endif
#ifndef HID_BLK
#define HID_BLK 0
#endif
#ifndef RESID_GROUP
#define RESID_GROUP 1
#endif
#ifndef NT_GATE
#define NT_GATE 1
#endif
#ifndef NT_X
#define NT_X 0
#endif
__device__ __forceinline__ v4u pack8bf(const f32x4 a, const f32x4 b) { v4u w; w.x = pk2(a[0], a[1]); w.y = pk2(a[2], a[3]); w.z = pk2(b[0], b[1]); w.w = pk2(b[2], b[3]); return w; }
__device__ __forceinline__ v4u pack8h(const f32x4 a, const f32x4 b) { v4u w; w.x = pkh2(a[0], a[1]); w.y = pkh2(a[2], a[3]); w.z = pkh2(b[0], b[1]); w.w = pkh2(b[2], b[3]); return w; }

struct EpiSwiGLU {
    static constexpr bool PERM = true, AFTER_DRAIN = false, CHAIN = false;
    bf16* H; const float* rstd; int skip;
    __device__ __forceinline__ void operator()(const f32x4 (&acc)[2][2][4][2], const Unit& u, int wr, int wc, int fr, int fq) const {
        if (skip) {
#pragma unroll
            for (int a = 0; a < 2; ++a)
#pragma unroll
                for (int b = 0; b < 2; ++b)
#pragma unroll
                    for (int m = 0; m < 4; ++m) asm volatile("" :: "v"(acc[a][b][m][0]), "v"(acc[a][b][m][1]));
            return; }
        const int row0 = u.pm * BM + wr * 64 + fr, col0 = u.pn * 128 + wc * 32 + 8 * fq;
#pragma unroll
        for (int ai = 0; ai < 2; ++ai)
#pragma unroll
            for (int m = 0; m < 4; ++m) { const int r = row0 + ai * HALF + m * 16; const float rs = rstd[r];
                f32x4 h0, h1;
                typedef float f2 __attribute__((ext_vector_type(2)));
                const float rn = rs * -1.4426950408889634f, r2 = rs * rs;
#pragma unroll
                for (int n = 0; n < 2; ++n)
#pragma unroll
                    for (int j = 0; j < 2; ++j) { const f2 g = {acc[ai][0][m][n][2 * j], acc[ai][0][m][n][2 * j + 1]}, uu = {acc[ai][1][m][n][2 * j], acc[ai][1][m][n][2 * j + 1]};
                        const f2 t = g * rn; f2 d = {__builtin_amdgcn_exp2f(t.x), __builtin_amdgcn_exp2f(t.y)}; d = d + 1.0f;
                        const f2 rc = {__builtin_amdgcn_rcpf(d.x), __builtin_amdgcn_rcpf(d.y)}; const f2 o = (g * uu) * (rc * r2);
                        if (n == 0) { h0[2 * j] = o.x; h0[2 * j + 1] = o.y; } else { h1[2 * j] = o.x; h1[2 * j + 1] = o.y; } }
                if (HID_BLK) *(v4u*)(H + (((size_t)(r >> 8) * (DFF / 64) + (col0 >> 6)) * 256 + (r & 255)) * 64 + (col0 & 63)) = pack8bf(h0, h1);
                else *(v4u*)(H + (size_t)r * DFF + col0) = pack8bf(h0, h1); }
    }
};
#ifndef RESID_BF16
#define RESID_BF16 1
#endif
struct EpiResid {
#if RESID_BF16
    static constexpr bool PERM = true, AFTER_DRAIN = false, CHAIN = false;
#else
    static constexpr bool PERM = false, AFTER_DRAIN = false, CHAIN = false;
#endif
    const float* base; float* X; bf16* XB; float* part; float coef; int skip = 0;
    __device__ __forceinline__ void operator()(const f32x4 (&acc)[2][2][4][2], const Unit& u, int wr, int wc, int fr, int fq) const {
        if (skip) {
#pragma unroll
            for (int a = 0; a < 2; ++a)
#pragma unroll
                for (int b = 0; b < 2; ++b)
#pragma unroll
                    for (int m = 0; m < 4; ++m) asm volatile("" :: "v"(acc[a][b][m][0]), "v"(acc[a][b][m][1]));
            return; }
#if RESID_BF16
        const int row0 = u.pm * BM + wr * 64 + fr, col0 = u.pn * BM + wc * 32 + 8 * fq;
#pragma unroll
        for (int ai = 0; ai < 2; ++ai)
#pragma unroll
            for (int m = 0; m < 4; ++m) { const int r = row0 + ai * HALF + m * 16; float ss = 0.f;
#pragma unroll
                for (int bj = 0; bj < 2; ++bj) { const size_t o = (size_t)r * DM + col0 + bj * HALF;
                    f32x4 b0, b1;
                    if (base) { b0 = *(const f32x4*)(base + o); b1 = *(const f32x4*)(base + o + 4); }
                    else { const v4u bw = *(const v4u*)(XB + o); b0 = (f32x4){bflo(bw.x), bfhi(bw.x), bflo(bw.y), bfhi(bw.y)}; b1 = (f32x4){bflo(bw.z), bfhi(bw.z), bflo(bw.w), bfhi(bw.w)}; }
                    const f32x4 v0 = b0 + acc[ai][bj][m][0] * coef, v1 = b1 + acc[ai][bj][m][1] * coef;
                    *(v4u*)(XB + o) = pack8bf(v0, v1);
                    ss += ((v0[0] * v0[0] + v0[1] * v0[1]) + (v0[2] * v0[2] + v0[3] * v0[3])) + ((v1[0] * v1[0] + v1[1] * v1[1]) + (v1[2] * v1[2] + v1[3] * v1[3])); }
                ss += __shfl_xor(ss, 16); ss += __shfl_xor(ss, 32);
                if (fq == 0) part[(size_t)r * 32 + u.pn * 4 + wc] = ss;
                if ((m & (RESID_GROUP - 1)) == RESID_GROUP - 1) asm volatile("" ::: "memory"); }
#else
        const int row0 = u.pm * BM + wr * 64 + fr, col0 = u.pn * BM + wc * 32 + 4 * fq;
#pragma unroll
        for (int ai = 0; ai < 2; ++ai)
#pragma unroll
            for (int m = 0; m < 4; ++m) { const int r = row0 + ai * HALF + m * 16; float ss = 0.f;
#pragma unroll
                for (int bj = 0; bj < 2; ++bj)
#pragma unroll
                    for (int n = 0; n < 2; ++n) { const size_t o = (size_t)r * DM + col0 + bj * HALF + n * 16;
                        const f32x4 b = NT_X ? __builtin_nontemporal_load((const f32x4*)(base + o)) : *(const f32x4*)(base + o); const f32x4 v = b + acc[ai][bj][m][n] * coef;
                        if (NT_X) __builtin_nontemporal_store(v, (f32x4*)(X + o)); else *(f32x4*)(X + o) = v;
                        v2u w; w.x = pk2(v[0], v[1]); w.y = pk2(v[2], v[3]); *(v2u*)(XB + o) = w;
                        ss += (v[0] * v[0] + v[1] * v[1]) + (v[2] * v[2] + v[3] * v[3]); }
                ss += __shfl_xor(ss, 16); ss += __shfl_xor(ss, 32);
                if (fq == 0) part[(size_t)r * 32 + u.pn * 4 + wc] = ss;
                if ((m & (RESID_GROUP - 1)) == RESID_GROUP - 1) asm volatile("" ::: "memory"); }
#endif
    }
};
struct EpiProj {
    static constexpr bool PERM = true, AFTER_DRAIN = false, CHAIN = false;
    const float* rstd; const float* rcos; const float* rsin;
    bf16 *QKR, *VR, *GR, *QA, *KA, *VA, *US, *VS, *GATE; unsigned short *QI, *KI; float* WI; int skip = 0;
    __device__ __forceinline__ void operator()(const f32x4 (&acc)[2][2][4][2], const Unit& u, int wr, int wc, int fr, int fq) const {
        if (skip) {
#pragma unroll
            for (int a = 0; a < 2; ++a)
#pragma unroll
                for (int b = 0; b < 2; ++b)
#pragma unroll
                    for (int m = 0; m < 4; ++m) asm volatile("" :: "v"(acc[a][b][m][0]), "v"(acc[a][b][m][1]));
            return; }
        const int row0 = u.pm * BM + wr * 64 + fr, pn = u.pn, cw = wc * 32 + 8 * fq;
        if (pn < 3) {
            const int slot = 4 * pn + wc;
#pragma unroll
            for (int ai = 0; ai < 2; ++ai)
#pragma unroll
                for (int m = 0; m < 4; ++m) { const int r = row0 + ai * HALF + m * 16; const float rs = rstd[r];
                    const f32x4 c0 = *(const f32x4*)(rcos + (size_t)r * 32 + 8 * fq), c1 = *(const f32x4*)(rcos + (size_t)r * 32 + 8 * fq + 4);
                    const f32x4 s0 = *(const f32x4*)(rsin + (size_t)r * 32 + 8 * fq), s1 = *(const f32x4*)(rsin + (size_t)r * 32 + 8 * fq + 4);
                    const f32x4 a0 = acc[ai][0][m][0] * rs, a1 = acc[ai][0][m][1] * rs, b0 = acc[ai][1][m][0] * rs, b1 = acc[ai][1][m][1] * rs;
                    const f32x4 o10 = a0 * c0 - b0 * s0, o11 = a1 * c1 - b1 * s1, o20 = a0 * s0 + b0 * c0, o21 = a1 * s1 + b1 * c1;
                    bf16* d = QKR + (size_t)r * 768 + slot * 64 + 8 * fq;
                    *(v4u*)d = pack8bf(o10, o11); *(v4u*)(d + 32) = pack8bf(o20, o21); }
            return;
        }
        if (pn == 19) {
#pragma unroll
            for (int ai = 0; ai < 2; ++ai)
#pragma unroll
                for (int m = 0; m < 4; ++m) { const int r = row0 + ai * HALF + m * 16; const float rs = rstd[r];
                    if (wc < 2) *(v4u*)(KI + (size_t)r * 64 + cw) = pack8h(acc[ai][0][m][0] * rs, acc[ai][0][m][1] * rs);
                    if (wc == 2 && fq == 0) *(f32x4*)(WI + (size_t)r * 4) = acc[ai][0][m][0] * (rs * 0.0625f); }
            return;
        }
        int mode; unsigned short* dst; int ld, c0;
        if (pn < 6) { mode = 0; dst = VR; ld = 768; c0 = (pn - 3) * 256; }
        else if (pn < 9) { mode = 1; dst = GR; ld = 768; c0 = (pn - 6) * 256; }
        else if (pn < 12) { mode = 0; dst = QA; ld = 768; c0 = (pn - 9) * 256; }
        else if (pn < 15) { mode = 0; dst = KA; ld = 768; c0 = (pn - 12) * 256; }
        else if (pn < 18) { mode = 0; dst = VA; ld = 768; c0 = (pn - 15) * 256; }
        else if (pn == 18) { mode = 4; dst = QI; ld = 256; c0 = 0; }
        else if (pn < 22) { mode = 2; dst = US; ld = 512; c0 = (pn - 20) * 256; }
        else if (pn < 24) { mode = 2; dst = VS; ld = 512; c0 = (pn - 22) * 256; }
        else { mode = 3; dst = GATE; ld = 6144; c0 = (pn - 24) * 256; }
#pragma unroll
        for (int ai = 0; ai < 2; ++ai)
#pragma unroll
            for (int m = 0; m < 4; ++m) { const int r = row0 + ai * HALF + m * 16; const float rs = rstd[r];
#pragma unroll
                for (int bj = 0; bj < 2; ++bj) { f32x4 v0 = acc[ai][bj][m][0] * rs, v1 = acc[ai][bj][m][1] * rs;
                    if (mode == 1 || mode == 2) { typedef float f2 __attribute__((ext_vector_type(2)));
#pragma unroll
                        for (int j = 0; j < 4; ++j) { f2 x = (j < 2) ? (f2){v0[2 * j], v0[2 * j + 1]} : (f2){v1[2 * j - 4], v1[2 * j - 3]};
                            f2 t = (mode == 1) ? x * -1.4426950408889634f : (x * (x * x * 0.044715f + 1.0f)) * (-1.4426950408889634f * 1.5957691216057308f);
                            f2 d = {__builtin_amdgcn_exp2f(t.x), __builtin_amdgcn_exp2f(t.y)}; d = d + 1.0f; const f2 rc = {__builtin_amdgcn_rcpf(d.x), __builtin_amdgcn_rcpf(d.y)}; x = x * rc;
                            if (j < 2) { v0[2 * j] = x.x; v0[2 * j + 1] = x.y; } else { v1[2 * j - 4] = x.x; v1[2 * j - 3] = x.y; } } }
                    else if (mode == 3) { typedef float f2 __attribute__((ext_vector_type(2)));
#pragma unroll
                        for (int j = 0; j < 2; ++j) { f2 a = {v0[2 * j], v0[2 * j + 1]}, b = {v1[2 * j], v1[2 * j + 1]}; a = a * -1.4426950408889634f; b = b * -1.4426950408889634f;
                            f2 da = {__builtin_amdgcn_exp2f(a.x), __builtin_amdgcn_exp2f(a.y)}, db = {__builtin_amdgcn_exp2f(b.x), __builtin_amdgcn_exp2f(b.y)}; da = da + 1.0f; db = db + 1.0f;
                            v0[2 * j] = da.x; v0[2 * j + 1] = da.y; v1[2 * j] = db.x; v1[2 * j + 1] = db.y; } }
                    const v4u w = (mode == 4) ? pack8h(v0, v1) : pack8bf(v0, v1);
                    v4u* dp = (v4u*)(dst + (size_t)r * ld + c0 + bj * HALF + cw);
                    if ((NT_GATE && mode == 3) || NT_PROJ) __builtin_nontemporal_store(w, dp); else *dp = w; } }
    }
};
struct EpiMerge {
    static constexpr bool PERM = true, AFTER_DRAIN = false, CHAIN = true;
    const bf16* GATE; bf16* MRG;
    __device__ __forceinline__ bool keep(const Unit& u) const { return (u.pm >> 6) < 2; }
    static __device__ __forceinline__ void dens8(const v4u g, float (&o)[8]) { const float hi = 1152921504606846976.0f;
        o[0] = fminf(bflo(g.x), hi); o[1] = fminf(bfhi(g.x), hi); o[2] = fminf(bflo(g.y), hi); o[3] = fminf(bfhi(g.y), hi); o[4] = fminf(bflo(g.z), hi); o[5] = fminf(bfhi(g.z), hi); o[6] = fminf(bflo(g.w), hi); o[7] = fminf(bfhi(g.w), hi); }
    __device__ __forceinline__ void operator()(f32x4 (&acc)[2][2][4][2], const Unit& u, int wr, int wc, int fr, int fq) const {
        const int br = u.pm >> 6, pm = u.pm & 63, pn = u.pn & 7;
        const int row0 = pm * BM + wr * 64 + fr, col0 = pn * BM + wc * 32 + 8 * fq;
#pragma unroll
        for (int ai = 0; ai < 2; ++ai)
#pragma unroll
            for (int m = 0; m < 4; ++m) { const int r = row0 + ai * HALF + m * 16;
#pragma unroll
                for (int bj = 0; bj < 2; ++bj) { const int c = col0 + bj * HALF;
                    const bf16* gp = GATE + (size_t)r * 6144 + br * 2048 + c;
                    float f[8]; dens8(*(const v4u*)gp, f);
#pragma unroll
                    for (int j = 0; j < 8; ++j) f[j] = __builtin_amdgcn_rcpf(f[j]);
                    if (br < 2) { float d[8]; dens8(*(const v4u*)(gp + 2048), d);
#pragma unroll
                        for (int j = 0; j < 8; ++j) f[j] *= d[j]; }
                    f32x4 v0 = acc[ai][bj][m][0], v1 = acc[ai][bj][m][1];
                    v0[0] *= f[0]; v0[1] *= f[1]; v0[2] *= f[2]; v0[3] *= f[3]; v1[0] *= f[4]; v1[1] *= f[5]; v1[2] *= f[6]; v1[3] *= f[7];
                    if (br < 2) { acc[ai][bj][m][0] = v0; acc[ai][bj][m][1] = v1; }
                    else *(v4u*)(MRG + (size_t)r * DM + c) = pack8bf(v0, v1); } }
    }
};
struct MergeOrder {
    pg8::StaticOrder so;
    __device__ void init(int G, int c, int wgm) { so.init(HROWS, DM, G, c, wgm); }
    __device__ bool next(int i, Unit& u) const { Unit t; if (!so.next(i / 3, t)) return false; const int br = i % 3; u.pm = 64 * br + t.pm; u.pn = 8 * br + t.pn; return true; }
    __device__ __forceinline__ void a_ready(const Unit&) const {}
    __device__ __forceinline__ void done(const Unit&) const {}
    __device__ __forceinline__ int ktiles(const Unit& u, int full) const { return (u.pm >> 6) == 2 ? 512 / 64 : full; }
};

struct Args { const void* in[22]; float* out; unsigned char* ws; int ph_lo, ph_hi; };
struct Frame {
    LAS unsigned char* lds; volatile LAS unsigned* MISC; gu32* ctl;
    int tid, lane, wave, vcu, G;
    unsigned char* ws;
    const float* xin; const int* pos; const float* rel;
    float* X;
};

__device__ __forceinline__ void conv_item(const float* W, int ldw, int sc, int cnt, int k0, int kvalid, const float* gain, bf16* WT, int drow0, int Kd, LAS float* scr, int lane, bool blk = false) {
#define WT_AT(n_, k_) (blk ? (WT + ((((size_t)((n_) >> 8) * (Kd / 64) + ((k_) >> 6)) * 256 + ((n_) & 255)) * 64 + ((k_) & 63))) : (WT + (size_t)(n_) * Kd + (k_)))
    const int c8 = lane & 7;
    if (k0 >= kvalid || cnt <= 0) {
#pragma unroll
        for (int j = 0; j < 4; ++j) { const int n = (lane >> 3) + 8 * j; *(GAS v4u*)WT_AT(drow0 + n, k0 + 8 * c8) = zero4u(); }
        return;
    }
    const int c4 = (lane & 7) * 4, kr = lane >> 3; const bool cok = c4 < cnt; const int cc = cok ? c4 : 0;
    f32x4 v[8];
#pragma unroll
    for (int i = 0; i < 8; ++i) v[i] = *(const f32x4*)(W + (size_t)(k0 + 8 * i + kr) * ldw + sc + cc);
#pragma unroll
    for (int i = 0; i < 8; ++i) { const int kk = 8 * i + kr; f32x4 x = cok ? v[i] : (f32x4){0.f, 0.f, 0.f, 0.f}; if (gain) x = x * gain[k0 + kk];
        LAS float* d = scr + kk * 33 + c4; d[0] = x[0]; d[1] = x[1]; d[2] = x[2]; d[3] = x[3]; }
    LDS_WAIT(); asm volatile("" ::: "memory");
#pragma unroll
    for (int j = 0; j < 4; ++j) { const int n = (lane >> 3) + 8 * j; const LAS float* s = scr + (8 * c8) * 33 + n;
        v4u o; o.x = pk2(s[0 * 33], s[1 * 33]); o.y = pk2(s[2 * 33], s[3 * 33]); o.z = pk2(s[4 * 33], s[5 * 33]); o.w = pk2(s[6 * 33], s[7 * 33]);
        *(GAS v4u*)WT_AT(drow0 + n, k0 + 8 * c8) = o; }
    LDS_WAIT(); asm volatile("" ::: "memory");
#undef WT_AT
}
__device__ __forceinline__ void proj_src_group(int g, int& sc, int& cnt) {
    const int r0 = 32 * g; cnt = 32;
    if (r0 < 768) { const int t = r0 / 256, w = r0 % 256, bj = w / 128, wcq = (w % 128) / 32; sc = (4 * t + wcq) * 64 + 32 * bj; }
    else if (r0 < 4864) sc = r0;
    else if (r0 < 5120) { const int w = r0 - 4864; if (w < 64) sc = 4864 + w; else if (w == 64) { sc = 4928; cnt = 4; } else { sc = 0; cnt = 0; } }
    else if (r0 < 6144) sc = 4932 + (r0 - 5120);
    else sc = 5956 + (r0 - 6144);
}
__device__ __forceinline__ void p_convert(Frame& F0, const Args& a, int l) {
    Frame F = F0; { GAS unsigned char* wsg_ = (GAS unsigned char*)F.ws; F.tid = F.wave * 64 + lane_id(); asm volatile("" : "+v"(F.tid), "+s"(wsg_), "+s"(F.vcu), "+s"(F.G)); F.lane = F.tid & 63; F.ws = (unsigned char*)wsg_; }
    LAS float* scr = (LAS float*)(F.lds + RING_OFF + F.wave * 16384);
    const int gw = F.vcu * NWAVES + F.wave, NGW = F.G * NWAVES;
    constexpr int I_GU = 352 * 32, I_D = 64 * 88, I_IN = 384 * 32, I_BR = 192 * 12, I_OUT = 64 * 32;
    constexpr int NITEMS = 2 * (I_GU + I_D) + I_IN + I_BR + I_OUT;
#pragma unroll 1
    for (int it = gw; it < NITEMS; it += NGW) {
        int r = it;
        int src_idx, ldw, sc, cnt = 32, k0, kvalid, gain_idx = -1, drow0, Kd; size_t src_off, dst_off; bool blk = false;
        if (r < 2 * (I_GU + I_D)) {
            const int which = r / (I_GU + I_D); r -= which * (I_GU + I_D);
            if (r < I_GU) { const int g = r / 32, kb = r % 32, pn = g / 8, w = g % 8, bj = w / 4;
                src_idx = (which ? 18 : 4) + bj; src_off = (size_t)l * DM * DFF; ldw = DFF; sc = 128 * pn + (w % 4) * 32; k0 = 64 * kb; kvalid = DM; gain_idx = which ? 17 : 3;
                dst_off = which ? WS_WGU2 : WS_WGU1; drow0 = 32 * g; Kd = DM; }
            else { r -= I_GU; const int g = r / 88, kb = r % 88;
                src_idx = which ? 20 : 6; src_off = (size_t)l * DFF * DM; ldw = DM; sc = 32 * g; k0 = 64 * kb; kvalid = DFF;
                dst_off = which ? WS_WD2 : WS_WD1; drow0 = 32 * g; Kd = DFF; blk = HID_BLK; }
        } else {
            r -= 2 * (I_GU + I_D);
            if (r < I_IN) { const int g = r / 32, kb = r % 32; proj_src_group(g, sc, cnt);
                src_idx = 8; src_off = (size_t)l * DM * DIN; ldw = DIN; k0 = 64 * kb; kvalid = DM; gain_idx = 7; dst_off = WS_WIN; drow0 = 32 * g; Kd = DM; }
            else { r -= I_IN;
                if (r < I_BR) { const int g = r / 12, kb = r % 12, br = g / 64; const int kbr = br == 2 ? 512 : 768;
                    src_idx = 13 + br; src_off = (size_t)l * kbr * DM; ldw = DM; sc = 32 * (g % 64); k0 = 64 * kb; kvalid = kbr; dst_off = WS_WBR; drow0 = 32 * g; Kd = 768; }
                else { r -= I_BR; const int g = r / 32, kb = r % 32;
                    src_idx = 16; src_off = (size_t)l * DM * DM; ldw = DM; sc = 32 * g; k0 = 64 * kb; kvalid = DM; dst_off = WS_WOUT; drow0 = 32 * g; Kd = DM; } }
        }
        const float* W = (const float*)a.in[src_idx] + src_off;
        const float* gain = gain_idx >= 0 ? (const float*)a.in[gain_idx] + (size_t)l * DM : nullptr;
        conv_item(W, ldw, sc, cnt, k0, kvalid, gain, (bf16*)(F.ws + dst_off), drow0, Kd, scr, F.lane, blk);
    }
}
__device__ __forceinline__ void p_prologue(Frame& F0) {
    Frame F = F0; { GAS unsigned char* wsg_ = (GAS unsigned char*)F.ws; F.tid = F.wave * 64 + lane_id(); asm volatile("" : "+v"(F.tid), "+s"(wsg_), "+s"(F.vcu), "+s"(F.G)); F.lane = F.tid & 63; F.ws = (unsigned char*)wsg_; }
    const int gw = F.vcu * NWAVES + F.wave, NGW = F.G * NWAVES;
    float* rcos = (float*)(F.ws + WS_ROPE); float* rsin = rcos + (size_t)MTOK * 32;
    const int j = F.lane & 31;
    const float invf = powf(10000.0f, -(float)(2 * j) / 64.0f);
    for (int t2 = gw; t2 < MTOK / 2; t2 += NGW) { const int t = 2 * t2 + (F.lane >> 5);
        const float ang = (float)F.pos[t] * invf;
        double rev = (double)ang * 0.15915494309189533577; rev -= __builtin_rint(rev);
        const float fr = (float)rev;
        rcos[(size_t)t * 32 + j] = __builtin_amdgcn_cosf(fr); rsin[(size_t)t * 32 + j] = __builtin_amdgcn_sinf(fr); }
    { int* pc = (int*)(F.ws + WS_POS); for (int i = F.vcu * NTHR + F.tid; i < MTOK; i += F.G * NTHR) pc[i] = F.pos[i]; }
    int* kmax = (int*)(F.ws + WS_KMAX);
    for (int kt = gw; kt < BATCH * 256; kt += NGW) { const int p0 = F.pos[kt * 64 + F.lane]; int p = p0, q0 = p0;
#pragma unroll
        for (int o = 1; o < 64; o <<= 1) { const int q = __shfl_xor(p, o); p = q > p ? q : p; }
#pragma unroll
        for (int o = 1; o < 32; o <<= 1) { const int q = __shfl_xor(q0, o); q0 = q < q0 ? q : q0; }
        if (F.lane == 0) kmax[kt] = p;
        if ((F.lane & 31) == 0) kmax[1024 + 2 * kt + (F.lane >> 5)] = q0; }
    bf16* XB = (bf16*)(F.ws + WS_XB); float* part = (float*)(F.ws + WS_PART);
    for (int m = gw; m < MTOK; m += NGW) {
        const GAS f32x4* xr = (const GAS f32x4*)(F.xin + (size_t)m * DM) + F.lane; float ss = 0.f;
#pragma unroll
        for (int jj = 0; jj < 8; ++jj) { const f32x4 v = xr[64 * jj]; ss += (v[0] * v[0] + v[1] * v[1]) + (v[2] * v[2] + v[3] * v[3]);
            v2u w; w.x = pk2(v[0], v[1]); w.y = pk2(v[2], v[3]); *((GAS v2u*)(XB + (size_t)m * DM) + F.lane + 64 * jj) = w; }
        ss = wave_sum(ss);
        if (F.lane < 32) part[(size_t)m * 32 + F.lane] = F.lane == 0 ? ss : 0.f; }
}
__device__ __forceinline__ void p_rowstat(Frame& F0) {
    Frame F = F0; { GAS unsigned char* wsg_ = (GAS unsigned char*)F.ws; F.tid = F.wave * 64 + lane_id(); asm volatile("" : "+v"(F.tid), "+s"(wsg_), "+s"(F.vcu), "+s"(F.G)); F.lane = F.tid & 63; F.ws = (unsigned char*)wsg_; }
    const float* part = (const float*)(F.ws + WS_PART); float* rstd = (float*)(F.ws + WS_RSTD);
    for (int r = F.vcu * NTHR + F.tid; r < MTOK; r += F.G * NTHR) { const f32x4* p = (const f32x4*)(part + (size_t)r * 32); float s = 0.f;
#pragma unroll
        for (int jj = 0; jj < 8; ++jj) { const f32x4 v = p[jj]; s += (v[0] + v[1]) + (v[2] + v[3]); }
        rstd[r] = 1.0f / sqrtf(s * (1.0f / DM) + EPS); }
}
__device__ __forceinline__ void p_final(Frame& F0, const float* gfin) {
    Frame F = F0; { GAS unsigned char* wsg_ = (GAS unsigned char*)F.ws; F.tid = F.wave * 64 + lane_id(); asm volatile("" : "+v"(F.tid), "+s"(wsg_), "+s"(F.vcu), "+s"(F.G)); F.lane = F.tid & 63; F.ws = (unsigned char*)wsg_; }
    const int gw = F.vcu * NWAVES + F.wave, NGW = F.G * NWAVES; const float* rstd = (const float*)(F.ws + WS_RSTD);
    const float* part = (const float*)(F.ws + WS_PART); (void)rstd;
    for (int m = gw; m < MTOK; m += NGW) { GAS f32x4* xr = (GAS f32x4*)(F.X + (size_t)m * DM) + F.lane;
        const float rs = 1.0f / sqrtf(wave_sum(F.lane < 32 ? part[(size_t)m * 32 + F.lane] : 0.f) * (1.0f / DM) + EPS);
#if RESID_BF16
        const GAS v2u* xb = (const GAS v2u*)((const bf16*)(F.ws + WS_XB) + (size_t)m * DM) + F.lane;
#pragma unroll
        for (int jj = 0; jj < 8; ++jj) { const f32x4 g = *((const f32x4*)gfin + F.lane + 64 * jj); const v2u w = xb[64 * jj];
            xr[64 * jj] = (f32x4){bflo(w.x), bfhi(w.x), bflo(w.y), bfhi(w.y)} * rs * g; } }
#else
#pragma unroll
        for (int jj = 0; jj < 8; ++jj) { const f32x4 g = *((const f32x4*)gfin + F.lane + 64 * jj); xr[64 * jj] = xr[64 * jj] * rs * g; } }
#endif
}

namespace idx {
constexpr int IDX_STATE = 131072 + 128;
typedef LAS unsigned* lhist_t;
__device__ __forceinline__ int crow16(int r, int hi) { return (r & 3) + 8 * (r >> 2) + 4 * hi; }
struct QState { f16x8 qf[4][4]; f32x4 wv; };
struct KFrag { f16x8 k[4]; };
__device__ __forceinline__ void load_k(const GAS char* ws, int kt, int c, int hi, KFrag& K) {
    const GAS char* p = ws + (unsigned)((unsigned)WS_KI + (unsigned)((32 * kt + c) * 64 + 8 * hi) * 2u);
#pragma unroll
    for (int ks = 0; ks < 4; ++ks) K.k[ks] = *(const GAS f16x8*)(p + ks * 32);
}
typedef float f32x2 __attribute__((ext_vector_type(2)));
__device__ __forceinline__ void relu_fma(const f32x16& a, float w, f32x2 (&s2)[8]) {
    const f32x2 w2 = (f32x2){w, w};
#pragma unroll
    for (int i = 0; i < 8; ++i) { f32x2 p; { const float f0 = a[2 * i], f1 = a[2 * i + 1]; const int x0 = __builtin_bit_cast(int, f0), x1 = __builtin_bit_cast(int, f1);
            p.x = __builtin_bit_cast(float, x0 > 0 ? x0 : 0); p.y = __builtin_bit_cast(float, x1 > 0 ? x1 : 0); } s2[i] = p * w2 + s2[i]; }
}
__device__ __forceinline__ void score_tile2(const KFrag& Ka, const KFrag& Kb, const LAS char* qlds, const f32x4 wv, f32x16& sa, f32x16& sb) {
    f32x2 a2[8], b2[8];
#pragma unroll
    for (int i = 0; i < 8; ++i) { a2[i] = (f32x2){0.f, 0.f}; b2[i] = (f32x2){0.f, 0.f}; }
#pragma unroll
    for (int h = 0; h < 4; ++h) { f32x16 aa = {}, ab = {};
#pragma unroll
        for (int ks = 0; ks < 4; ++ks) { const f16x8 qf = *(const LAS f16x8*)(qlds + (h * 4 + ks) * 1024);
            aa = __builtin_amdgcn_mfma_f32_32x32x16_f16(Ka.k[ks], qf, aa, 0, 0, 0); ab = __builtin_amdgcn_mfma_f32_32x32x16_f16(Kb.k[ks], qf, ab, 0, 0, 0); }
        relu_fma(aa, wv[h], a2); relu_fma(ab, wv[h], b2); }
#pragma unroll
    for (int i = 0; i < 8; ++i) { sa[2 * i] = a2[i].x; sa[2 * i + 1] = a2[i].y; sb[2 * i] = b2[i].x; sb[2 * i + 1] = b2[i].y; }
}
__device__ __forceinline__ void score_tile1(const KFrag& Ka, const LAS char* qlds, const f32x4 wv, f32x16& sa) {
    f32x2 a2[8];
#pragma unroll
    for (int i = 0; i < 8; ++i) a2[i] = (f32x2){0.f, 0.f};
#pragma unroll
    for (int h = 0; h < 4; ++h) { f32x16 aa = {};
#pragma unroll
        for (int ks = 0; ks < 4; ++ks) aa = __builtin_amdgcn_mfma_f32_32x32x16_f16(Ka.k[ks], *(const LAS f16x8*)(qlds + (h * 4 + ks) * 1024), aa, 0, 0, 0);
        relu_fma(aa, wv[h], a2); }
#pragma unroll
    for (int i = 0; i < 8; ++i) { sa[2 * i] = a2[i].x; sa[2 * i + 1] = a2[i].y; }
}
__device__ __forceinline__ unsigned skey22(float s) { unsigned u = __builtin_bit_cast(unsigned, s); u ^= (unsigned)((int)u >> 31) | 0x80000000u; return u >> 10; }

template <int PASS, bool CAUSAL>
__device__ __forceinline__ void hist_tile(const f32x16& sc, int kt, int q, int c, int hi, lhist_t hrow, unsigned pfx) {
#pragma unroll
    for (int r = 0; r < 16; ++r) { const unsigned k22 = skey22(sc[r]); unsigned bin, inc;
        if (PASS == 0) { bin = k22 >> 11; inc = 1u; } else { bin = k22 & 2047u; inc = (k22 >> 11) == pfx ? 1u : 0u; }
        if (CAUSAL) { const int s = 32 * kt + crow16(r, hi); inc = s <= q ? inc : 0u; }
        __hip_atomic_fetch_add(hrow + ((bin >> 1) ^ (unsigned)c), inc << ((bin & 1u) * 16u), __ATOMIC_RELAXED, __HIP_MEMORY_SCOPE_WORKGROUP);
        if ((r & 3) == 3) __builtin_amdgcn_sched_barrier(0); }
}
template <int PASS>
__device__ __forceinline__ void hist_pass(const GAS char* ws, int q0, int qb32, int wave, int c, int hi, const LAS char* qlds, const f32x4 wv, lhist_t hist, unsigned pfx) {
    const int q = q0 + c; lhist_t hrow = hist + c * 1024;
    KFrag Ka, Kb;
    if (wave < qb32) { load_k(ws, wave, c, hi, Ka); load_k(ws, wave + 8 < qb32 ? wave + 8 : wave, c, hi, Kb); }
#pragma unroll 1
    for (int kt = wave; kt < qb32; kt += 16) { const bool has2 = kt + 8 < qb32;
        f32x16 sa, sb; score_tile2(Ka, Kb, qlds, wv, sa, sb);
        { const int kn = kt + 16 < qb32 ? kt + 16 : kt, kn2 = kn + 8 < qb32 ? kn + 8 : kn; load_k(ws, kn, c, hi, Ka); load_k(ws, kn2, c, hi, Kb); }
        hist_tile<PASS, false>(sa, kt, q, c, hi, hrow, pfx);
        if (has2) hist_tile<PASS, false>(sb, kt + 8, q, c, hi, hrow, pfx); }
    if (wave == (qb32 & 7)) { load_k(ws, qb32, c, hi, Ka); f32x16 sa; score_tile1(Ka, qlds, wv, sa); hist_tile<PASS, true>(sa, qb32, q, c, hi, hrow, pfx); }
}
constexpr int LROW = 1025;
template <bool CAUSAL>
__device__ __forceinline__ void lhist_tile(const f32x16& sc, int kt, int q, int c, int hi, lhist_t hrow, float ka, float kc) {
#pragma unroll
    for (int r = 0; r < 16; ++r) { const int b = (int)__builtin_amdgcn_fmed3f(__builtin_fmaf(sc[r], ka, kc), 0.f, 1023.f); unsigned inc = 1u;
        if (CAUSAL) { const int s = 32 * kt + crow16(r, hi); inc = s <= q ? 1u : 0u; }
        __hip_atomic_fetch_add(hrow + b, inc, __ATOMIC_RELAXED, __HIP_MEMORY_SCOPE_WORKGROUP);
        if ((r & 3) == 3) __builtin_amdgcn_sched_barrier(0); }
}
__device__ __forceinline__ void lhist_pass(const GAS char* ws, int q0, int qb32, int wave, int c, int hi, const LAS char* qlds, const f32x4 wv, lhist_t hist, float ka, float kc, int step, bool diag) {
    const int q = q0 + c; lhist_t hrow = hist + c * LROW;
    KFrag Ka, Kb;
    if (wave < qb32) { load_k(ws, wave, c, hi, Ka); load_k(ws, wave + 8 < qb32 ? wave + 8 : wave, c, hi, Kb); }
#pragma unroll 1
    for (int kt = wave; kt < qb32; kt += step) { const bool has2 = kt + 8 < qb32;
        f32x16 sa, sb; score_tile2(Ka, Kb, qlds, wv, sa, sb);
        { const int kn = kt + step < qb32 ? kt + step : kt, kn2 = kn + 8 < qb32 ? kn + 8 : kn; load_k(ws, kn, c, hi, Ka); load_k(ws, kn2, c, hi, Kb); }
        lhist_tile<false>(sa, kt, q, c, hi, hrow, ka, kc);
        if (has2) lhist_tile<false>(sb, kt + 8, q, c, hi, hrow, ka, kc); }
    if (diag && wave == (qb32 & 7)) { load_k(ws, qb32, c, hi, Ka); f32x16 sa; score_tile1(Ka, qlds, wv, sa); lhist_tile<true>(sa, qb32, q, c, hi, hrow, ka, kc); }
}
__device__ __forceinline__ void lin_scan(const LAS unsigned* hrow, int cq, int lane, unsigned& sl_out, unsigned& T_out) {
    unsigned sl = 0;
#pragma unroll
    for (int j = 0; j < 16; ++j) sl += hrow[16 * lane + j];
    unsigned T = sl;
#pragma unroll
    for (int o = 1; o < 64; o <<= 1) { const unsigned v = __shfl_down(T, o); T += (lane + o < 64) ? v : 0u; }
    sl_out = sl; T_out = T;
}
__device__ __forceinline__ int lin_locate(const LAS unsigned* hrow, int cq, int lane, unsigned sl, unsigned T, unsigned need, unsigned& need_out, unsigned& cnt_out) {
    const unsigned long long bal = __ballot(T >= need);
    if (bal == 0ull) { need_out = need; cnt_out = 0u; return -1; }
    const int L = 63 - __builtin_clzll(bal);
    int bin = -1; unsigned nn = need, cb = 0u;
    if (lane == L) { unsigned cum = T - sl;
#pragma unroll 1
        for (int j = 15; j >= 0 && bin < 0; --j) { const unsigned w = hrow[16 * lane + j];
            if (cum + w >= need) { bin = 16 * lane + j; nn = need - cum; cb = w; } else cum += w; } }
    bin = __shfl(bin, L); nn = __shfl(nn, L); cb = __shfl(cb, L); need_out = nn; cnt_out = cb; return bin;
}
__device__ __forceinline__ f32x4 load_wv(const GAS char* ws, int q) {
    unsigned o = (unsigned)WS_WI + (unsigned)q * 16u; asm volatile("" : "+v"(o));
    const f32x4 w = *(const GAS f32x4*)(ws + o);
    const float sa = fmaxf((__builtin_fabsf(w[0]) + __builtin_fabsf(w[1])) + (__builtin_fabsf(w[2]) + __builtin_fabsf(w[3])), 1e-30f);
    const float sc = __uint_as_float(__float_as_uint(40.0f / sa) & 0x7f800000u);
    return w * sc;
}
__device__ __forceinline__ int select_bin(const LAS unsigned* hrow, int cq, int lane, unsigned need, unsigned& need_out) {
    unsigned sl = 0;
#pragma unroll
    for (int j = 0; j < 16; ++j) { const unsigned w = hrow[(16 * lane + j) ^ cq]; sl += (w & 0xffffu) + (w >> 16); }
    unsigned T = sl;
#pragma unroll
    for (int o = 1; o < 64; o <<= 1) { const unsigned v = __shfl_down(T, o); T += (lane + o < 64) ? v : 0u; }
    const unsigned long long bal = __ballot(T >= need);
    if (bal == 0ull) { need_out = need; return -1; }
    const int L = 63 - __builtin_clzll(bal);
    int bin = -1; unsigned nn = need;
    if (lane == L) { unsigned cum = T - sl;
#pragma unroll 1
        for (int j = 15; j >= 0 && bin < 0; --j) { const unsigned w = hrow[(16 * lane + j) ^ cq]; const unsigned chi = w >> 16, clo = w & 0xffffu;
            if (cum + chi >= need) { bin = 32 * lane + 2 * j + 1; nn = need - cum; } else { cum += chi;
                if (cum + clo >= need) { bin = 32 * lane + 2 * j; nn = need - cum; } else cum += clo; } } }
    bin = __shfl(bin, L); nn = __shfl(nn, L); need_out = nn; return bin;
}
__device__ __forceinline__ void item(const Frame& F, int qb32) {
    lhist_t hist = (lhist_t)(F.lds); LAS unsigned* sta = (LAS unsigned*)(F.lds + IDX_STATE); LAS unsigned* need = sta + 32;
    LAS unsigned* Gw = (LAS unsigned*)(F.lds); LAS unsigned* Tw = (LAS unsigned*)(F.lds + 65536);
    const GAS char* ws = (const GAS char*)F.ws;
    int lane_ = lane_id();
    int wave_ = F.wave; asm volatile("" : "+s"(wave_));
    const int lane = lane_, wave = wave_, tid = wave * 64 + lane, c = lane & 31, hi = lane >> 5, q0 = 32 * qb32, q = q0 + c;
    LAS char* qall = (LAS char*)(F.lds + IDX_STATE + 1024);
    const LAS char* qlds = qall + lane * 16;
    if (wave == 0) {
#pragma unroll
        for (int h = 0; h < 4; ++h)
#pragma unroll
            for (int ks = 0; ks < 4; ++ks) *(LAS f16x8*)(qall + (h * 4 + ks) * 1024 + lane * 16) = *(const GAS f16x8*)(ws + (unsigned)((unsigned)WS_QI + (unsigned)(q * 256 + 8 * hi) * 2u) + (h * 64 + 16 * ks) * 2); }
    LAS unsigned* lcnt = sta + 96; LAS unsigned* slowf = sta + 128;
    LAS unsigned* lists = (LAS unsigned*)(F.lds + IDX_STATE + 1024 + 16384);
    constexpr unsigned LCAP = 56;
    if (tid < 32) { sta[tid] = 0u; need[tid] = (unsigned)TOPK; lcnt[tid] = 0u; } if (tid >= 32 && tid < 35) slowf[tid - 32] = 0u;
    const bool sel_needed = q0 + 31 >= TOPK;
    bool fast = false;
    if (sel_needed) {
        LAS float* kaf = (LAS float*)(sta + 160); LAS float* kcf = (LAS float*)(sta + 192);
        #ifndef IDX_CBCAP
#define IDX_CBCAP LCAP
#endif
#ifndef IDX_FORCEZOOM
#define IDX_FORCEZOOM 0
#endif
#ifndef IDX_SMAX
#define IDX_SMAX 16
#endif
#ifndef IDX_BRK_A
#define IDX_BRK_A 3.5f
#define IDX_BRK_B 5.0f
#endif
        const int S_ = qb32 >> 4, pstep = 16 * (S_ < 1 ? 1 : (S_ > IDX_SMAX ? IDX_SMAX : S_));
        LAS float* kza = (LAS float*)(sta + 224); LAS float* kzc = (LAS float*)(sta + 64);
        int nlp = 2;
#pragma unroll 1
        for (int lp = 0; lp < nlp; ++lp) {
#pragma unroll
            for (int i = 0; i < 64; ++i) hist[tid + 512 * i] = 0u;
            if (tid < 32) hist[32768 + tid] = 0u;
            LDS_WAIT(); __syncthreads();
            { float ka_ = 1.0f, kc_ = 256.0f; if (lp >= 1) { ka_ = kaf[c]; kc_ = kcf[c]; }
              const f32x4 wv = load_wv(ws, q); lhist_pass(ws, q0, qb32, wave, c, hi, qlds, wv, hist, ka_, kc_, lp == 0 ? pstep : 16, lp >= 1); }
            LDS_WAIT(); __syncthreads();
#pragma unroll 1
            for (int i = 0; i < 4; ++i) { const int cq = 4 * wave + i; unsigned sl, T; lin_scan(hist + cq * LROW, cq, lane, sl, T);
                if (lp == 0) {
                    const unsigned total = (unsigned)__builtin_amdgcn_readfirstlane((int)T);
                    const float rmid = 256.0f * (float)total / (float)(q0 + cq + 1), sq = __builtin_sqrtf(rmid);
                    const float fa = __builtin_floorf(rmid - IDX_BRK_A * sq - 2.0f), fb = __builtin_ceilf(rmid + IDX_BRK_B * sq + 8.0f);
                    const unsigned ra = fa < 1.0f ? 1u : (unsigned)fa, rb = (unsigned)fb; unsigned n0, n1;
                    const int ba = lin_locate(hist + cq * LROW, cq, lane, sl, T, ra, n0, n1); int bb = lin_locate(hist + cq * LROW, cq, lane, sl, T, rb, n0, n1);
                    if (bb < 0) bb = 0;
                    if (lane == 0) { const float lo = (float)(bb - 256), hiw = (float)(ba - 255); const float ka_ = 1022.0f / (hiw - lo); kaf[cq] = ka_; kcf[cq] = 1.0f - lo * ka_; } }
                else { unsigned nn, cb; const int bin = lin_locate(hist + cq * LROW, cq, lane, sl, T, (unsigned)TOPK, nn, cb);
                    if (lane == 0) { sta[cq] = (unsigned)bin; need[cq] = nn;
                        const float kc0 = kcf[cq]; const int zb = (int)__builtin_floorf(__builtin_amdgcn_fmed3f(kc0, 0.f, 1023.f));
                        if (!(bin >= 1 && bin <= 1022)) __hip_atomic_fetch_or(slowf + (lp - 1), 1u, __ATOMIC_RELAXED, __HIP_MEMORY_SCOPE_WORKGROUP);
                        else if (!(bin == zb || cb <= IDX_CBCAP)) __hip_atomic_fetch_or(slowf + (lp - 1), lp == 1 ? 8u : 2u, __ATOMIC_RELAXED, __HIP_MEMORY_SCOPE_WORKGROUP);
                        if (lp == 1) { const float Z = 1022.0f / 3.0f; kza[cq] = kaf[cq] * Z; kzc[cq] = (kc0 - (float)(bin - 1)) * Z + 1.0f; } } } }
            LDS_WAIT(); __syncthreads();
            if (lp == 1) { const int f1 = __builtin_amdgcn_readfirstlane((int)slowf[0]);
                if (f1 == 8 || (IDX_FORCEZOOM && f1 == 0)) { nlp = 3; if (tid < 32) { kaf[tid] = kza[tid]; kcf[tid] = kzc[tid]; } } }
        }
        { const int f1 = __builtin_amdgcn_readfirstlane((int)slowf[0]), f2 = __builtin_amdgcn_readfirstlane((int)slowf[1]); fast = nlp == 2 ? f1 == 0 : f2 == 0; }
        if (fast) {
            const f32x4 wv = load_wv(ws, q);
            const float loT = (float)(int)sta[c], hiT = loT + 1.0f, ka_ = kaf[c], kc_ = kcf[c];
#define MASK_TILE_F(SC, KT, CAUSAL) do { unsigned gb = 0u, eb = 0u, tb = 0u; \
            _Pragma("unroll") for (int r = 15; r >= 0; --r) { const float u2_ = __builtin_fmaf(SC[r], ka_, kc_); \
                bool g_ = u2_ >= hiT, e_ = u2_ >= loT; if (CAUSAL) { const bool ok_ = 32 * (KT) + crow16(r, hi) <= q; g_ = g_ && ok_; e_ = e_ && ok_; } \
                gb = gb + gb + (g_ ? 1u : 0u); eb = eb + eb + (e_ ? 1u : 0u); \
                if ((r & 3) == 0) __builtin_amdgcn_sched_barrier(0); } \
            eb &= ~gb;                                              \
            if (eb != 0u) { \
                _Pragma("unroll") for (int r = 0; r < 16; ++r) if (eb & (1u << r)) { const float t_ = SC[r]; \
                    if (t_ == 0.f) tb |= 1u << ((r & 3) + 8 * (r >> 2)); \
                    else { const unsigned p_ = __hip_atomic_fetch_add(lcnt + c, 1u, __ATOMIC_RELAXED, __HIP_MEMORY_SCOPE_WORKGROUP); \
                           if (p_ < LCAP) { unsigned u_ = __float_as_uint(t_); u_ ^= (unsigned)((int)u_ >> 31) | 0x80000000u; \
                               *(LAS v2u*)(lists + 2 * (c * LCAP + p_)) = (v2u){16383u - (unsigned)(32 * (KT) + crow16(r, hi)), u_}; } } } } \
            gb = (gb | (gb << 8)) & 0x00ff00ffu; gb = (gb | (gb << 4)) & 0x0f0f0f0fu;     \
            gb <<= 4 * hi; tb <<= 4 * hi; gb |= (unsigned)__shfl_xor((int)gb, 32); tb |= (unsigned)__shfl_xor((int)tb, 32); \
            if (hi == 0) { Gw[c * 512 + (KT)] = gb; Tw[c * 512 + (KT)] = tb; } } while (0)
            KFrag Ka, Kb;
            if (wave < qb32) { load_k(ws, wave, c, hi, Ka); load_k(ws, wave + 8 < qb32 ? wave + 8 : wave, c, hi, Kb); }
#pragma unroll 1
            for (int kt = wave; kt < qb32; kt += 16) { const bool has2 = kt + 8 < qb32;
                f32x16 sa, sb; score_tile2(Ka, Kb, qlds, wv, sa, sb);
                { const int kn = kt + 16 < qb32 ? kt + 16 : kt, kn2 = kn + 8 < qb32 ? kn + 8 : kn; load_k(ws, kn, c, hi, Ka); load_k(ws, kn2, c, hi, Kb); }
                MASK_TILE_F(sa, kt, false);
                if (has2) MASK_TILE_F(sb, kt + 8, false); }
            if (wave == (qb32 & 7)) { load_k(ws, qb32, c, hi, Ka); f32x16 sa; score_tile1(Ka, qlds, wv, sa); MASK_TILE_F(sa, qb32, true); }
#undef MASK_TILE_F
            LDS_WAIT(); __syncthreads();
#pragma unroll 1
            for (int i = 0; i < 4; ++i) { const int cq = 4 * wave + i; const unsigned n = lcnt[cq], rk = need[cq];
                if (n > LCAP) { if (lane == 0) slowf[2] = 1u; }
                else { v2u e = (v2u){0u, 0u}; if (lane < (int)n) e = *(const LAS v2u*)(lists + 2 * (cq * LCAP + lane));
                    const unsigned long long ev = ((unsigned long long)e.y << 32) | e.x; unsigned above = 0u;
#pragma unroll 1
                    for (unsigned j = 0; j < n; ++j) { const unsigned long long ej = ((unsigned long long)(unsigned)__builtin_amdgcn_readlane((int)e.y, (int)j) << 32) | (unsigned)__builtin_amdgcn_readlane((int)e.x, (int)j);
                        above += ej > ev ? 1u : 0u; }
                    if (lane < (int)n && above < rk) { const unsigned sidx = 16383u - e.x;
                        __hip_atomic_fetch_or(Gw + cq * 512 + (sidx >> 5), 1u << (sidx & 31u), __ATOMIC_RELAXED, __HIP_MEMORY_SCOPE_WORKGROUP); }
                    if (lane == 0) need[cq] = rk > n ? rk - n : 0u; } }
            LDS_WAIT(); __syncthreads();
            fast = __builtin_amdgcn_readfirstlane((int)slowf[2]) == 0;
        }
    } else { LDS_WAIT(); __syncthreads(); }
#ifndef PROBE_IDXFB
#define PROBE_IDXFB 1
#endif
#ifndef PROBE_IDXFB_MASK
#define PROBE_IDXFB_MASK 7
#endif
    const int slow_reason = 7;
    if (!fast)
#pragma unroll 1
    for (int fbrep_ = 0, fbn_ = rep_count((sel_needed && (slow_reason & PROBE_IDXFB_MASK)) ? PROBE_IDXFB : 1); fbrep_ < fbn_; ++fbrep_) {
        __syncthreads();
        if (tid < 32) { sta[tid] = 0u; need[tid] = (unsigned)TOPK; }
        const f32x4 wv = load_wv(ws, q);
        const bool all = q < TOPK; lhist_t hrow = hist + c * 1024;
#pragma unroll 1
        for (int mode = sel_needed ? 0 : 2; mode < 3; ++mode) {
            if (mode < 2) {
#pragma unroll 1
                for (int i = 0; i < 64; ++i) hist[tid + 512 * i] = 0u; }
            LDS_WAIT(); __syncthreads();
            unsigned a = sta[c]; if (all) a = 0u;
#pragma unroll 1
            for (int kt = wave; kt <= qb32; kt += 8) { KFrag Ka; load_k(ws, kt, c, hi, Ka); f32x16 sa; score_tile1(Ka, qlds, wv, sa);
                unsigned gb = 0u, tb = 0u;
#pragma unroll
                for (int r = 15; r >= 0; --r) { const int c0 = (r & 3) + 8 * (r >> 2); const unsigned k22 = skey22(sa[r]); const bool ok = 32 * kt + c0 + 4 * hi <= q;
                    if (mode == 2) { gb = gb + gb + ((ok && (all || k22 > a)) ? 1u : 0u); tb = tb + tb + ((ok && !all && k22 == a) ? 1u : 0u); }
                    else { const unsigned bin = mode == 0 ? k22 >> 11 : k22 & 2047u; const unsigned inc = (ok && (mode == 0 || (k22 >> 11) == a)) ? 1u : 0u;
                        __hip_atomic_fetch_add(hrow + ((bin >> 1) ^ (unsigned)c), inc << ((bin & 1u) * 16u), __ATOMIC_RELAXED, __HIP_MEMORY_SCOPE_WORKGROUP); }
                    if ((r & 3) == 0) __builtin_amdgcn_sched_barrier(0); }
                if (mode == 2) { gb = (gb | (gb << 8)) & 0x00ff00ffu; gb = (gb | (gb << 4)) & 0x0f0f0f0fu; tb = (tb | (tb << 8)) & 0x00ff00ffu; tb = (tb | (tb << 4)) & 0x0f0f0f0fu;
                    gb <<= 4 * hi; tb <<= 4 * hi; gb |= (unsigned)__shfl_xor((int)gb, 32); tb |= (unsigned)__shfl_xor((int)tb, 32);
                    if (hi == 0) { Gw[c * 512 + kt] = gb; Tw[c * 512 + kt] = tb; } } }
            LDS_WAIT(); __syncthreads();
            if (mode < 2) {
#pragma unroll 1
                for (int i = 0; i < 4; ++i) { const int cq = 4 * wave + i; unsigned nn; const int bin = select_bin(hist + cq * 1024, cq, lane, need[cq], nn);
                    if (lane == 0 && bin >= 0) { sta[cq] = mode == 0 ? (unsigned)bin : ((sta[cq] << 11) | (unsigned)bin); need[cq] = nn; } }
                LDS_WAIT(); __syncthreads(); }
        }
    }
    LDS_WAIT(); __syncthreads();
    const int kt_end = 8 * (q0 / 256 + 1);
    GAS unsigned* MK = (GAS unsigned*)(F.ws + WS_MASK);
#pragma unroll 1
    for (int i = 0; i < 4; ++i) { const int cq = 4 * wave + i; const unsigned r = need[cq]; unsigned base = 0u;
#pragma unroll 1
        for (int k0 = 0; k0 < kt_end; k0 += 64) { const int kt = k0 + lane; const bool live = kt <= qb32;
            const unsigned g = live ? Gw[cq * 512 + kt] : 0u, t = live ? Tw[cq * 512 + kt] : 0u; const unsigned p = __builtin_popcount(t);
            unsigned C = p;
#pragma unroll
            for (int o = 1; o < 64; o <<= 1) { const unsigned v = __shfl_up(C, o); C += (lane >= o) ? v : 0u; }
            const unsigned before = base + C - p;
            unsigned keep = t;
            if (before >= r) keep = 0u;
            else if (before + p > r) { unsigned left = r - before, m = 0u, tt = t;
#pragma unroll 1
                while (left) { const unsigned lowbit = tt & (0u - tt); m |= lowbit; tt ^= lowbit; --left; }
                keep = m; }
            if (kt < kt_end) MK[((size_t)(kt >> 1) * HROWS + (q0 + cq)) * 2 + (kt & 1)] = g | keep;
            base += __shfl(C, 63); } }
    __syncthreads();
}
}

namespace att {
constexpr int D = 128, NW = 8, QBLK = 32, KVBLK = 64, QB = 256, STR = 768;
constexpr float SCALE = 0.08838834764831845f, THR = 8.f;
constexpr int SHM_V = KVBLK * D * 2, SHM_K = KVBLK * D * 2;
constexpr int ATT_LDS = 2 * SHM_V + 2 * SHM_K + NW * 64 * 4;
constexpr int BIAS_OFF = ATT_LDS;
constexpr int QL_OFF = ATT_LDS + 3200;
typedef short s16x4 __attribute__((ext_vector_type(4)));
typedef LAS char* lp_t;
#define KSWZ(row, colB) ((row) * 256 + ((colB) ^ (((row) & 7) << 4)))
#define SBAR() __builtin_amdgcn_sched_barrier(0)
__device__ __forceinline__ int v_st(int k, int c) { const int kk = (k & ~0xC) | ((k & 4) << 1) | ((k & 8) >> 1); return ((kk >> 3) * 4 + (c >> 5)) * 512 + ((kk & 7) * 32 + (c & 31)) * 2; }
__device__ __forceinline__ int v_rd_base(int lane) { return ((lane & 3) << 3) | (((lane >> 2) & 3) << 6) | (((lane >> 4) & 1) << 5) | (((lane >> 5) & 1) << 8); }
constexpr int v_rd_off(int d0, int ks, int half) { return d0 * 512 + ks * 4096 + half * 2048; }
__device__ __forceinline__ int crow(int r, int hi) { return (r & 3) + 8 * (r >> 2) + 4 * hi; }
__device__ __forceinline__ unsigned cvtpk(float lo, float hi) { unsigned r; asm volatile("v_cvt_pk_bf16_f32 %0, %1, %2" : "=v"(r) : "v"(lo), "v"(hi)); return r; }
__device__ __forceinline__ bf16x8 load8(const unsigned short* p) { return *reinterpret_cast<const bf16x8*>(p); }

__device__ __forceinline__ void partialSM(f32x16& p0, f32x16& p1, float& m_reg, float& mn, float& alpha) {
    float pmax = p0[0]; for (int r = 1; r < 16; ++r) pmax = fmaxf(pmax, p0[r]); for (int r = 0; r < 16; ++r) pmax = fmaxf(pmax, p1[r]);
    { auto rr = __builtin_amdgcn_permlane32_swap(__float_as_uint(pmax), __float_as_uint(pmax), false, false);
      pmax = fmaxf(__uint_as_float(rr[0]), __uint_as_float(rr[1])); }
    constexpr float C2 = 1.4426950408889634f * SCALE;
    if (__builtin_expect(__all((pmax - m_reg) * SCALE <= THR), 1)) { mn = m_reg; alpha = 1.f; }
    else { mn = fmaxf(m_reg, pmax); alpha = __builtin_amdgcn_exp2f((m_reg - mn) * C2); m_reg = mn; }
    const float mnL = -mn * C2;
    for (int r = 0; r < 16; ++r) p0[r] = fmaf(p0[r], C2, mnL); for (int r = 0; r < 16; ++r) p1[r] = fmaf(p1[r], C2, mnL);
    for (int r = 0; r < 16; ++r) p0[r] = __builtin_amdgcn_exp2f(p0[r]);
}
__device__ __forceinline__ void finishSM(f32x16& p0, f32x16& p1, float alpha, float& l_reg, bf16x8& pa0, bf16x8& pa1, bf16x8& pa2, bf16x8& pa3) {
    for (int r = 0; r < 16; ++r) p1[r] = __builtin_amdgcn_exp2f(p1[r]);
    float ps = 0; for (int r = 0; r < 16; ++r) ps += p0[r]; for (int r = 0; r < 16; ++r) ps += p1[r];
    { auto rr = __builtin_amdgcn_permlane32_swap(__float_as_uint(ps), __float_as_uint(ps), false, false);
      ps = __uint_as_float(rr[0]) + __uint_as_float(rr[1]); }
    l_reg = l_reg * alpha + ps;
#define PK4(P, B_, OUT) do { unsigned a0 = cvtpk(P[B_+0], P[B_+1]), a1 = cvtpk(P[B_+2], P[B_+3]);                          \
        unsigned b0 = cvtpk(P[B_+4], P[B_+5]), b1 = cvtpk(P[B_+6], P[B_+7]);                                             \
        auto r0 = __builtin_amdgcn_permlane32_swap(a0, b0, false, false); auto r1 = __builtin_amdgcn_permlane32_swap(a1, b1, false, false); \
        v4u w = {r0[0], r1[0], r0[1], r1[1]}; OUT = *reinterpret_cast<bf16x8*>(&w); } while (0)
    PK4(p0, 0, pa0); PK4(p0, 8, pa1); PK4(p1, 0, pa2); PK4(p1, 8, pa3);
#undef PK4
}
template <int KB>
__device__ __forceinline__ void qkt(f32x16& p0, f32x16& p1, const LAS char* K_lds, int r32, int hi, const bf16x8* qr) {
    p0 = f32x16{}; p1 = f32x16{};
    const LAS char* kb[4];
#pragma unroll
    for (int dd = 0; dd < 4; ++dd) kb[dd] = K_lds + KB * SHM_K + KSWZ(r32, (dd * 16 + hi * 8) * 2);
#pragma unroll
    for (int d0 = 0; d0 < 8; ++d0) { const LAS char* a = kb[d0 & 3] + (d0 >> 2) * 128;
        bf16x8 b0 = *reinterpret_cast<const LAS bf16x8*>(a);
        bf16x8 b1 = *reinterpret_cast<const LAS bf16x8*>(a + 32 * 256);
        p0 = __builtin_amdgcn_mfma_f32_32x32x16_bf16(b0, qr[d0], p0, 0, 0, 0);
        p1 = __builtin_amdgcn_mfma_f32_32x32x16_bf16(b1, qr[d0], p1, 0, 0, 0); }
}
template <int VB>
__device__ __forceinline__ void pv_tile(f32x16* o, int vb0, bf16x8 pa0, bf16x8 pa1, bf16x8 pa2, bf16x8 pa3) {
#define TRRD(dst, off) asm volatile("ds_read_b64_tr_b16 %0, %1 offset:%2" : "=&v"(dst) : "v"(vb0), "i"(off) : "memory")
#define PV_D0(d0) do { s16x4 l0, l1, l2, l3, h0, h1, h2, h3; constexpr int b_ = VB * SHM_V + v_rd_off(d0, 0, 0); \
        TRRD(l0, b_); TRRD(h0, b_ + 2048); TRRD(l1, b_ + 4096); TRRD(h1, b_ + 6144); TRRD(l2, b_ + 8192); TRRD(h2, b_ + 10240); TRRD(l3, b_ + 12288); TRRD(h3, b_ + 14336); \
        asm volatile("s_waitcnt lgkmcnt(0)" ::: "memory"); SBAR();   \
        o[d0] = __builtin_amdgcn_mfma_f32_32x32x16_bf16(pa0, (bf16x8){l0[0], l0[1], l0[2], l0[3], h0[0], h0[1], h0[2], h0[3]}, o[d0], 0, 0, 0);   \
        o[d0] = __builtin_amdgcn_mfma_f32_32x32x16_bf16(pa1, (bf16x8){l1[0], l1[1], l1[2], l1[3], h1[0], h1[1], h1[2], h1[3]}, o[d0], 0, 0, 0);   \
        o[d0] = __builtin_amdgcn_mfma_f32_32x32x16_bf16(pa2, (bf16x8){l2[0], l2[1], l2[2], l2[3], h2[0], h2[1], h2[2], h2[3]}, o[d0], 0, 0, 0);   \
        o[d0] = __builtin_amdgcn_mfma_f32_32x32x16_bf16(pa3, (bf16x8){l3[0], l3[1], l3[2], l3[3], h3[0], h3[1], h3[2], h3[3]}, o[d0], 0, 0, 0); } while (0)
    PV_D0(0); PV_D0(1); PV_D0(2); PV_D0(3);
#undef PV_D0
#undef TRRD
}
__device__ __forceinline__ void apply_mask(f32x16& p0, f32x16& p1, v2u mw, int hi) {
    const int m0 = (int)(mw.x >> (4 * hi)), m1 = (int)(mw.y >> (4 * hi)); const unsigned NEG = 0xff800000u;
#pragma unroll
    for (int r = 0; r < 16; ++r) { const int c = (r & 3) + 8 * (r >> 2);
        const unsigned a0 = (unsigned)((m0 << (31 - c)) >> 31), a1 = (unsigned)((m1 << (31 - c)) >> 31);
        p0[r] = __uint_as_float((__float_as_uint(p0[r]) & a0) | (NEG & ~a0)); p1[r] = __uint_as_float((__float_as_uint(p1[r]) & a1) | (NEG & ~a1)); }
}
__device__ __forceinline__ void bias_tile(f32x16& p0, f32x16& p1, const GAS char* ws, unsigned pko  , int pq, const LAS float* bT, int hi) {
    const unsigned ho = pko + (unsigned)hi * 16u;
#pragma unroll
    for (int r = 0; r < 16; ++r) { const int c = (r & 3) + 8 * (r >> 2);
        int d0 = pq - *(const GAS int*)(ws + (unsigned)(ho + c * 4)); d0 = d0 < 0 ? 0 : (d0 > 128 ? 128 : d0); p0[r] += bT[d0];
        int d1 = pq - *(const GAS int*)(ws + (unsigned)(ho + (c + 32) * 4)); d1 = d1 < 0 ? 0 : (d1 > 128 ? 128 : d1); p1[r] += bT[d1];
        if ((r & 3) == 3) asm volatile("" ::: "memory"); }
}
struct BlockRef { int P0, h, t0, nt, pidx; };
struct Seam { bf16x8 qr[8]; bf16x8 st_v0, st_v1, st_k0, st_k1; };
typedef const GAS char* gp_t;
#define VMW() asm volatile("s_waitcnt vmcnt(0)" ::: "memory")
#define LD8W(off) (*reinterpret_cast<const GAS bf16x8*>(ws + (unsigned)(off)))
#define SLOAD_H(ko_, k0) do { const unsigned so0_ = so0, so1_ = so1; \
        const unsigned t_ = (unsigned)(k0) * (STR * 2u) + (ko_); \
        S.st_v0 = LD8W(t_ + (unsigned)(WS_VA - WS_KA) + so0_); S.st_v1 = LD8W(t_ + (unsigned)(WS_VA - WS_KA) + so1_); S.st_k0 = LD8W(t_ + so0_); S.st_k1 = LD8W(t_ + so1_); } while (0)
#define SWRITE_HK(bf) do { const int kws_ = kws; \
        *(LAS bf16x8*)(K_lds + (bf) * SHM_K + kws_) = S.st_k0; *(LAS bf16x8*)(K_lds + (bf) * SHM_K + kws_ + 32 * 256) = S.st_k1; } while (0)
#define SWRITE_HV(bf) do { const int vs0_ = vst0, vs1_ = vst1; \
        *(LAS bf16x8*)(V_lds + (bf) * SHM_V + vs0_) = S.st_v0; *(LAS bf16x8*)(V_lds + (bf) * SHM_V + vs1_) = S.st_v1; } while (0)
#define SWRITE_H(bf) do { SWRITE_HV(bf); SWRITE_HK(bf); } while (0)
__device__ __forceinline__ unsigned q_off(const BlockRef& r) { return (unsigned)WS_QA + (unsigned)(r.P0 * STR + r.h * 128) * 2u; }
__device__ __forceinline__ unsigned k_off(const BlockRef& r) { return (unsigned)WS_KA + (unsigned)(r.h * 128) * 2u; }
__device__ __forceinline__ void prime(const BlockRef& cur, gp_t ws, lp_t lds, Seam& S, int tid) {
    const int wid = __builtin_amdgcn_readfirstlane(tid >> 6), lane = tid & 63, r32 = lane & 31, hi = lane >> 5;
    lp_t K_lds = lds + 2 * SHM_V;
    const unsigned qo = (unsigned)((wid * QBLK + r32) * STR + hi * 8) * 2u;
    const unsigned so0 = (unsigned)((tid >> 4) * STR + (tid & 15) * 8) * 2u, so1 = so0 + 32u * STR * 2u; const int kws = KSWZ(tid >> 4, (tid & 15) * 16);
    const unsigned qb_ = q_off(cur) + qo, ko_ = k_off(cur);
#pragma unroll
    for (int d0 = 0; d0 < 8; ++d0) S.qr[d0] = LD8W(qb_ + d0 * 32);
    SLOAD_H(ko_, cur.t0 * KVBLK); VMW(); SWRITE_HK(0);
    __syncthreads();
}
__device__ __forceinline__ void block(const BlockRef& cur, const BlockRef& nxt, gp_t ws, lp_t lds, Seam& S, int b, int tid) {
    const int wid = __builtin_amdgcn_readfirstlane(tid >> 6), lane = tid & 63, r32 = lane & 31, hi = lane >> 5;
    const int NT = cur.nt, T0 = cur.t0, NTA = cur.P0 / KVBLK + QB / KVBLK;
    const int qrow = cur.P0 + wid * QBLK + r32;
    lp_t V_lds = lds; lp_t K_lds = lds + 2 * SHM_V;
    LAS float* wsf = (LAS float*)(lds + 2 * SHM_V + 2 * SHM_K) + wid * 64; LAS float* li_l = wsf; LAS float* al_l = wsf + 32;
    const LAS float* bT = (const LAS float*)(lds + BIAS_OFF) + cur.h * 132;
    float m_reg = -1e30f, l_reg = 0; f32x16 o[4]; o[0] = zero16(); o[1] = zero16(); o[2] = zero16(); o[3] = zero16();
    const int vb0 = (int)(unsigned)(uintptr_t)V_lds + v_rd_base(lane);
    const unsigned so0 = (unsigned)((tid >> 4) * STR + (tid & 15) * 8) * 2u, so1 = so0 + 32u * STR * 2u; const int kws = KSWZ(tid >> 4, (tid & 15) * 16), vst0 = v_st(tid >> 4, (tid & 15) * 8), vst1 = v_st(32 + (tid >> 4), (tid & 15) * 8);
    const unsigned ko_ = k_off(cur);
    const unsigned pbo = (unsigned)WS_POS + (unsigned)b * (SEQ * 4u);
    const int pq = *(const GAS int*)(ws + (unsigned)(pbo + (unsigned)qrow * 4u));
    const int qmin = *(const GAS int*)(ws + (unsigned)((unsigned)WS_KMAX + (unsigned)(1024 + b * 512 + (cur.P0 >> 5) + wid) * 4u));
    const unsigned mo = (unsigned)WS_MASK + (unsigned)qrow * 8u;
    int nearfirst = NTA;
    { const unsigned kmo = (unsigned)WS_KMAX + (unsigned)b * 1024u;
#pragma unroll 1
      for (int t0 = 0; t0 < NTA; t0 += 64) { const int t_ = t0 + lane; const int km = *(const GAS int*)(ws + (unsigned)(kmo + (unsigned)(t_ < NTA ? t_ : NTA - 1) * 4u));
          const unsigned long long bal = __ballot(t_ < NTA && qmin - km < 128);
          if (bal) { nearfirst = t0 + (int)__builtin_ctzll(bal); break; } } }
#define MLOAD(t) (*(const GAS v2u*)(ws + (unsigned)((unsigned)(T0 + (t)) * (HROWS * 8u) + mo)))
#define RESC(a) do { if (__any((a) < 1.f)) { if (hi == 0) al_l[r32] = (a); asm volatile("s_waitcnt lgkmcnt(0)" ::: "memory");              \
                     for (int d_ = 0; d_ < 4; ++d_) for (int r = 0; r < 16; ++r) o[d_][r] *= al_l[crow(r, hi)]; } } while (0)
#define KBASE(t) ((T0 + (t)) * KVBLK)
#define MASKT(P0_, P1_, t, MW) do { if (T0 + (t) >= nearfirst) bias_tile(P0_, P1_, ws, pbo + (unsigned)KBASE(t) * 4u, pq, bT, hi); apply_mask(P0_, P1_, MW, hi); } while (0)
    f32x16 pA0, pA1, pB0, pB1; float mnA, mnB, alA, alB; bf16x8 pa0, pa1, pa2, pa3;
    v2u mwc = MLOAD(0);
    SWRITE_HV(0); SBAR();
    if (NT > 1) { SLOAD_H(ko_, KBASE(1)); }
    SBAR(); qkt<0>(pA0, pA1, K_lds, r32, hi, S.qr);
    MASKT(pA0, pA1, 0, mwc); partialSM(pA0, pA1, m_reg, mnA, alA);
    if (NT > 1) { VMW(); SWRITE_H(1); }
    __syncthreads();
#define HALF_STEP(PX0, PX1, mnX, alX, PY0, PY1, alY, t, KB, VB, SB) do {                                                      \
        mwc = MLOAD(t);                                                                                                        \
        SBAR(); qkt<KB>(PX0, PX1, K_lds, r32, hi, S.qr);                                                                      \
        finishSM(PY0, PY1, alY, l_reg, pa0, pa1, pa2, pa3); SBAR();                                                           \
        if ((t) + 1 < NT) { SLOAD_H(ko_, KBASE((t) + 1)); SBAR(); }                                                           \
        pv_tile<VB>(o, vb0, pa0, pa1, pa2, pa3); MASKT(PX0, PX1, (t), mwc); partialSM(PX0, PX1, m_reg, mnX, alX);             \
        __syncthreads();                                                                                                      \
        if ((t) + 1 < NT) { VMW(); SWRITE_H(SB); }                                                                            \
        RESC(alX); __syncthreads(); } while (0)
#pragma unroll 1
    for (int t = 1; t + 1 < NT; t += 2) {
        HALF_STEP(pB0, pB1, mnB, alB, pA0, pA1, alA, t, 1, 0, 0);
        HALF_STEP(pA0, pA1, mnA, alA, pB0, pB1, alB, t + 1, 0, 1, 1);
    }
    mwc = MLOAD(NT - 1);
    SBAR(); qkt<1>(pB0, pB1, K_lds, r32, hi, S.qr); SBAR();
    { const unsigned kn_ = k_off(nxt); SLOAD_H(kn_, nxt.t0 * KVBLK); } SBAR();
    int lane_t = lane; asm volatile("" : "+v"(lane_t));
    { const unsigned qn_ = q_off(nxt) + (unsigned)((wid * QBLK + (lane_t & 31)) * STR + (lane_t >> 5) * 8) * 2u;
#pragma unroll
      for (int d0 = 0; d0 < 8; ++d0) S.qr[d0] = LD8W(qn_ + d0 * 32); }
    SBAR();
    finishSM(pA0, pA1, alA, l_reg, pa0, pa1, pa2, pa3); SBAR();
    pv_tile<0>(o, vb0, pa0, pa1, pa2, pa3);
    MASKT(pB0, pB1, NT - 1, mwc); partialSM(pB0, pB1, m_reg, mnB, alB); __syncthreads(); RESC(alB);
    finishSM(pB0, pB1, alB, l_reg, pa0, pa1, pa2, pa3); SBAR(); pv_tile<1>(o, vb0, pa0, pa1, pa2, pa3);
    SBAR(); VMW(); SWRITE_HK(0); SBAR();
    if (cur.pidx >= 0) {
        const unsigned po = (unsigned)WS_APART + (unsigned)cur.pidx * (QB * 128u * 4u) + (unsigned)((wid * QBLK + 4 * (lane_t >> 5)) * 128 + (lane_t & 31)) * 4u;
#pragma unroll
        for (int r = 0; r < 16; ++r) { const int orc = (r & 3) + 8 * (r >> 2);
#pragma unroll
            for (int d0 = 0; d0 < 4; ++d0) *(GAS float*)((GAS char*)ws + (unsigned)(po + (unsigned)(orc * 128 + d0 * 32) * 4u)) = o[d0][r]; }
        if ((lane_t >> 5) == 0) { typedef float f2_t __attribute__((ext_vector_type(2)));
            *(GAS f2_t*)((GAS char*)ws + (unsigned)((unsigned)WS_AML + (unsigned)(cur.pidx * QB + wid * QBLK + (lane_t & 31)) * 8u)) = (f2_t){m_reg, l_reg}; }
    } else {
    if (hi == 0) li_l[r32] = l_reg; asm volatile("s_waitcnt lgkmcnt(0)" ::: "memory");
    float rli[16];
#pragma unroll
    for (int r = 0; r < 16; ++r) rli[r] = __builtin_amdgcn_rcpf(li_l[crow(r, hi)]);
    const unsigned oo = (unsigned)WS_OBR + (unsigned)HROWS * 768u * 2u + (unsigned)((cur.P0 + wid * QBLK + 4 * (lane_t >> 5)) * STR + cur.h * 128 + (lane_t & 31)) * 2u;
#pragma unroll
    for (int r = 0; r < 16; ++r) { const int orc = (r & 3) + 8 * (r >> 2);
#pragma unroll
        for (int d0 = 0; d0 < 4; ++d0) { const float v = o[d0][r] * rli[r];
            const float vn = __uint_as_float((unsigned)__builtin_amdgcn_update_dpp(0, (int)__float_as_uint(v), 0xB1, 0xF, 0xF, false));
            if ((r32 & 1) == 0) *(GAS unsigned*)((GAS char*)ws + (unsigned)(oo + (unsigned)(orc * STR + d0 * 32) * 2u)) = cvtpk(v, vn); } }
    }
    __syncthreads();
#undef MLOAD
#undef RESC
#undef KBASE
#undef MASKT
#undef HALF_STEP
}
#undef LD8W
#undef VMW
#undef SLOAD_H
#undef SWRITE_HK
#undef SWRITE_HV
#undef SWRITE_H
}

constexpr int ATT_NIT = 480, ATT_QSPLIT = 48;
__device__ __forceinline__ att::BlockRef att_ref(int i) { att::BlockRef r; int qb, h, part = -1;
    if (i < 96) { qb = 47 - i / 6; h = i % 6; }
    else if (i < 336) { const int j = i - 96, p = j / 30, q = j % 30;
        if (q < 12) { qb = 63 - 2 * p; part = q / 6; h = q % 6; } else if (q < 18) { qb = 31 - p; h = q - 12; } else { qb = 62 - 2 * p; part = (q - 18) / 6; h = (q - 18) % 6; } }
    else { const int j = i - 336; qb = 23 - j / 6; h = j % 6; }
    r.P0 = qb * 256; r.h = h; const int nta = 4 * (qb + 1);
    if (part < 0) { r.t0 = 0; r.nt = nta; r.pidx = -1; } else { r.t0 = part * (nta / 2); r.nt = nta / 2; r.pidx = ((qb - ATT_QSPLIT) * 6 + h) * 2 + part; }
    return r; }
__device__ __forceinline__ int att_item(int k, int G, int c) { return (k & 1) ? (k + 1) * G - 1 - c : k * G + c; }
__device__ __forceinline__ int att_head_item(int h, int j) {
    if (j < 16) return 6 * j + h;
    if (j < 56) { const int jj = j - 16, p = jj / 5, q5 = jj % 5; const int q = q5 == 0 ? h : q5 == 1 ? 6 + h : q5 == 2 ? 12 + h : q5 == 3 ? 18 + h : 24 + h; return 96 + 30 * p + q; }
    return 336 + 6 * (j - 56) + h;
}
__device__ __forceinline__ int att_xcd_item(int x, int n) { const int g = 3 * x + n % 3, h = g >> 2, j = (g & 3) + 4 * (n / 3); return att_head_item(h, j); }
__device__ __forceinline__ void p_attn(Frame& F0, int b) {
    Frame F = F0; GAS unsigned char* wsg_ = (GAS unsigned char*)F.ws; F.tid = F.wave * 64 + lane_id(); asm volatile("" : "+v"(F.tid), "+s"(wsg_), "+s"(F.vcu), "+s"(F.G)); F.lane = F.tid & 63;
    att::gp_t ws = (att::gp_t)wsg_;
    att::lp_t lds = (att::lp_t)F.lds;
    { LAS float* bT = (LAS float*)(lds + att::BIAS_OFF);
        for (int i = F.tid; i < 6 * 129; i += NTHR) { const int h = i / 129, d = i % 129;
            const int bk = d < 16 ? d : 16 + (d >= 19) + (d >= 21) + (d >= 24) + (d >= 27) + (d >= 31) + (d >= 35) + (d >= 40) + (d >= 46) + (d >= 52) + (d >= 59) + (d >= 67) + (d >= 77) + (d >= 87) + (d >= 99) + (d >= 113);
            bT[h * 132 + d] = (F.rel[bk * 6 + h] - F.rel[31 * 6 + h]) * (1.0f / att::SCALE); } }
    LDS_WAIT(); __syncthreads();
    const bool xcd = F.G == 256; const int x = F.vcu >> 5, rk = F.vcu & 31;
    int k = 0, i = xcd ? att_xcd_item(x, rk) : att_item(0, F.G, F.vcu);
    if (i >= ATT_NIT) return;
    att::BlockRef cur = att_ref(i); att::Seam S;
    att::prime(cur, ws, lds, S, F.tid);
#pragma unroll 1
    for (;;) { int in;
        if (xcd) in = (k == 0 && 63 - rk < 60) ? att_xcd_item(x, 63 - rk) : ATT_NIT; else in = att_item(k + 1, F.G, F.vcu);
        const bool last = in >= ATT_NIT;
        const att::BlockRef nxt = last ? cur : att_ref(in);
        att::block(cur, nxt, ws, lds, S, b, F.tid);
        if (last) break;
        cur = nxt; ++k; }
}
__device__ __forceinline__ void p_attn_combine(Frame& F0) {
    Frame F = F0; { GAS unsigned char* wsg_ = (GAS unsigned char*)F.ws; F.tid = F.wave * 64 + lane_id(); asm volatile("" : "+v"(F.tid), "+s"(wsg_), "+s"(F.vcu), "+s"(F.G)); F.lane = F.tid & 63; F.ws = (unsigned char*)wsg_; }
    typedef float f2_t __attribute__((ext_vector_type(2)));
    const float* AP = (const float*)(F.ws + WS_APART); const f2_t* ML = (const f2_t*)(F.ws + WS_AML); bf16* OA = (bf16*)(F.ws + WS_OBR) + (size_t)HROWS * 768;
    constexpr float C2 = 1.4426950408889634f * att::SCALE;
    const int total = 96 * 256 * 16;
#pragma unroll 1
    for (int i = F.vcu * NTHR + F.tid; i < total; i += F.G * NTHR) { const int c8 = (i & 15) * 8, row = (i >> 4) & 255, blk = i >> 12;
        const f2_t a = ML[(size_t)(2 * blk) * 256 + row], bq = ML[(size_t)(2 * blk + 1) * 256 + row];
        const float m = fmaxf(a.x, bq.x), f0 = __builtin_amdgcn_exp2f((a.x - m) * C2), f1 = __builtin_amdgcn_exp2f((bq.x - m) * C2), inv = 1.0f / (a.y * f0 + bq.y * f1);
        const f32x4* p0 = (const f32x4*)(AP + ((size_t)(2 * blk) * 256 + row) * 128 + c8); const f32x4* p1 = (const f32x4*)(AP + ((size_t)(2 * blk + 1) * 256 + row) * 128 + c8);
        const f32x4 x0 = (p0[0] * f0 + p1[0] * f1) * inv, x1 = (p0[1] * f0 + p1[1] * f1) * inv;
        const int qb = ATT_QSPLIT + blk / 6, h = blk % 6;
        *(v4u*)(OA + (size_t)(qb * 256 + row) * 768 + h * 128 + c8) = pack8bf(x0, x1); }
}

constexpr int PT128 = 136, PT64 = 72;
#define MFMA16(a, b, c) __builtin_amdgcn_mfma_f32_16x16x32_bf16((a), (b), (c), 0, 0, 0)
__device__ __forceinline__ bf16x8 ldsfrag(const LAS unsigned short* base, int row, int pitch, int k) { return *(const LAS bf16x8*)(base + row * pitch + k); }
__device__ __forceinline__ float log2_gamma(int h) {
    const float x = __builtin_amdgcn_exp2f(-5.0f - (float)h);
    return -x * (1.0f + x * (0.5f + x * (0.33333334f + x * (0.25f + x * (0.2f + x * 0.16666667f))))) * 1.4426950408889634f;
}
__device__ __forceinline__ void unpack8(const v4u w, float (&f)[8]) { f[0] = bflo(w.x); f[1] = bfhi(w.x); f[2] = bflo(w.y); f[3] = bfhi(w.y); f[4] = bflo(w.z); f[5] = bfhi(w.z); f[6] = bflo(w.w); f[7] = bfhi(w.w); }
__device__ __forceinline__ v4u pack8f(const float (&f)[8]) { v4u w; w.x = pk2(f[0], f[1]); w.y = pk2(f[2], f[3]); w.z = pk2(f[4], f[5]); w.w = pk2(f[6], f[7]); return w; }

__device__ __forceinline__ void mix_sg_item(const Frame& F, const float* sgn, const float* sgw, const float* sgb, int n, int g) {
    LAS unsigned short* Wm = (LAS unsigned short*)(F.lds);
    LAS unsigned short* vnT = (LAS unsigned short*)(F.lds + 34816);
    LAS unsigned short* strip = (LAS unsigned short*)(F.lds + 69632) + F.wave * (16 * PT128);
    LAS float* rs = (LAS float*)(F.lds + 104448);
    const bf16* VS = (const bf16*)(F.ws + WS_VS); const bf16* US = (const bf16*)(F.ws + WS_US); bf16* OS = (bf16*)(F.ws + WS_OBR) + (size_t)2 * HROWS * 768;
    int lane_ = lane_id();
    const int r0 = n * 128, lane = lane_, w = F.wave, tid = w * 64 + lane, fr = lane & 15, fq = lane >> 4;
#pragma unroll 4
    for (int i = 0; i < 16; ++i) { const int t = w * 16 + i; const v4u x = *(const v4u*)(VS + (size_t)(r0 + t) * 512 + lane * 8); float f[8]; unpack8(x, f); float ss = 0.f;
#pragma unroll
        for (int j = 0; j < 8; ++j) ss += f[j] * f[j];
        ss = wave_sum(ss); if (lane == 0) rs[t] = 1.0f / sqrtf(ss * (1.0f / 512.0f) + EPS); }
    { const int t = tid >> 2, s0 = (tid & 3) * 32; const float* wr = sgw + ((size_t)g * 128 + t) * 128 + s0;
#pragma unroll
        for (int q = 0; q < 4; ++q) { const f32x4 a = *(const f32x4*)(wr + 8 * q), b = *(const f32x4*)(wr + 8 * q + 4); float f[8] = {a[0], a[1], a[2], a[3], b[0], b[1], b[2], b[3]};
#pragma unroll
            for (int j = 0; j < 8; ++j) f[j] = (s0 + 8 * q + j <= t) ? f[j] : 0.f;
            *(LAS v4u*)(Wm + t * PT128 + s0 + 8 * q) = pack8f(f); } }
    LDS_WAIT(); __syncthreads();
    { const int s = tid >> 2, d0 = (tid & 3) * 32; const float r = rs[s];
#pragma unroll
        for (int q = 0; q < 4; ++q) { const v4u x = *(const v4u*)(VS + (size_t)(r0 + s) * 512 + g * 128 + d0 + 8 * q); float f[8]; unpack8(x, f);
            const f32x4 ga = *(const f32x4*)(sgn + g * 128 + d0 + 8 * q), gb = *(const f32x4*)(sgn + g * 128 + d0 + 8 * q + 4); const float gg[8] = {ga[0], ga[1], ga[2], ga[3], gb[0], gb[1], gb[2], gb[3]};
#pragma unroll
            for (int j = 0; j < 8; ++j) vnT[(d0 + 8 * q + j) * PT128 + s] = (unsigned short)f2bf(f[j] * r * gg[j]); } }
    LDS_WAIT(); __syncthreads();
    f32x4 acc[8];
#pragma unroll
    for (int cb = 0; cb < 8; ++cb) acc[cb] = zero4();
    const int nks = (16 * w + 15) / 32 + 1;
#pragma unroll 1
    for (int ks = 0; ks < nks; ++ks) { const bf16x8 a = ldsfrag(Wm, 16 * w + fr, PT128, 32 * ks + 8 * fq);
#pragma unroll
        for (int cb = 0; cb < 8; ++cb) acc[cb] = MFMA16(a, ldsfrag(vnT, 16 * cb + fr, PT128, 32 * ks + 8 * fq), acc[cb]); }
#pragma unroll
    for (int reg = 0; reg < 4; ++reg) { const int tl = 4 * fq + reg; const float bias = sgb[g * 128 + 16 * w + tl];
#pragma unroll
        for (int cb = 0; cb < 8; ++cb) strip[tl * PT128 + 16 * cb + fr] = (unsigned short)f2bf(acc[cb][reg] + bias); }
    LDS_WAIT(); asm volatile("" ::: "memory");
#pragma unroll
    for (int i = 0; i < 4; ++i) { const int c = lane + 64 * i, row = c >> 4, col = (c & 15) * 8; const size_t r = (size_t)(r0 + 16 * w + row);
        const v4u m = *(const LAS v4u*)(strip + row * PT128 + col); const v4u u = *(const v4u*)(US + r * 512 + g * 128 + col); float fm[8], fu[8]; unpack8(m, fm); unpack8(u, fu);
#pragma unroll
        for (int j = 0; j < 8; ++j) fm[j] *= fu[j];
        *(v4u*)(OS + r * 768 + g * 128 + col) = pack8f(fm); }
    { const int i0 = tid * 2;
#pragma unroll
        for (int i = i0; i < i0 + 2; ++i) { const int row = i >> 3, c8 = (i & 7) * 8; *(v4u*)(OS + (size_t)(r0 + row) * 768 + 512 + g * 64 + c8) = zero4u(); } }
    __syncthreads();
}
__device__ __forceinline__ void mix_r1_item(const Frame& F, int h, int n) {
    LAS unsigned short* VT = (LAS unsigned short*)(F.lds);
    LAS unsigned short* KdT = (LAS unsigned short*)(F.lds + 34816);
    const bf16* QKR = (const bf16*)(F.ws + WS_QKR); const bf16* VR = (const bf16*)(F.ws + WS_VR); float* KV = (float*)(F.ws + WS_KVST) + ((size_t)h * 128 + n) * 8192;
    int lane_ = lane_id();
    const int r0 = n * 128, lane = lane_, w = F.wave, tid = w * 64 + lane, fr = lane & 15, fq = lane >> 4; const float lg2 = log2_gamma(h);
    { const int s = tid >> 2, v0 = (tid & 3) * 32;
#pragma unroll
        for (int q = 0; q < 4; ++q) { const v4u x = *(const v4u*)(VR + (size_t)(r0 + s) * 768 + h * 128 + v0 + 8 * q);
            const unsigned xs[4] = {x.x, x.y, x.z, x.w};
#pragma unroll
            for (int j = 0; j < 4; ++j) { VT[(v0 + 8 * q + 2 * j) * PT128 + s] = (unsigned short)(xs[j] & 0xffffu); VT[(v0 + 8 * q + 2 * j + 1) * PT128 + s] = (unsigned short)(xs[j] >> 16); } } }
    { const int s = tid >> 2, d0 = (tid & 3) * 16; const float dec = __builtin_amdgcn_exp2f((float)(127 - s) * lg2);
#pragma unroll
        for (int q = 0; q < 2; ++q) { const v4u x = *(const v4u*)(QKR + (size_t)(r0 + s) * 768 + 384 + h * 64 + d0 + 8 * q); float f[8]; unpack8(x, f);
#pragma unroll
            for (int j = 0; j < 8; ++j) KdT[(d0 + 8 * q + j) * PT128 + s] = (unsigned short)f2bf(f[j] * dec); } }
    LDS_WAIT(); __syncthreads();
    f32x4 acc[4];
#pragma unroll
    for (int cb = 0; cb < 4; ++cb) acc[cb] = zero4();
#pragma unroll
    for (int ks = 0; ks < 4; ++ks) { const bf16x8 a = ldsfrag(VT, 16 * w + fr, PT128, 32 * ks + 8 * fq);
#pragma unroll
        for (int cb = 0; cb < 4; ++cb) acc[cb] = MFMA16(a, ldsfrag(KdT, 16 * cb + fr, PT128, 32 * ks + 8 * fq), acc[cb]); }
#pragma unroll
    for (int cb = 0; cb < 4; ++cb)
#pragma unroll
        for (int reg = 0; reg < 4; ++reg) KV[(16 * w + 4 * fq + reg) * 64 + 16 * cb + fr] = acc[cb][reg];
    __syncthreads();
}
__device__ __forceinline__ void mix_r2(const Frame& F) {
    float* KVb = (float*)(F.ws + WS_KVST); LAS float* car = (LAS float*)(F.lds);
    const int tid = F.wave * 64 + lane_id(), el = tid & 63, seg = tid >> 6;
#pragma unroll 1
    for (int blk = F.vcu; blk < RH * 8192 / 64; blk += F.G) { const int e0 = blk * 64 + el, h = e0 >> 13, e = e0 & 8191;
        const float cd = __builtin_amdgcn_exp2f(128.0f * log2_gamma(h));
        float* p = KVb + (size_t)h * 128 * 8192 + (size_t)(seg * 16) * 8192 + e; float kv[16];
#pragma unroll
        for (int n = 0; n < 16; ++n) kv[n] = p[(size_t)n * 8192];
        float st = 0.f;
#pragma unroll
        for (int n = 0; n < 16; ++n) { const float t = kv[n]; kv[n] = st; st = st * cd + t; }
        car[seg * 64 + el] = st; LDS_WAIT(); __syncthreads();
        float cin = 0.f, cd16 = cd; cd16 *= cd16; cd16 *= cd16; cd16 *= cd16; cd16 *= cd16;
#pragma unroll 1
        for (int s2 = 0; s2 < seg; ++s2) cin = cin * cd16 + car[s2 * 64 + el];
        float f = 1.f;
#pragma unroll
        for (int n = 0; n < 16; ++n) { p[(size_t)n * 8192] = kv[n] + cin * f; f *= cd; }
        __syncthreads(); }
}
__device__ __forceinline__ void mix_r3_item(const Frame& F, const float* retn, int h, int n) {
    LAS unsigned short* Qs = (LAS unsigned short*)(F.lds);
    LAS unsigned short* Ks = (LAS unsigned short*)(F.lds + 18432);
    LAS unsigned short* VT = (LAS unsigned short*)(F.lds + 36864);
    LAS unsigned short* PT = (LAS unsigned short*)(F.lds + 71680);
    LAS unsigned short* strip = (LAS unsigned short*)(F.lds + 90112) + F.wave * (16 * PT128);
    const bf16* QKR = (const bf16*)(F.ws + WS_QKR); const bf16* VR = (const bf16*)(F.ws + WS_VR); const bf16* GR = (const bf16*)(F.ws + WS_GR); bf16* OR = (bf16*)(F.ws + WS_OBR);
    const float* KV = (const float*)(F.ws + WS_KVST) + ((size_t)h * 128 + n) * 8192;
    int lane_ = lane_id();
    const int r0 = n * 128, lane = lane_, w = F.wave, tid = w * 64 + lane, fr = lane & 15, fq = lane >> 4; const float lg2 = log2_gamma(h);
    { const int s = tid >> 2, d0 = (tid & 3) * 16; const bf16* src = QKR + (size_t)(r0 + s) * 768 + h * 64 + d0;
#pragma unroll
        for (int q = 0; q < 2; ++q) { *(LAS v4u*)(Qs + s * PT64 + d0 + 8 * q) = *(const v4u*)(src + 8 * q); *(LAS v4u*)(Ks + s * PT64 + d0 + 8 * q) = *(const v4u*)(src + 384 + 8 * q); } }
    { const int s = tid >> 2, v0 = (tid & 3) * 32;
#pragma unroll
        for (int q = 0; q < 4; ++q) { const v4u x = *(const v4u*)(VR + (size_t)(r0 + s) * 768 + h * 128 + v0 + 8 * q);
            const unsigned xs[4] = {x.x, x.y, x.z, x.w};
#pragma unroll
            for (int j = 0; j < 4; ++j) { VT[(v0 + 8 * q + 2 * j) * PT128 + s] = (unsigned short)(xs[j] & 0xffffu); VT[(v0 + 8 * q + 2 * j + 1) * PT128 + s] = (unsigned short)(xs[j] >> 16); } } }
    { const int v = tid >> 2, d0 = (tid & 3) * 16; const float* src = KV + v * 64 + d0;
#pragma unroll
        for (int q = 0; q < 2; ++q) *(LAS v4u*)(PT + v * PT64 + d0 + 8 * q) = pack8bf(*(const f32x4*)(src + 8 * q), *(const f32x4*)(src + 8 * q + 4)); }
    LDS_WAIT(); __syncthreads();
    const bf16x8 qa0 = ldsfrag(Qs, 16 * w + fr, PT64, 8 * fq), qa1 = ldsfrag(Qs, 16 * w + fr, PT64, 32 + 8 * fq);
    f32x4 acc[8];
#pragma unroll
    for (int cb = 0; cb < 8; ++cb) { acc[cb] = zero4();
        acc[cb] = MFMA16(qa0, ldsfrag(PT, 16 * cb + fr, PT64, 8 * fq), acc[cb]); acc[cb] = MFMA16(qa1, ldsfrag(PT, 16 * cb + fr, PT64, 32 + 8 * fq), acc[cb]); }
#pragma unroll
    for (int reg = 0; reg < 4; ++reg) { const float f = 0.125f * __builtin_amdgcn_exp2f((float)(16 * w + 4 * fq + reg + 1) * lg2);
#pragma unroll
        for (int cb = 0; cb < 8; ++cb) acc[cb][reg] *= f; }
    const int nb = (w | 1) + 1;
#pragma unroll 1
    for (int cb = 0; cb < nb; ++cb) { f32x4 sa = zero4();
        sa = MFMA16(qa0, ldsfrag(Ks, 16 * cb + fr, PT64, 8 * fq), sa); sa = MFMA16(qa1, ldsfrag(Ks, 16 * cb + fr, PT64, 32 + 8 * fq), sa);
        const int s = 16 * cb + fr;
#pragma unroll
        for (int reg = 0; reg < 4; ++reg) { const int t = 16 * w + 4 * fq + reg; const float p = (s <= t) ? sa[reg] * 0.125f * __builtin_amdgcn_exp2f((float)(t - s) * lg2) : 0.f;
            strip[(4 * fq + reg) * PT128 + s] = (unsigned short)f2bf(p); } }
    LDS_WAIT(); asm volatile("" ::: "memory");
    const int nks = (w >> 1) + 1;
#pragma unroll 1
    for (int ks = 0; ks < nks; ++ks) { const bf16x8 a = ldsfrag(strip, fr, PT128, 32 * ks + 8 * fq);
#pragma unroll
        for (int cb = 0; cb < 8; ++cb) acc[cb] = MFMA16(a, ldsfrag(VT, 16 * cb + fr, PT128, 32 * ks + 8 * fq), acc[cb]); }
    LDS_WAIT(); asm volatile("" ::: "memory");
#pragma unroll
    for (int reg = 0; reg < 4; ++reg) { float sum = 0.f;
#pragma unroll
        for (int cb = 0; cb < 8; ++cb) sum += acc[cb][reg];
        sum += __shfl_xor(sum, 1); sum += __shfl_xor(sum, 2); sum += __shfl_xor(sum, 4); sum += __shfl_xor(sum, 8);
        const float mu = sum * (1.0f / 128.0f); float q = 0.f;
#pragma unroll
        for (int cb = 0; cb < 8; ++cb) { const float d = acc[cb][reg] - mu; q += d * d; }
        q += __shfl_xor(q, 1); q += __shfl_xor(q, 2); q += __shfl_xor(q, 4); q += __shfl_xor(q, 8);
        const float rsd = 1.0f / sqrtf(q * (1.0f / 128.0f) + EPS);
#pragma unroll
        for (int cb = 0; cb < 8; ++cb) strip[(4 * fq + reg) * PT128 + 16 * cb + fr] = (unsigned short)f2bf((acc[cb][reg] - mu) * rsd); }
    LDS_WAIT(); asm volatile("" ::: "memory");
#pragma unroll
    for (int i = 0; i < 4; ++i) { const int c = lane + 64 * i, row = c >> 4, col = (c & 15) * 8; const size_t r = (size_t)(r0 + 16 * w + row);
        const v4u y = *(const LAS v4u*)(strip + row * PT128 + col); const v4u gg = *(const v4u*)(GR + r * 768 + h * 128 + col); float fy[8], fg[8]; unpack8(y, fy); unpack8(gg, fg);
        const f32x4 na = *(const f32x4*)(retn + h * 128 + col), nb2 = *(const f32x4*)(retn + h * 128 + col + 4); const float nn[8] = {na[0], na[1], na[2], na[3], nb2[0], nb2[1], nb2[2], nb2[3]};
#pragma unroll
        for (int j = 0; j < 8; ++j) fy[j] = fy[j] * nn[j] * fg[j];
        *(v4u*)(OR + r * 768 + h * 128 + col) = pack8f(fy); }
    __syncthreads();
}
__device__ __forceinline__ void p_mix2(Frame& F0, const Args& a, int l) {
    Frame F = F0; { GAS unsigned char* wsg_ = (GAS unsigned char*)F.ws; F.tid = F.wave * 64 + lane_id(); asm volatile("" : "+v"(F.tid), "+s"(wsg_), "+s"(F.vcu), "+s"(F.G)); F.lane = F.tid & 63; F.ws = (unsigned char*)wsg_; }
    const float* sgn = (const float*)a.in[10] + (size_t)l * 512; const float* sgw = (const float*)a.in[11] + (size_t)l * 4 * 128 * 128; const float* sgb = (const float*)a.in[12] + (size_t)l * 512;
#pragma unroll 1
    for (int rp = 0, nr = rep_count(PROBE_SGR1); rp < nr; ++rp) {
#pragma unroll 1
    for (int it = F.vcu; it < 512; it += F.G) mix_sg_item(F, sgn, sgw, sgb, it >> 2, it & 3);
#pragma unroll 1
    for (int it = F.vcu; it < 768; it += F.G) mix_r1_item(F, it % 6, it / 6);
    }
#pragma unroll 1
    for (int rp = 0, nr = rep_count(PROBE_IDX); rp < nr; ++rp)
#pragma unroll 1
    for (int pq = F.vcu; pq < 256; pq += F.G) {
#pragma unroll 1
        for (int hh = 0; hh < 2; ++hh) idx::item(F, hh ? 511 - pq : pq); }
}
__device__ __forceinline__ void p_mix3(Frame& F0) {
    Frame F = F0; { GAS unsigned char* wsg_ = (GAS unsigned char*)F.ws; F.tid = F.wave * 64 + lane_id(); asm volatile("" : "+v"(F.tid), "+s"(wsg_), "+s"(F.vcu), "+s"(F.G)); F.lane = F.tid & 63; F.ws = (unsigned char*)wsg_; }
    mix_r2(F);
}
__device__ __forceinline__ void p_mix4(Frame& F0, const Args& a, int l) {
    Frame F = F0; { GAS unsigned char* wsg_ = (GAS unsigned char*)F.ws; F.tid = F.wave * 64 + lane_id(); asm volatile("" : "+v"(F.tid), "+s"(wsg_), "+s"(F.vcu), "+s"(F.G)); F.lane = F.tid & 63; F.ws = (unsigned char*)wsg_; }
    const float* retn = (const float*)a.in[9] + (size_t)l * 768;
#pragma unroll 1
    for (int rp = 0, nr = rep_count(PROBE_R3); rp < nr; ++rp)
#pragma unroll 1
    for (int it = F.vcu; it < 768; it += F.G) mix_r3_item(F, retn, it % 6, it / 6);
}
#ifndef PROBE_GU
#define PROBE_GU 1
#endif
#ifndef PROBE_GU_SKIP
#define PROBE_GU_SKIP 0
#endif
#ifndef PROBE_BARS
#define PROBE_BARS 0
#endif
#ifndef PROBE_RS
#define PROBE_RS 0
#endif
#ifndef WGM_GU
#define WGM_GU 4
#endif
#ifndef WGM_DOWN
#define WGM_DOWN 4
#endif
#ifndef WGM_PROJ
#define WGM_PROJ 8
#endif
#ifndef WGM_OUT
#define WGM_OUT 4
#endif
#ifndef WGM_MERGE
#define WGM_MERGE 4
#endif
#ifndef OUT_SPLIT
#define OUT_SPLIT 1
#endif
#ifndef DOWN_SEAM
#define DOWN_SEAM 0
#endif
#ifndef DOWN_REV
#define DOWN_REV 0
#endif
#ifndef DOWN_SPLIT
#define DOWN_SPLIT 2
#endif
#ifndef FFN_PARTS
#define FFN_PARTS 2
#endif
constexpr int FROWS = MTOK / FFN_PARTS;
#ifndef PROBE_PROJ_SKIP
#define PROBE_PROJ_SKIP 0
#endif
#ifndef PROBE_DOWN_SKIP
#define PROBE_DOWN_SKIP 0
#endif
#ifndef PROBE_DOWN
#define PROBE_DOWN 1
#endif
#ifndef PROBE_PROJ
#define PROBE_PROJ 1
#endif
#ifndef PROBE_MIX2
#define PROBE_MIX2 1
#endif
#ifndef PROBE_MIX4
#define PROBE_MIX4 1
#endif
#ifndef PROBE_MERGE
#define PROBE_MERGE 1
#endif
#ifndef PROBE_CONV
#define PROBE_CONV 1
#endif
#define REP(K) _Pragma("unroll 1") for (int rep_ = 0, nrep_ = rep_count(K); rep_ < nrep_; ++rep_)
#ifndef EN_GU
#define EN_GU 1
#endif
#ifndef EN_DOWN
#define EN_DOWN 1
#endif
#ifndef EN_PROJ
#define EN_PROJ 1
#endif
#ifndef EN_MERGE
#define EN_MERGE 1
#endif
#ifndef EN_OUT
#define EN_OUT 1
#endif

#ifndef PG8_SP2
#define PG8_SP2 true
#endif
#ifndef PG8_ALIGN
#define PG8_ALIGN true
#endif
__global__ void __launch_bounds__(NTHR, 2) mega_fwd(Args args) {
    extern __shared__ __attribute__((aligned(16))) unsigned char lds[];
    Frame F;
    F.lds = (LAS unsigned char*)lds; F.MISC = (volatile LAS unsigned*)(F.lds + MISC_OFF);
    F.tid = threadIdx.x; F.lane = F.tid & 63; F.wave = __builtin_amdgcn_readfirstlane(F.tid >> 6);
    F.G = gridDim.x; { const int bx = blockIdx.x; F.vcu = (F.G % 8 == 0) ? (bx % 8) * (F.G / 8) + bx / 8 : bx; }
    F.ws = args.ws; F.ctl = (gu32*)(args.ws + WS_CTL);
    F.xin = (const float*)args.in[0]; F.pos = (const int*)args.in[1]; F.rel = (const float*)args.in[2]; F.X = args.out;
    for (int u = F.tid; u < (LDS_BYTES - LDSCTL_OFF) / 4; u += NTHR) ((LAS unsigned*)(F.lds + LDSCTL_OFF))[u] = 0u;
    __syncthreads();
    XcdBarrier bar; bar.bar = (unsigned*)(F.ctl + CW_BAR); bar.x = 0; bar.st = nullptr;
    if (!MK_PER_PHASE) bar = xcd_barrier_post((unsigned*)(F.ctl + CW_BAR), F.MISC + 8);
    const int lo = args.ph_lo, hi = args.ph_hi; int ph = 0;
#define IN() (lo <= ph && ph < hi)
#define SEAM() do { if (!MK_PER_PHASE && lo <= ph && ph + 1 < hi) xcd_barrier(bar, F.wave); ++ph; } while (0)
#define SITE_PTRS() GAS unsigned char* wsg_ = (GAS unsigned char*)args.ws; int sG_ = F.G, sB_ = (int)blockIdx.x; asm volatile("" : "+s"(wsg_), "+s"(sG_), "+s"(sB_)); unsigned char* ws = (unsigned char*)wsg_; float* const part = (float*)(ws + WS_PART); const float* const rstd = (const float*)(ws + WS_RSTD); bf16* const XB = (bf16*)(ws + WS_XB); (void)part; (void)rstd; (void)XB

    if (IN()) p_prologue(F);
    SEAM();
#pragma unroll 1
    for (int l = 0; l < DEPTH; ++l) {
        if (IN()) REP(PROBE_CONV) p_convert(F, args, l);
#pragma unroll 1
        for (int s = 0; s < 3; ++s) {
            if (IN()) p_rowstat(F);
            SEAM();
            if (s != 1) {
#pragma unroll 1
                for (int h = 0; h < FFN_PARTS; ++h) {
                    const size_t r0 = (size_t)h * FROWS;
                    if (IN()) { SITE_PTRS(); const bf16* Wgu = (const bf16*)(ws + (s ? WS_WGU2 : WS_WGU1)); pg8::Gemm g{XB + r0 * DM, Wgu, FROWS, 2 * DFF, DM}; pg8::StaticOrder S; S.init(FROWS, 2 * DFF, sG_, sB_, WGM_GU);
#if EN_GU
                        REP(PROBE_GU) { EpiSwiGLU E{(bf16*)(ws + WS_HID), rstd + r0, (PROBE_GU_SKIP && rep_ + 1 < nrep_) ? 1 : 0};
                        if (PROBE_GU_SKIP == 2 && rep_ + 1 < nrep_) g.kmul = 0; else g.kmul = 1;
                        pg8::gemm_phase<EpiSwiGLU, pg8::StaticOrder, PG8_ALIGN, PG8_SP2>(F.lds + RING_OFF, g, S, E, F.wave); }
#endif
                    }
                    SEAM();
#pragma unroll 1
                    for (int dp = 0; dp < DOWN_SPLIT; ++dp) {
                    const int dq = DOWN_REV ? DOWN_SPLIT - 1 - dp : dp;
                    const size_t rd = r0 + (size_t)dq * (FROWS / DOWN_SPLIT), rl = (size_t)dq * (FROWS / DOWN_SPLIT);
                    if (IN()) { SITE_PTRS(); const bf16* Wd = (const bf16*)(ws + (s ? WS_WD2 : WS_WD1)); pg8::Gemm g{(const bf16*)(ws + WS_HID) + rl * DFF, Wd, FROWS / DOWN_SPLIT, DM, DFF}; pg8::StaticOrder S; S.init(FROWS / DOWN_SPLIT, DM, sG_, sB_, WGM_DOWN);
                        const float* base = (l == 0 && s == 0) ? F.xin : (RESID_BF16 ? (const float*)nullptr : (const float*)F.X);
#if EN_DOWN
                        REP(PROBE_DOWN) { EpiResid E{base ? base + rd * DM : base, F.X + rd * DM, XB + rd * DM, part + rd * 32, rep_ + 1 == nrep_ ? 0.5f : 0.0f, (PROBE_DOWN_SKIP && rep_ + 1 < nrep_) ? 1 : 0};
                        pg8::gemm_phase<EpiResid, pg8::StaticOrder, PG8_ALIGN, PG8_SP2, HID_BLK != 0>(F.lds + RING_OFF, g, S, E, F.wave); }
#endif
                    }
                    if (dp + 1 == DOWN_SPLIT) SEAM(); else if (DOWN_SEAM) SEAM();
                    }
                }
            } else {
#pragma unroll 1
                for (int b = 0; b < BATCH; ++b) {
                    const size_t r0 = (size_t)b * HROWS;
                    if (IN()) { SITE_PTRS(); pg8::Gemm g{XB + r0 * DM, (const bf16*)(ws + WS_WIN), HROWS, NPROJ, DM}; pg8::StaticOrder S; S.init(HROWS, NPROJ, sG_, sB_, WGM_PROJ);
                        const float* rc = (const float*)(ws + WS_ROPE) + r0 * 32;
                        EpiProj E{rstd + r0, rc, rc + (size_t)MTOK * 32, (bf16*)(ws + WS_QKR), (bf16*)(ws + WS_VR), (bf16*)(ws + WS_GR), (bf16*)(ws + WS_QA), (bf16*)(ws + WS_KA), (bf16*)(ws + WS_VA),
                                  (bf16*)(ws + WS_US), (bf16*)(ws + WS_VS), (bf16*)(ws + WS_GATE), (unsigned short*)(ws + WS_QI), (unsigned short*)(ws + WS_KI), (float*)(ws + WS_WI)};
#if EN_PROJ
                        REP(PROBE_PROJ) { E.skip = (PROBE_PROJ_SKIP && rep_ + 1 < nrep_) ? 1 : 0;
                        pg8::gemm_phase<EpiProj, pg8::StaticOrder, PG8_ALIGN, PG8_SP2>(F.lds + RING_OFF, g, S, E, F.wave); }
#endif
                    }
                    SEAM();
                    if (IN()) REP(PROBE_MIX2) p_mix2(F, args, l);
                    SEAM();
                    if (IN()) p_mix3(F);
                    SEAM();
                    if (IN()) REP(PROBE_MIX4) { p_mix4(F, args, l); p_attn(F, b); }
                    SEAM();
                    if (IN()) p_attn_combine(F);
                    SEAM();
                    if (IN()) { SITE_PTRS(); pg8::Gemm g{(const bf16*)(ws + WS_OBR), (const bf16*)(ws + WS_WBR), 3 * HROWS, 3 * DM, 768}; MergeOrder S; S.init(sG_, sB_, WGM_MERGE);
                        EpiMerge E{(const bf16*)(ws + WS_GATE), (bf16*)(ws + WS_MRG)};
#if EN_MERGE
                        REP(PROBE_MERGE)
                        pg8::gemm_phase<EpiMerge, MergeOrder, PG8_ALIGN, PG8_SP2>(F.lds + RING_OFF, g, S, E, F.wave);
#endif
                    }
                    SEAM();
#pragma unroll 1
                    for (int op = 0; op < OUT_SPLIT; ++op) {
                    const size_t ro = r0 + (size_t)op * (HROWS / OUT_SPLIT), rl = (size_t)op * (HROWS / OUT_SPLIT);
                    if (IN()) { SITE_PTRS(); pg8::Gemm g{(const bf16*)(ws + WS_MRG) + rl * DM, (const bf16*)(ws + WS_WOUT), HROWS / OUT_SPLIT, DM, DM}; pg8::StaticOrder S; S.init(HROWS / OUT_SPLIT, DM, sG_, sB_, WGM_OUT);
                        EpiResid E{RESID_BF16 ? (const float*)nullptr : (const float*)(F.X + ro * DM), F.X + ro * DM, XB + ro * DM, part + ro * 32, 1.0f};
#if EN_OUT
                        pg8::gemm_phase<EpiResid, pg8::StaticOrder, PG8_ALIGN, PG8_SP2>(F.lds + RING_OFF, g, S, E, F.wave);
#endif
                    }
                    SEAM();
                    }
                }
            }
        }
    }
#if PROBE_BARS
    if (!MK_PER_PHASE) {
#pragma unroll 1
        for (int rp = 0, nr = rep_count(PROBE_BARS); rp < nr; ++rp) xcd_barrier(bar, F.wave); }
#endif
#if PROBE_RS
#pragma unroll 1
    for (int rp = 0, nr = rep_count(PROBE_RS); rp < nr; ++rp) if (lo == 0) { p_rowstat(F); xcd_barrier(bar, F.wave); }
#endif
    if (IN()) p_final(F, (const float*)args.in[21]);
#undef IN
#undef SEAM
}
constexpr int N_PHASES = 1 + DEPTH * (3 + 2 * (1 + (DOWN_SEAM ? DOWN_SPLIT : 1)) * FFN_PARTS + BATCH * (6 + OUT_SPLIT)) + 1;

extern "C" void kernel_launch(void* const* d_in, const int* in_sizes, int n_in, void* d_out, int out_size, void* d_ws, size_t ws_size, hipStream_t stream) {
    static int grid = 0;
    if (grid == 0) {
        if (n_in != 22 || in_sizes[0] != MTOK * DM || out_size != MTOK * DM || ws_size < WS_END) { fprintf(stderr, "kernel_launch: unexpected shapes (n_in %d, in0 %d, out %d, ws %zu)\n", n_in, n_in > 0 ? in_sizes[0] : -1, out_size, ws_size); grid = -1; return; }
        int dev = 0, cus = 0, per_cu = 0;
        if (hipGetDevice(&dev) != hipSuccess || hipDeviceGetAttribute(&cus, hipDeviceAttributeMultiprocessorCount, dev) != hipSuccess) { grid = -1; return; }
        if (hipFuncSetAttribute((const void*)mega_fwd, hipFuncAttributeMaxDynamicSharedMemorySize, LDS_BYTES) != hipSuccess) { fprintf(stderr, "kernel_launch: hipFuncSetAttribute failed\n"); grid = -1; return; }
        if (hipOccupancyMaxActiveBlocksPerMultiprocessor(&per_cu, (const void*)mega_fwd, NTHR, LDS_BYTES) != hipSuccess || per_cu < 1) fprintf(stderr, "kernel_launch: occupancy query says %d\n", per_cu);
        (void)hipGetLastError();
        grid = cus;
    }
    if (grid < 0) return;
    if (hipMemsetAsync((char*)d_ws + WS_CTL, 0, CTL_ZERO_BYTES, stream) != hipSuccess) return;
    Args a{};
    for (int i = 0; i < 22; ++i) a.in[i] = d_in[i];
    a.out = (float*)d_out; a.ws = (unsigned char*)d_ws;
#if MK_PER_PHASE
    for (int p = 0; p < N_PHASES; ++p) { a.ph_lo = p; a.ph_hi = p + 1; hipLaunchKernelGGL(mega_fwd, dim3(grid), dim3(NTHR), LDS_BYTES, stream, a); }
#else
    a.ph_lo = 0; a.ph_hi = N_PHASES; hipLaunchKernelGGL(mega_fwd, dim3(grid), dim3(NTHR), LDS_BYTES, stream, a);
#endif
}
```

```cpp
#include <hip/hip_runtime.h>
#include <cstdio>
#include <cstdint>

#ifndef PG8_WGM
#define PG8_WGM 8
#endif
#ifndef MK_PER_PHASE
#define MK_PER_PHASE 0
#endif

namespace pg8 {
#define PG8_LAS __attribute__((address_space(3)))
typedef unsigned short bf16_t;
typedef short bf16x8 __attribute__((ext_vector_type(8)));
typedef float f32x4 __attribute__((ext_vector_type(4)));
typedef unsigned u32x4 __attribute__((ext_vector_type(4)));
constexpr int BM = 256, BK = 64, HALF = 128, HTB = HALF * BK * 2  , STAGE_BYTES = 8 * HTB, NXCD = 8, WGM = PG8_WGM;

__host__ __device__ __forceinline__ int lds_byte(int r, int c) { const int st = (r >> 4) * 2 + (c >> 5), rr = r & 15, cc = c & 31, ob = rr * 64 + cc * 2; return st * 1024 + (ob ^ (((ob >> 9) & 1) << 5)); }
__host__ __device__ __forceinline__ void stage_rc(int b, int& R, int& C) { const int st = b / 1024, sb = b % 1024, swz = sb ^ (((sb >> 9) & 1) << 5); R = (st >> 1) * 16 + swz / 64; C = (st & 1) * 32 + (swz % 64) / 2; }
__host__ __device__ __forceinline__ int perm32(int rho) { const int n = rho >> 4, i = rho & 15; return 8 * (i >> 2) + 4 * n + (i & 3); }

struct Unit { int pm, pn; };
struct Gemm { const bf16_t* A; const bf16_t* Bt; int M, N, K; int kmul = 1; };

struct StaticOrder {
    int nM, nN, nwg, G, c, wgm;
    __host__ __device__ void init(int M, int N, int G_, int c_, int wgm_ = WGM) { nM = M / BM; nN = N / BM; nwg = nM * nN; G = G_; c = c_; wgm = wgm_; }
    __host__ __device__ bool next(int i, Unit& u) const {
        const long L = (long)i * G + c; if (L >= nwg) return false;
        int wgid = (int)L; { const int q = nwg / NXCD, r = nwg % NXCD, xcd = wgid % NXCD, off = wgid / NXCD; wgid = (xcd < r ? xcd * (q + 1) : r * (q + 1) + (xcd - r) * q) + off; }
        const int nig = wgm * nN, gid = wgid / nig, fm = gid * wgm, gsz = (nM - fm) < wgm ? (nM - fm) : wgm;
        u.pm = fm + ((wgid % nig) % gsz); u.pn = (wgid % nig) / gsz; return true;
    }
    __device__ __forceinline__ void a_ready(const Unit&) const {}
    __device__ __forceinline__ void done(const Unit&) const {}
    __device__ __forceinline__ int ktiles(const Unit&, int full) const { return full; }
};

template <class Epi, class Sched, bool ALIGN_EPI = false, bool SP2 = false, bool BLK = false>
__device__ __forceinline__ void gemm_phase(PG8_LAS unsigned char* lds, const Gemm g, const Sched& S, const Epi& E, const int wave_sgpr) {
    unsigned m_ = ~0u; asm volatile("" : "+s"(m_)); int tid_ = wave_sgpr * 64 + (int)__builtin_amdgcn_mbcnt_hi(m_, __builtin_amdgcn_mbcnt_lo(m_, 0u)); asm volatile("" : "+v"(tid_));
    const int tid = tid_, wid = __builtin_amdgcn_readfirstlane(tid >> 6), lane = tid & 63, wr = wid >> 2, wc = wid & 3, fr = lane & 15, fq = lane >> 4;
    const int K = g.K; int nt = K / BK;
    unsigned voffA[2], voffB[2];
#pragma unroll
    for (int i = 0; i < 2; ++i) { int R, C; stage_rc(tid * 16 + i * 8192, R, C); const int p32 = perm32(R & 31);
        const int Rb = Epi::PMODE == 2 ? ((R >> 5) * 64 + (p32 >> 3) * 16 + (p32 & 7)) : (Epi::PMODE == 1 ? ((R & ~31) + p32) : R);
        voffA[i] = (unsigned)(R * (BLK ? BK : K) + C) * 2u; voffB[i] = (unsigned)(Rb * (BLK ? BK : K) + C) * 2u; }
    const size_t kstep = (BLK ? (size_t)(BM * BK * 2) : (size_t)(BK * 2)) * (size_t)g.kmul;
    const size_t hstep = BLK ? (size_t)(HALF * BK * 2) : (size_t)HALF * K * 2;
    const size_t hstepB = Epi::PMODE == 2 ? (size_t)8 * K * 2 : hstep;
    const size_t tstep = (size_t)BM * K * 2;
    const unsigned ldsw = (unsigned)wid * 1024u;
    const int aoff = lds_byte(wr * 64 + fr, fq * 8), boff = lds_byte(wc * 32 + fr, fq * 8);
#define PG8_SA(b, h) (((b) * 2 + (h)) * HTB)
#define PG8_SB(b, h) ((4 + (b) * 2 + (h)) * HTB)
#define PG8_STAGE(bufoff, gbase, voff) do { _Pragma("unroll") for (int _i = 0; _i < 2; ++_i) \
        __builtin_amdgcn_global_load_lds((const unsigned*)((const char*)(gbase) + (voff)[_i]), (PG8_LAS unsigned*)(lds + (bufoff) + ldsw + _i * 8192), 16, 0, 0); } while (0)
#define PG8_LDA(dst, b, h) do { _Pragma("unroll") for (int m = 0; m < 4; ++m) _Pragma("unroll") for (int k = 0; k < 2; ++k) dst[m][k] = *(const PG8_LAS bf16x8*)(lds + PG8_SA(b, h) + aoff + m * 2048 + k * 1024); } while (0)
#define PG8_LDB(dst, b, h) do { _Pragma("unroll") for (int n = 0; n < 2; ++n) _Pragma("unroll") for (int k = 0; k < 2; ++k) dst[n][k] = *(const PG8_LAS bf16x8*)(lds + PG8_SB(b, h) + boff + n * 2048 + k * 1024); } while (0)
#define PG8_MMA(ai, bj, At, Bt) do { __builtin_amdgcn_s_setprio(1); _Pragma("unroll") for (int m = 0; m < 4; ++m) _Pragma("unroll") for (int n = 0; n < 2; ++n) _Pragma("unroll") for (int k = 0; k < 2; ++k) \
        acc[ai][bj][m][n] = __builtin_amdgcn_mfma_f32_16x16x32_bf16(Bt[n][k], At[m][k], acc[ai][bj][m][n], 0, 0, 0); __builtin_amdgcn_s_setprio(0); } while (0)
#define PG8_WAIT_V(n) asm volatile("s_waitcnt vmcnt(" #n ")" ::: "memory")
#define PG8_WAIT_L(n) asm volatile("s_waitcnt lgkmcnt(" #n ")" ::: "memory")
#define PG8_BAR __builtin_amdgcn_s_barrier()
#define PG8_SCHED __builtin_amdgcn_sched_barrier(0)
    Unit cur, nxt; int ui = 0;
    if (!S.next(0, cur)) return;
    nt = S.ktiles(cur, K / BK);
    f32x4 acc[2][2][4][2];
#pragma unroll
    for (int a = 0; a < 2; ++a)
#pragma unroll
        for (int b = 0; b < 2; ++b)
#pragma unroll
            for (int m = 0; m < 4; ++m)
#pragma unroll
                for (int n = 0; n < 2; ++n) { float zf_ = 0.f; asm volatile("" : "+v"(zf_)); acc[a][b][m][n] = (f32x4){zf_, zf_, zf_, zf_}; }
    bf16x8 At[4][2], B0[2][2], B1[2][2];
    const char* cA = (const char*)g.A + (size_t)cur.pm * tstep; const char* cB = (const char*)g.Bt + (size_t)cur.pn * tstep;
    S.a_ready(cur);
    if constexpr (SP2) {
        PG8_STAGE(PG8_SB(0, 0), cB, voffB); PG8_STAGE(PG8_SB(0, 1), cB + hstepB, voffB); PG8_STAGE(PG8_SA(0, 0), cA, voffA); PG8_STAGE(PG8_SA(0, 1), cA + hstep, voffA);
        if (wr == 1) PG8_BAR;
        PG8_WAIT_V(2); PG8_BAR;
        PG8_STAGE(PG8_SB(1, 0), cB + kstep, voffB); PG8_STAGE(PG8_SA(1, 0), cA + kstep, voffA); PG8_STAGE(PG8_SB(1, 1), cB + hstepB + kstep, voffB);
        PG8_WAIT_V(6); PG8_BAR;
    } else {
        PG8_STAGE(PG8_SB(0, 0), cB, voffB); PG8_STAGE(PG8_SA(0, 0), cA, voffA); PG8_STAGE(PG8_SB(0, 1), cB + hstepB, voffB); PG8_STAGE(PG8_SA(0, 1), cA + hstep, voffA);
        if (wr == 1) PG8_BAR;
        PG8_WAIT_V(4); PG8_BAR;
        PG8_STAGE(PG8_SB(1, 0), cB + kstep, voffB); PG8_STAGE(PG8_SA(1, 0), cA + kstep, voffA); PG8_STAGE(PG8_SB(1, 1), cB + hstepB + kstep, voffB);
        PG8_WAIT_V(6); PG8_BAR;
    }
    for (;;) {
        const bool has_next = S.next(ui + 1, nxt);
        const char* nA = has_next ? (const char*)g.A + (size_t)nxt.pm * tstep : cA; const char* nB = has_next ? (const char*)g.Bt + (size_t)nxt.pn * tstep : cB;
        for (int t = 0; t < nt; t += 2) {
            const bool last = (t == nt - 2);
            const char* a1 = cA + (size_t)(t + 1) * kstep;
            const char* a2 = last ? nA : cA + (size_t)(t + 2) * kstep; const char* b2 = last ? nB : cB + (size_t)(t + 2) * kstep;
            const char* a3 = a2 + kstep; const char* b3 = b2 + kstep;
            if (last && has_next) S.a_ready(nxt);
            if constexpr (SP2) {
            PG8_LDB(B0, 0, 0); PG8_LDB(B1, 0, 1); PG8_SCHED; PG8_LDA(At, 0, 0); PG8_STAGE(PG8_SA(1, 1), a1 + hstep, voffA);
            PG8_WAIT_V(8); PG8_WAIT_L(0); PG8_BAR; PG8_MMA(0, 0, At, B0); PG8_MMA(0, 1, At, B1); PG8_BAR; PG8_SCHED;
            PG8_LDA(At, 0, 1); PG8_STAGE(PG8_SB(0, 0), b2, voffB); PG8_STAGE(PG8_SB(0, 1), b2 + hstepB, voffB); PG8_STAGE(PG8_SA(0, 0), a2, voffA);
            PG8_WAIT_V(8); PG8_WAIT_L(0); PG8_BAR; PG8_MMA(1, 0, At, B0); PG8_MMA(1, 1, At, B1); PG8_BAR; PG8_SCHED;
            PG8_LDB(B0, 1, 0); PG8_LDB(B1, 1, 1); PG8_SCHED; PG8_LDA(At, 1, 0); PG8_STAGE(PG8_SA(0, 1), a2 + hstep, voffA);
            PG8_WAIT_V(8); PG8_WAIT_L(0); PG8_BAR; PG8_MMA(0, 0, At, B0); PG8_MMA(0, 1, At, B1); PG8_BAR; PG8_SCHED;
            PG8_LDA(At, 1, 1); PG8_STAGE(PG8_SB(1, 0), b3, voffB); PG8_STAGE(PG8_SB(1, 1), b3 + hstepB, voffB); PG8_STAGE(PG8_SA(1, 0), a3, voffA);
            PG8_WAIT_V(8); PG8_WAIT_L(0); PG8_BAR; PG8_MMA(1, 0, At, B0); PG8_MMA(1, 1, At, B1); PG8_BAR; PG8_SCHED;
            } else {
            PG8_LDB(B0, 0, 0); PG8_SCHED; PG8_LDA(At, 0, 0); PG8_STAGE(PG8_SA(1, 1), a1 + hstep, voffA);
            PG8_WAIT_L(8); PG8_BAR; PG8_WAIT_L(0); PG8_MMA(0, 0, At, B0); PG8_BAR; PG8_SCHED;
            PG8_LDB(B1, 0, 1); PG8_STAGE(PG8_SB(0, 0), b2, voffB);
            PG8_BAR; PG8_WAIT_L(0); PG8_MMA(0, 1, At, B1); PG8_BAR;
            PG8_LDA(At, 0, 1); PG8_STAGE(PG8_SA(0, 0), a2, voffA);
            PG8_BAR; PG8_WAIT_L(0); PG8_MMA(1, 0, At, B0); PG8_BAR; PG8_SCHED;
            PG8_STAGE(PG8_SB(0, 1), b2 + hstepB, voffB);
            PG8_WAIT_V(6); PG8_BAR; PG8_MMA(1, 1, At, B1); PG8_BAR;
            PG8_LDB(B0, 1, 0); PG8_SCHED; PG8_LDA(At, 1, 0); PG8_STAGE(PG8_SA(0, 1), a2 + hstep, voffA);
            PG8_WAIT_L(8); PG8_BAR; PG8_WAIT_L(0); PG8_MMA(0, 0, At, B0); PG8_BAR; PG8_SCHED;
            PG8_LDB(B1, 1, 1); PG8_STAGE(PG8_SB(1, 0), b3, voffB);
            PG8_BAR; PG8_WAIT_L(0); PG8_MMA(0, 1, At, B1); PG8_BAR;
            PG8_LDA(At, 1, 1); PG8_STAGE(PG8_SA(1, 0), a3, voffA);
            PG8_BAR; PG8_WAIT_L(0); PG8_MMA(1, 0, At, B0); PG8_BAR; PG8_SCHED;
            PG8_STAGE(PG8_SB(1, 1), b3 + hstepB, voffB);
            PG8_WAIT_V(6); PG8_BAR; PG8_MMA(1, 1, At, B1); PG8_BAR;
            }
        }
        if constexpr (ALIGN_EPI) { if (wr == 0) PG8_BAR; }
        if constexpr (!Epi::AFTER_DRAIN) { E(acc, cur, wr, wc, fr, fq); S.done(cur); }
        if (!has_next) break;
        bool keep_acc = false; if constexpr (Epi::CHAIN) keep_acc = E.keep(cur);
        if (!keep_acc) {
#pragma unroll
        for (int a = 0; a < 2; ++a)
#pragma unroll
            for (int b = 0; b < 2; ++b)
#pragma unroll
                for (int m = 0; m < 4; ++m)
#pragma unroll
                    for (int n = 0; n < 2; ++n) { float zf_ = 0.f; asm volatile("" : "+v"(zf_)); acc[a][b][m][n] = (f32x4){zf_, zf_, zf_, zf_}; }
        }
        cur = nxt; cA = nA; cB = nB; ++ui; nt = S.ktiles(cur, K / BK);
        if constexpr (ALIGN_EPI) { if (wr == 1) PG8_BAR; }
    }
    PG8_WAIT_V(0);
    if constexpr (!ALIGN_EPI) { if (wr == 0) PG8_BAR; }
    PG8_BAR;
    if constexpr (Epi::AFTER_DRAIN) { E.fused(acc, cur, wr, wc, fr, fq, lds, wid, lane); S.done(cur); }
#undef PG8_SA
#undef PG8_SB
#undef PG8_STAGE
#undef PG8_LDA
#undef PG8_LDB
#undef PG8_MMA
#undef PG8_WAIT_V
#undef PG8_WAIT_L
#undef PG8_BAR
#undef PG8_SCHED
}
}

constexpr int NWAVES = 8, NTHR = 512;
constexpr int BATCH = 2, SEQ = 16384, DM = 2048, DEPTH = 2, MTOK = BATCH * SEQ, DFF = 5632;
constexpr int RH = 6, RDK = 64, RDV = 128, RCH = 128;
constexpr int AH = 6, AD = 128, IH = 4, IDIM = 64, TOPK = 256;
constexpr int SGG = 4, SGD = 128, SGC = 128;
constexpr int NPROJ = 12288;
constexpr int DIN = 12100;
constexpr float EPS = 1e-6f;
constexpr int HROWS = 16384;

constexpr size_t MiB = 1u << 20;
constexpr size_t WS_CTL = 0, CTL_ZERO_BYTES = 1 * MiB;
constexpr size_t WS_PART = 1 * MiB;
constexpr size_t WS_RSTD = 5 * MiB;
constexpr size_t WS_KMAX = 5 * MiB + 512 * 1024;
constexpr size_t WS_POS = 5 * MiB + 768 * 1024;
constexpr size_t WS_ROPE = 6 * MiB;
constexpr size_t WS_WGU1 = 16 * MiB, WS_WD1 = 60 * MiB, WS_WGU2 = 82 * MiB, WS_WD2 = 126 * MiB, WS_WIN = 148 * MiB, WS_WBR = 196 * MiB, WS_WOUT = 205 * MiB;
constexpr size_t WS_XB = 216 * MiB;
constexpr size_t WS_ACT = 344 * MiB;
constexpr size_t WS_HID = WS_ACT;
constexpr size_t WS_QKR = WS_ACT;
constexpr size_t WS_VR = WS_QKR + 24 * MiB, WS_GR = WS_VR + 24 * MiB, WS_QA = WS_GR + 24 * MiB, WS_KA = WS_QA + 24 * MiB, WS_VA = WS_KA + 24 * MiB;
constexpr size_t WS_QI = WS_VA + 24 * MiB;
constexpr size_t WS_KI = WS_QI + 8 * MiB;
constexpr size_t WS_WI = WS_KI + 2 * MiB;
constexpr size_t WS_US = WS_WI + 1 * MiB, WS_VS = WS_US + 16 * MiB;
constexpr size_t WS_GATE = WS_VS + 16 * MiB;
constexpr size_t WS_OBR = WS_GATE + 192 * MiB;
constexpr size_t WS_MRG = WS_OBR + 72 * MiB;
constexpr size_t WS_MASK = WS_MRG + 64 * MiB;
constexpr size_t WS_KVST = WS_MASK + 32 * MiB;
constexpr size_t WS_APART = WS_KVST + 24 * MiB;
constexpr size_t WS_AML = WS_APART + 24 * MiB;
constexpr size_t WS_END = WS_AML + 1 * MiB;
static_assert(WS_END <= 1030 * MiB, "workspace map");
static_assert(WS_HID + (size_t)HROWS * DFF * 2 <= WS_END, "hid overlay");
constexpr int CW_TMO = 0, CW_BAR = 4096;

constexpr int RING_OFF = 0, RING_BYTES = 131072;
constexpr int LDSCTL_OFF = RING_BYTES + 31744 + 128, MISC_OFF = LDSCTL_OFF;
constexpr int LDS_BYTES = LDSCTL_OFF + 256;
static_assert(LDS_BYTES <= 160 * 1024, "LDS");

#define GAS __attribute__((address_space(1)))
#define LAS __attribute__((address_space(3)))
typedef unsigned short bf16;
typedef unsigned v4u __attribute__((ext_vector_type(4)));
typedef unsigned v2u __attribute__((ext_vector_type(2)));
typedef float f32x4 __attribute__((ext_vector_type(4)));
typedef float f32x16 __attribute__((ext_vector_type(16)));
typedef short bf16x8 __attribute__((ext_vector_type(8)));
typedef _Float16 f16x8 __attribute__((ext_vector_type(8)));
typedef _Float16 f16x2 __attribute__((ext_vector_type(2)));
typedef GAS unsigned gu32;
#define RLX_AGENT __ATOMIC_RELAXED, __HIP_MEMORY_SCOPE_AGENT
#define LDS_WAIT() asm volatile("s_waitcnt lgkmcnt(0)" ::: "memory")
#define VM_WAIT() asm volatile("s_waitcnt vmcnt(0)" ::: "memory")
__device__ __forceinline__ unsigned f2bf(float f) { unsigned u = __builtin_bit_cast(unsigned, f); return (u + 0x7fffu + ((u >> 16) & 1u)) >> 16; }
__device__ __forceinline__ unsigned pk2(float lo, float hi) { unsigned r; asm volatile("v_cvt_pk_bf16_f32 %0, %1, %2" : "=v"(r) : "v"(lo), "v"(hi)); return r; }
__device__ __forceinline__ float bf2f(unsigned short b) { return __builtin_bit_cast(float, ((unsigned)b) << 16); }
__device__ __forceinline__ float bflo(unsigned w) { return __builtin_bit_cast(float, w << 16); }
__device__ __forceinline__ float bfhi(unsigned w) { return __builtin_bit_cast(float, w & 0xffff0000u); }
__device__ __forceinline__ unsigned pkh2(float lo, float hi) { f16x2 v = {(_Float16)lo, (_Float16)hi}; return __builtin_bit_cast(unsigned, v); }
__device__ __forceinline__ float fsigmoid(float x) { return __builtin_amdgcn_rcpf(1.0f + __builtin_amdgcn_exp2f(-1.4426950408889634f * x)); }
__device__ __forceinline__ float fsilu(float x) { return x * fsigmoid(x); }
__device__ __forceinline__ float fgelu_tanh(float x) { const float u = 1.5957691216057308f * (x + 0.044715f * x * x * x); return x * fsigmoid(u); }
__device__ __forceinline__ float wave_sum(float v) {
#pragma unroll
    for (int o = 1; o < 64; o <<= 1) v += __shfl_xor(v, o);
    return v;
}
__device__ __forceinline__ f32x4 zero4() { float z = 0.f; asm volatile("" : "+v"(z)); return (f32x4){z, z, z, z}; }
__device__ __forceinline__ f32x16 zero16() { float z = 0.f; asm volatile("" : "+v"(z)); return (f32x16){z, z, z, z, z, z, z, z, z, z, z, z, z, z, z, z}; }
__device__ __forceinline__ v4u zero4u() { unsigned z = 0u; asm volatile("" : "+v"(z)); return (v4u){z, z, z, z}; }
__device__ __forceinline__ int lane_id() { unsigned m = ~0u; asm volatile("" : "+s"(m)); return (int)__builtin_amdgcn_mbcnt_hi(m, __builtin_amdgcn_mbcnt_lo(m, 0u)); }
#ifndef PROBE_SGR1
#define PROBE_SGR1 1
#endif
#ifndef PROBE_R3
#define PROBE_R3 1
#endif
#ifndef PROBE_IDX
#define PROBE_IDX 1
#endif
__device__ __forceinline__ int rep_count(int k) { asm volatile("" : "+s"(k)); return k; }
#ifndef PROBE_IDXD
#define PROBE_IDXD 0
#endif
#define XB_TMO      128
#define XB_XCNT(j)  (256  + 64 * (j))
#define XB_XSUB(j)  (1280 + 64 * (j))
#define XB_XGEN(j)  (2304 + 64 * (j))
#define XB_TOP      3328
#define XB_TOPGEN   3392
#define XCD_BAR_WORDS 3456
#define XB_SPIN_CAP (1u << 18)

__device__ __forceinline__ unsigned xb_ld(unsigned* p)              { return __hip_atomic_load(p, __ATOMIC_RELAXED, __HIP_MEMORY_SCOPE_AGENT); }
__device__ __forceinline__ unsigned xb_add(unsigned* p, unsigned v) { return __hip_atomic_fetch_add(p, v, __ATOMIC_RELAXED, __HIP_MEMORY_SCOPE_AGENT); }
__device__ __forceinline__ unsigned xb_xcc_id() { return (unsigned)__builtin_amdgcn_s_getreg((3 << 11) | 20) & 0xFu; }
#define XB_SPIN(cond, bar) do { unsigned _sp = 0; while (cond) { __builtin_amdgcn_s_sleep(1); \
    if ((++_sp & 255u) == 0u) { if (xb_ld(&(bar)[XB_TMO])) break; if (_sp > XB_SPIN_CAP) { atomicAdd(&(bar)[XB_TMO], 1u); break; } } } } while (0)

struct XcdBarrier {
    unsigned* bar; unsigned x;
    volatile LAS unsigned* st;
};

__device__ __forceinline__ XcdBarrier xcd_barrier_post(unsigned* bar, volatile LAS unsigned* st) {
    XcdBarrier b; b.bar = bar; b.x = xb_xcc_id(); b.st = st;
    if (threadIdx.x == 0) (void)xb_add(&bar[XB_XCNT(b.x)], 1u);
    return b;
}
__device__ __forceinline__ void xcd_barrier_complete(unsigned* bar, unsigned x, unsigned& nloc, unsigned& nx) {
    const unsigned G = gridDim.x * gridDim.y * gridDim.z;
    unsigned sum, cnt, mine, sp = 0u;
    for (;;) {
        sum = 0u; cnt = 0u; mine = 0u;
#pragma unroll
        for (unsigned j = 0; j < 16; ++j) { const unsigned c = xb_ld(&bar[XB_XCNT(j)]); sum += c; cnt += (c > 0u) ? 1u : 0u; mine = (j == x) ? c : mine; }
        if (sum == G) break;
        __builtin_amdgcn_s_sleep(1);
        if ((++sp & 255u) == 0u) { if (xb_ld(&bar[XB_TMO])) break; if (sp > XB_SPIN_CAP) { atomicAdd(&bar[XB_TMO], 1u); break; } }
    }
    nloc = mine > 0u ? mine : 1u; nx = cnt > 0u ? cnt : 1u;
}

__device__ __forceinline__ void xcd_barrier(const XcdBarrier& b0, const int wave_sgpr) {
    XcdBarrier b = b0; asm volatile("" : "+s"(b.bar), "+s"(b.x));
    asm volatile("s_waitcnt vmcnt(0)" ::: "memory");
    __syncthreads();
    if (wave_sgpr == 0 && lane_id() == 0) {
        unsigned* bar = b.bar;
        __builtin_amdgcn_s_waitcnt(0);
        unsigned nloc = b.st[0], nx = b.st[1];
        if (nloc == 0u) { xcd_barrier_complete(bar, b.x, nloc, nx); b.st[0] = nloc; b.st[1] = nx; }
        const unsigned old = xb_add(&bar[XB_XSUB(b.x)], 1u);
        const unsigned gen = old / nloc;
        if (old + 1u == (gen + 1u) * nloc) {
            __builtin_amdgcn_fence(__ATOMIC_RELEASE, "agent");
            asm volatile("s_waitcnt vmcnt(0)" ::: "memory");
            const unsigned og = xb_add(&bar[XB_TOP], 1u);
            const unsigned tg = og / nx;
            if (og + 1u == (tg + 1u) * nx) xb_add(&bar[XB_TOPGEN], 1u);
            else XB_SPIN(xb_ld(&bar[XB_TOPGEN]) == tg, bar);
            __builtin_amdgcn_fence(__ATOMIC_ACQUIRE, "agent");
            xb_add(&bar[XB_XGEN(b.x)], 1u);
            asm volatile("s_waitcnt vmcnt(0)" ::: "memory");
        } else {
            XB_SPIN(xb_ld(&bar[XB_XGEN(b.x)]) == gen, bar);
            __builtin_amdgcn_fence(__ATOMIC_ACQUIRE, "agent");
            asm volatile("s_waitcnt vmcnt(0)" ::: "memory");
        }
    }
    __syncthreads();
}

using pg8::Unit; using pg8::HALF; using pg8::BM;
#ifndef NT_PROJ
#define NT_PROJ 0
#endif
#ifndef HID_BLK
#define HID_BLK 0
#endif
#ifndef RESID_GROUP
#define RESID_GROUP 1
#endif
#ifndef NT_GATE
#define NT_GATE 1
#endif
#ifndef NT_X
#define NT_X 0
#endif
__device__ __forceinline__ v4u pack8bf(const f32x4 a, const f32x4 b) { v4u w; w.x = pk2(a[0], a[1]); w.y = pk2(a[2], a[3]); w.z = pk2(b[0], b[1]); w.w = pk2(b[2], b[3]); return w; }
__device__ __forceinline__ v4u pack8h(const f32x4 a, const f32x4 b) { v4u w; w.x = pkh2(a[0], a[1]); w.y = pkh2(a[2], a[3]); w.z = pkh2(b[0], b[1]); w.w = pkh2(b[2], b[3]); return w; }

struct EpiSwiGLU {
    static constexpr bool PERM = true, AFTER_DRAIN = false, CHAIN = false; static constexpr int PMODE = 1;
    bf16* H; const float* rstd; int skip;
    __device__ __forceinline__ void operator()(const f32x4 (&acc)[2][2][4][2], const Unit& u, int wr, int wc, int fr, int fq) const {
        if (skip) {
#pragma unroll
            for (int a = 0; a < 2; ++a)
#pragma unroll
                for (int b = 0; b < 2; ++b)
#pragma unroll
                    for (int m = 0; m < 4; ++m) asm volatile("" :: "v"(acc[a][b][m][0]), "v"(acc[a][b][m][1]));
            return; }
        const int row0 = u.pm * BM + wr * 64 + fr, col0 = u.pn * 128 + wc * 32 + 8 * fq;
#pragma unroll
        for (int ai = 0; ai < 2; ++ai)
#pragma unroll
            for (int m = 0; m < 4; ++m) { const int r = row0 + ai * HALF + m * 16; const float rs = rstd[r];
                f32x4 h0, h1;
                typedef float f2 __attribute__((ext_vector_type(2)));
                const float rn = rs * -1.4426950408889634f, r2 = rs * rs;
#pragma unroll
                for (int n = 0; n < 2; ++n)
#pragma unroll
                    for (int j = 0; j < 2; ++j) { const f2 g = {acc[ai][0][m][n][2 * j], acc[ai][0][m][n][2 * j + 1]}, uu = {acc[ai][1][m][n][2 * j], acc[ai][1][m][n][2 * j + 1]};
                        const f2 t = g * rn; f2 d = {__builtin_amdgcn_exp2f(t.x), __builtin_amdgcn_exp2f(t.y)}; d = d + 1.0f;
                        const f2 rc = {__builtin_amdgcn_rcpf(d.x), __builtin_amdgcn_rcpf(d.y)}; const f2 o = (g * uu) * (rc * r2);
                        if (n == 0) { h0[2 * j] = o.x; h0[2 * j + 1] = o.y; } else { h1[2 * j] = o.x; h1[2 * j + 1] = o.y; } }
                if (HID_BLK) *(v4u*)(H + (((size_t)(r >> 8) * (DFF / 64) + (col0 >> 6)) * 256 + (r & 255)) * 64 + (col0 & 63)) = pack8bf(h0, h1);
                else *(v4u*)(H + (size_t)r * DFF + col0) = pack8bf(h0, h1); }
    }
};
#ifndef RESID_BF16
#define RESID_BF16 1
#endif
struct EpiResid {
#if RESID_BF16
    static constexpr bool PERM = true, AFTER_DRAIN = false, CHAIN = false; static constexpr int PMODE = 2;
#else
    static constexpr bool PERM = false, AFTER_DRAIN = false, CHAIN = false; static constexpr int PMODE = 0;
#endif
    const float* base; float* X; bf16* XB; float* part; float coef; int skip = 0;
    __device__ __forceinline__ void operator()(const f32x4 (&acc)[2][2][4][2], const Unit& u, int wr, int wc, int fr, int fq) const {
        if (skip) {
#pragma unroll
            for (int a = 0; a < 2; ++a)
#pragma unroll
                for (int b = 0; b < 2; ++b)
#pragma unroll
                    for (int m = 0; m < 4; ++m) asm volatile("" :: "v"(acc[a][b][m][0]), "v"(acc[a][b][m][1]));
            return; }
#if RESID_BF16
        const int row0 = u.pm * BM + wr * 64 + fr, col0 = u.pn * BM + wc * 64 + 16 * fq;
#pragma unroll
        for (int ai = 0; ai < 2; ++ai)
#pragma unroll
            for (int m = 0; m < 4; ++m) { const int r = row0 + ai * HALF + m * 16; float ss = 0.f;
#pragma unroll
                for (int bj = 0; bj < 2; ++bj) { const size_t o = (size_t)r * DM + col0 + bj * 8;
                    f32x4 b0, b1;
                    if (base) { b0 = *(const f32x4*)(base + o); b1 = *(const f32x4*)(base + o + 4); }
                    else { const v4u bw = *(const v4u*)(XB + o); b0 = (f32x4){bflo(bw.x), bfhi(bw.x), bflo(bw.y), bfhi(bw.y)}; b1 = (f32x4){bflo(bw.z), bfhi(bw.z), bflo(bw.w), bfhi(bw.w)}; }
                    const f32x4 v0 = b0 + acc[ai][bj][m][0] * coef, v1 = b1 + acc[ai][bj][m][1] * coef;
                    *(v4u*)(XB + o) = pack8bf(v0, v1);
                    ss += ((v0[0] * v0[0] + v0[1] * v0[1]) + (v0[2] * v0[2] + v0[3] * v0[3])) + ((v1[0] * v1[0] + v1[1] * v1[1]) + (v1[2] * v1[2] + v1[3] * v1[3])); }
                ss += __shfl_xor(ss, 16); ss += __shfl_xor(ss, 32);
                if (fq == 0) part[(size_t)r * 32 + u.pn * 4 + wc] = ss;
                if ((m & (RESID_GROUP - 1)) == RESID_GROUP - 1) asm volatile("" ::: "memory"); }
#else
        const int row0 = u.pm * BM + wr * 64 + fr, col0 = u.pn * BM + wc * 32 + 4 * fq;
#pragma unroll
        for (int ai = 0; ai < 2; ++ai)
#pragma unroll
            for (int m = 0; m < 4; ++m) { const int r = row0 + ai * HALF + m * 16; float ss = 0.f;
#pragma unroll
                for (int bj = 0; bj < 2; ++bj)
#pragma unroll
                    for (int n = 0; n < 2; ++n) { const size_t o = (size_t)r * DM + col0 + bj * HALF + n * 16;
                        const f32x4 b = NT_X ? __builtin_nontemporal_load((const f32x4*)(base + o)) : *(const f32x4*)(base + o); const f32x4 v = b + acc[ai][bj][m][n] * coef;
                        if (NT_X) __builtin_nontemporal_store(v, (f32x4*)(X + o)); else *(f32x4*)(X + o) = v;
                        v2u w; w.x = pk2(v[0], v[1]); w.y = pk2(v[2], v[3]); *(v2u*)(XB + o) = w;
                        ss += (v[0] * v[0] + v[1] * v[1]) + (v[2] * v[2] + v[3] * v[3]); }
                ss += __shfl_xor(ss, 16); ss += __shfl_xor(ss, 32);
                if (fq == 0) part[(size_t)r * 32 + u.pn * 4 + wc] = ss;
                if ((m & (RESID_GROUP - 1)) == RESID_GROUP - 1) asm volatile("" ::: "memory"); }
#endif
    }
};
struct EpiProj {
    static constexpr bool PERM = true, AFTER_DRAIN = false, CHAIN = false; static constexpr int PMODE = 1;
    const float* rstd; const float* rcos; const float* rsin;
    bf16 *QKR, *VR, *GR, *QA, *KA, *VA, *US, *VS, *GATE; unsigned short *QI, *KI; float* WI; int skip = 0;
    __device__ __forceinline__ void operator()(const f32x4 (&acc)[2][2][4][2], const Unit& u, int wr, int wc, int fr, int fq) const {
        if (skip) {
#pragma unroll
            for (int a = 0; a < 2; ++a)
#pragma unroll
                for (int b = 0; b < 2; ++b)
#pragma unroll
                    for (int m = 0; m < 4; ++m) asm volatile("" :: "v"(acc[a][b][m][0]), "v"(acc[a][b][m][1]));
            return; }
        const int row0 = u.pm * BM + wr * 64 + fr, pn = u.pn, cw = wc * 32 + 8 * fq;
        if (pn < 3) {
            const int slot = 4 * pn + wc;
#pragma unroll
            for (int ai = 0; ai < 2; ++ai)
#pragma unroll
                for (int m = 0; m < 4; ++m) { const int r = row0 + ai * HALF + m * 16; const float rs = rstd[r];
                    const f32x4 c0 = *(const f32x4*)(rcos + (size_t)r * 32 + 8 * fq), c1 = *(const f32x4*)(rcos + (size_t)r * 32 + 8 * fq + 4);
                    const f32x4 s0 = *(const f32x4*)(rsin + (size_t)r * 32 + 8 * fq), s1 = *(const f32x4*)(rsin + (size_t)r * 32 + 8 * fq + 4);
                    const f32x4 a0 = acc[ai][0][m][0] * rs, a1 = acc[ai][0][m][1] * rs, b0 = acc[ai][1][m][0] * rs, b1 = acc[ai][1][m][1] * rs;
                    const f32x4 o10 = a0 * c0 - b0 * s0, o11 = a1 * c1 - b1 * s1, o20 = a0 * s0 + b0 * c0, o21 = a1 * s1 + b1 * c1;
                    bf16* d = QKR + (size_t)r * 768 + slot * 64 + 8 * fq;
                    *(v4u*)d = pack8bf(o10, o11); *(v4u*)(d + 32) = pack8bf(o20, o21); }
            return;
        }
        if (pn == 19) {
#pragma unroll
            for (int ai = 0; ai < 2; ++ai)
#pragma unroll
                for (int m = 0; m < 4; ++m) { const int r = row0 + ai * HALF + m * 16; const float rs = rstd[r];
                    if (wc < 2) *(v4u*)(KI + (size_t)r * 64 + cw) = pack8h(acc[ai][0][m][0] * rs, acc[ai][0][m][1] * rs);
                    if (wc == 2 && fq == 0) *(f32x4*)(WI + (size_t)r * 4) = acc[ai][0][m][0] * (rs * 0.0625f); }
            return;
        }
        int mode; unsigned short* dst; int ld, c0;
        if (pn < 6) { mode = 0; dst = VR; ld = 768; c0 = (pn - 3) * 256; }
        else if (pn < 9) { mode = 1; dst = GR; ld = 768; c0 = (pn - 6) * 256; }
        else if (pn < 12) { mode = 0; dst = QA; ld = 768; c0 = (pn - 9) * 256; }
        else if (pn < 15) { mode = 0; dst = KA; ld = 768; c0 = (pn - 12) * 256; }
        else if (pn < 18) { mode = 0; dst = VA; ld = 768; c0 = (pn - 15) * 256; }
        else if (pn == 18) { mode = 4; dst = QI; ld = 256; c0 = 0; }
        else if (pn < 22) { mode = 2; dst = US; ld = 512; c0 = (pn - 20) * 256; }
        else if (pn < 24) { mode = 2; dst = VS; ld = 512; c0 = (pn - 22) * 256; }
        else { mode = 3; dst = GATE; ld = 6144; c0 = (pn - 24) * 256; }
#pragma unroll
        for (int ai = 0; ai < 2; ++ai)
#pragma unroll
            for (int m = 0; m < 4; ++m) { const int r = row0 + ai * HALF + m * 16; const float rs = rstd[r];
#pragma unroll
                for (int bj = 0; bj < 2; ++bj) { f32x4 v0 = acc[ai][bj][m][0] * rs, v1 = acc[ai][bj][m][1] * rs;
                    if (mode == 1 || mode == 2) { typedef float f2 __attribute__((ext_vector_type(2)));
#pragma unroll
                        for (int j = 0; j < 4; ++j) { f2 x = (j < 2) ? (f2){v0[2 * j], v0[2 * j + 1]} : (f2){v1[2 * j - 4], v1[2 * j - 3]};
                            f2 t = (mode == 1) ? x * -1.4426950408889634f : (x * (x * x * 0.044715f + 1.0f)) * (-1.4426950408889634f * 1.5957691216057308f);
                            f2 d = {__builtin_amdgcn_exp2f(t.x), __builtin_amdgcn_exp2f(t.y)}; d = d + 1.0f; const f2 rc = {__builtin_amdgcn_rcpf(d.x), __builtin_amdgcn_rcpf(d.y)}; x = x * rc;
                            if (j < 2) { v0[2 * j] = x.x; v0[2 * j + 1] = x.y; } else { v1[2 * j - 4] = x.x; v1[2 * j - 3] = x.y; } } }
                    else if (mode == 3) { typedef float f2 __attribute__((ext_vector_type(2)));
#pragma unroll
                        for (int j = 0; j < 2; ++j) { f2 a = {v0[2 * j], v0[2 * j + 1]}, b = {v1[2 * j], v1[2 * j + 1]}; a = a * -1.4426950408889634f; b = b * -1.4426950408889634f;
                            f2 da = {__builtin_amdgcn_exp2f(a.x), __builtin_amdgcn_exp2f(a.y)}, db = {__builtin_amdgcn_exp2f(b.x), __builtin_amdgcn_exp2f(b.y)}; da = da + 1.0f; db = db + 1.0f;
                            v0[2 * j] = da.x; v0[2 * j + 1] = da.y; v1[2 * j] = db.x; v1[2 * j + 1] = db.y; } }
                    const v4u w = (mode == 4) ? pack8h(v0, v1) : pack8bf(v0, v1);
                    v4u* dp = (v4u*)(dst + (size_t)r * ld + c0 + bj * HALF + cw);
                    if ((NT_GATE && mode == 3) || NT_PROJ) __builtin_nontemporal_store(w, dp); else *dp = w; } }
    }
};
struct EpiMerge {
    static constexpr bool PERM = true, AFTER_DRAIN = false, CHAIN = true; static constexpr int PMODE = 2;
    const bf16* GATE; bf16* MRG;
    __device__ __forceinline__ bool keep(const Unit& u) const { return (u.pm >> 6) < 2; }
    static __device__ __forceinline__ void dens8(const v4u g, float (&o)[8]) { const float hi = 1152921504606846976.0f;
        o[0] = fminf(bflo(g.x), hi); o[1] = fminf(bfhi(g.x), hi); o[2] = fminf(bflo(g.y), hi); o[3] = fminf(bfhi(g.y), hi); o[4] = fminf(bflo(g.z), hi); o[5] = fminf(bfhi(g.z), hi); o[6] = fminf(bflo(g.w), hi); o[7] = fminf(bfhi(g.w), hi); }
    __device__ __forceinline__ void operator()(f32x4 (&acc)[2][2][4][2], const Unit& u, int wr, int wc, int fr, int fq) const {
        const int br = u.pm >> 6, pm = u.pm & 63, pn = u.pn & 7;
        const int row0 = pm * BM + wr * 64 + fr, col0 = pn * BM + wc * 64 + 16 * fq;
#pragma unroll
        for (int ai = 0; ai < 2; ++ai)
#pragma unroll
            for (int m = 0; m < 4; ++m) { const int r = row0 + ai * HALF + m * 16;
#pragma unroll
                for (int bj = 0; bj < 2; ++bj) { const int c = col0 + bj * 8;
                    const bf16* gp = GATE + (size_t)r * 6144 + br * 2048 + c;
                    float f[8]; dens8(*(const v4u*)gp, f);
#pragma unroll
                    for (int j = 0; j < 8; ++j) f[j] = __builtin_amdgcn_rcpf(f[j]);
                    if (br < 2) { float d[8]; dens8(*(const v4u*)(gp + 2048), d);
#pragma unroll
                        for (int j = 0; j < 8; ++j) f[j] *= d[j]; }
                    f32x4 v0 = acc[ai][bj][m][0], v1 = acc[ai][bj][m][1];
                    v0[0] *= f[0]; v0[1] *= f[1]; v0[2] *= f[2]; v0[3] *= f[3]; v1[0] *= f[4]; v1[1] *= f[5]; v1[2] *= f[6]; v1[3] *= f[7];
                    if (br < 2) { acc[ai][bj][m][0] = v0; acc[ai][bj][m][1] = v1; }
                    else *(v4u*)(MRG + (size_t)r * DM + c) = pack8bf(v0, v1); } }
    }
};
struct MergeOrder {
    pg8::StaticOrder so;
    __device__ void init(int G, int c, int wgm) { so.init(HROWS, DM, G, c, wgm); }
    __device__ bool next(int i, Unit& u) const { Unit t; if (!so.next(i / 3, t)) return false; const int br = i % 3; u.pm = 64 * br + t.pm; u.pn = 8 * br + t.pn; return true; }
    __device__ __forceinline__ void a_ready(const Unit&) const {}
    __device__ __forceinline__ void done(const Unit&) const {}
    __device__ __forceinline__ int ktiles(const Unit& u, int full) const { return (u.pm >> 6) == 2 ? 512 / 64 : full; }
};

struct Args { const void* in[22]; float* out; unsigned char* ws; int ph_lo, ph_hi; };
struct Frame {
    LAS unsigned char* lds; volatile LAS unsigned* MISC; gu32* ctl;
    int tid, lane, wave, vcu, G;
    unsigned char* ws;
    const float* xin; const int* pos; const float* rel;
    float* X;
};

__device__ __forceinline__ void conv_item(const float* W, int ldw, int sc, int cnt, int k0, int kvalid, const float* gain, bf16* WT, int drow0, int Kd, LAS float* scr, int lane, bool blk = false) {
#define WT_AT(n_, k_) (blk ? (WT + ((((size_t)((n_) >> 8) * (Kd / 64) + ((k_) >> 6)) * 256 + ((n_) & 255)) * 64 + ((k_) & 63))) : (WT + (size_t)(n_) * Kd + (k_)))
    const int c8 = lane & 7;
    if (k0 >= kvalid || cnt <= 0) {
#pragma unroll
        for (int j = 0; j < 4; ++j) { const int n = (lane >> 3) + 8 * j; *(GAS v4u*)WT_AT(drow0 + n, k0 + 8 * c8) = zero4u(); }
        return;
    }
    const int c4 = (lane & 7) * 4, kr = lane >> 3; const bool cok = c4 < cnt; const int cc = cok ? c4 : 0;
    f32x4 v[8];
#pragma unroll
    for (int i = 0; i < 8; ++i) v[i] = *(const f32x4*)(W + (size_t)(k0 + 8 * i + kr) * ldw + sc + cc);
#pragma unroll
    for (int i = 0; i < 8; ++i) { const int kk = 8 * i + kr; f32x4 x = cok ? v[i] : (f32x4){0.f, 0.f, 0.f, 0.f}; if (gain) x = x * gain[k0 + kk];
        LAS float* d = scr + kk * 33 + c4; d[0] = x[0]; d[1] = x[1]; d[2] = x[2]; d[3] = x[3]; }
    LDS_WAIT(); asm volatile("" ::: "memory");
#pragma unroll
    for (int j = 0; j < 4; ++j) { const int n = (lane >> 3) + 8 * j; const LAS float* s = scr + (8 * c8) * 33 + n;
        v4u o; o.x = pk2(s[0 * 33], s[1 * 33]); o.y = pk2(s[2 * 33], s[3 * 33]); o.z = pk2(s[4 * 33], s[5 * 33]); o.w = pk2(s[6 * 33], s[7 * 33]);
        *(GAS v4u*)WT_AT(drow0 + n, k0 + 8 * c8) = o; }
    LDS_WAIT(); asm volatile("" ::: "memory");
#undef WT_AT
}
__device__ __forceinline__ void proj_src_group(int g, int& sc, int& cnt) {
    const int r0 = 32 * g; cnt = 32;
    if (r0 < 768) { const int t = r0 / 256, w = r0 % 256, bj = w / 128, wcq = (w % 128) / 32; sc = (4 * t + wcq) * 64 + 32 * bj; }
    else if (r0 < 4864) sc = r0;
    else if (r0 < 5120) { const int w = r0 - 4864; if (w < 64) sc = 4864 + w; else if (w == 64) { sc = 4928; cnt = 4; } else { sc = 0; cnt = 0; } }
    else if (r0 < 6144) sc = 4932 + (r0 - 5120);
    else sc = 5956 + (r0 - 6144);
}
__device__ __forceinline__ void p_convert(Frame& F0, const Args& a, int l) {
    Frame F = F0; { GAS unsigned char* wsg_ = (GAS unsigned char*)F.ws; F.tid = F.wave * 64 + lane_id(); asm volatile("" : "+v"(F.tid), "+s"(wsg_), "+s"(F.vcu), "+s"(F.G)); F.lane = F.tid & 63; F.ws = (unsigned char*)wsg_; }
    LAS float* scr = (LAS float*)(F.lds + RING_OFF + F.wave * 16384);
    const int gw = F.vcu * NWAVES + F.wave, NGW = F.G * NWAVES;
    constexpr int I_GU = 352 * 32, I_D = 64 * 88, I_IN = 384 * 32, I_BR = 192 * 12, I_OUT = 64 * 32;
    constexpr int NITEMS = 2 * (I_GU + I_D) + I_IN + I_BR + I_OUT;
#pragma unroll 1
    for (int it = gw; it < NITEMS; it += NGW) {
        int r = it;
        int src_idx, ldw, sc, cnt = 32, k0, kvalid, gain_idx = -1, drow0, Kd; size_t src_off, dst_off; bool blk = false;
        if (r < 2 * (I_GU + I_D)) {
            const int which = r / (I_GU + I_D); r -= which * (I_GU + I_D);
            if (r < I_GU) { const int g = r / 32, kb = r % 32, pn = g / 8, w = g % 8, bj = w / 4;
                src_idx = (which ? 18 : 4) + bj; src_off = (size_t)l * DM * DFF; ldw = DFF; sc = 128 * pn + (w % 4) * 32; k0 = 64 * kb; kvalid = DM; gain_idx = which ? 17 : 3;
                dst_off = which ? WS_WGU2 : WS_WGU1; drow0 = 32 * g; Kd = DM; }
            else { r -= I_GU; const int g = r / 88, kb = r % 88;
                src_idx = which ? 20 : 6; src_off = (size_t)l * DFF * DM; ldw = DM; sc = 32 * g; k0 = 64 * kb; kvalid = DFF;
                dst_off = which ? WS_WD2 : WS_WD1; drow0 = 32 * g; Kd = DFF; blk = HID_BLK; }
        } else {
            r -= 2 * (I_GU + I_D);
            if (r < I_IN) { const int g = r / 32, kb = r % 32; proj_src_group(g, sc, cnt);
                src_idx = 8; src_off = (size_t)l * DM * DIN; ldw = DIN; k0 = 64 * kb; kvalid = DM; gain_idx = 7; dst_off = WS_WIN; drow0 = 32 * g; Kd = DM; }
            else { r -= I_IN;
                if (r < I_BR) { const int g = r / 12, kb = r % 12, br = g / 64; const int kbr = br == 2 ? 512 : 768;
                    src_idx = 13 + br; src_off = (size_t)l * kbr * DM; ldw = DM; sc = 32 * (g % 64); k0 = 64 * kb; kvalid = kbr; dst_off = WS_WBR; drow0 = 32 * g; Kd = 768; }
                else { r -= I_BR; const int g = r / 32, kb = r % 32;
                    src_idx = 16; src_off = (size_t)l * DM * DM; ldw = DM; sc = 32 * g; k0 = 64 * kb; kvalid = DM; dst_off = WS_WOUT; drow0 = 32 * g; Kd = DM; } }
        }
        const float* W = (const float*)a.in[src_idx] + src_off;
        const float* gain = gain_idx >= 0 ? (const float*)a.in[gain_idx] + (size_t)l * DM : nullptr;
        conv_item(W, ldw, sc, cnt, k0, kvalid, gain, (bf16*)(F.ws + dst_off), drow0, Kd, scr, F.lane, blk);
    }
}
__device__ __forceinline__ void p_prologue(Frame& F0) {
    Frame F = F0; { GAS unsigned char* wsg_ = (GAS unsigned char*)F.ws; F.tid = F.wave * 64 + lane_id(); asm volatile("" : "+v"(F.tid), "+s"(wsg_), "+s"(F.vcu), "+s"(F.G)); F.lane = F.tid & 63; F.ws = (unsigned char*)wsg_; }
    const int gw = F.vcu * NWAVES + F.wave, NGW = F.G * NWAVES;
    float* rcos = (float*)(F.ws + WS_ROPE); float* rsin = rcos + (size_t)MTOK * 32;
    const int j = F.lane & 31;
    const float invf = powf(10000.0f, -(float)(2 * j) / 64.0f);
    for (int t2 = gw; t2 < MTOK / 2; t2 += NGW) { const int t = 2 * t2 + (F.lane >> 5);
        const float ang = (float)F.pos[t] * invf;
        double rev = (double)ang * 0.15915494309189533577; rev -= __builtin_rint(rev);
        const float fr = (float)rev;
        rcos[(size_t)t * 32 + j] = __builtin_amdgcn_cosf(fr); rsin[(size_t)t * 32 + j] = __builtin_amdgcn_sinf(fr); }
    { int* pc = (int*)(F.ws + WS_POS); for (int i = F.vcu * NTHR + F.tid; i < MTOK; i += F.G * NTHR) pc[i] = F.pos[i]; }
    int* kmax = (int*)(F.ws + WS_KMAX);
    for (int kt = gw; kt < BATCH * 256; kt += NGW) { const int p0 = F.pos[kt * 64 + F.lane]; int p = p0, q0 = p0;
#pragma unroll
        for (int o = 1; o < 64; o <<= 1) { const int q = __shfl_xor(p, o); p = q > p ? q : p; }
#pragma unroll
        for (int o = 1; o < 32; o <<= 1) { const int q = __shfl_xor(q0, o); q0 = q < q0 ? q : q0; }
        if (F.lane == 0) kmax[kt] = p;
        if ((F.lane & 31) == 0) kmax[1024 + 2 * kt + (F.lane >> 5)] = q0; }
    bf16* XB = (bf16*)(F.ws + WS_XB); float* part = (float*)(F.ws + WS_PART);
    for (int m = gw; m < MTOK; m += NGW) {
        const GAS f32x4* xr = (const GAS f32x4*)(F.xin + (size_t)m * DM) + F.lane; float ss = 0.f;
#pragma unroll
        for (int jj = 0; jj < 8; ++jj) { const f32x4 v = xr[64 * jj]; ss += (v[0] * v[0] + v[1] * v[1]) + (v[2] * v[2] + v[3] * v[3]);
            v2u w; w.x = pk2(v[0], v[1]); w.y = pk2(v[2], v[3]); *((GAS v2u*)(XB + (size_t)m * DM) + F.lane + 64 * jj) = w; }
        ss = wave_sum(ss);
        if (F.lane < 32) part[(size_t)m * 32 + F.lane] = F.lane == 0 ? ss : 0.f; }
}
__device__ __forceinline__ void p_rowstat(Frame& F0) {
    Frame F = F0; { GAS unsigned char* wsg_ = (GAS unsigned char*)F.ws; F.tid = F.wave * 64 + lane_id(); asm volatile("" : "+v"(F.tid), "+s"(wsg_), "+s"(F.vcu), "+s"(F.G)); F.lane = F.tid & 63; F.ws = (unsigned char*)wsg_; }
    const float* part = (const float*)(F.ws + WS_PART); float* rstd = (float*)(F.ws + WS_RSTD);
    for (int r = F.vcu * NTHR + F.tid; r < MTOK; r += F.G * NTHR) { const f32x4* p = (const f32x4*)(part + (size_t)r * 32); float s = 0.f;
#pragma unroll
        for (int jj = 0; jj < 8; ++jj) { const f32x4 v = p[jj]; s += (v[0] + v[1]) + (v[2] + v[3]); }
        rstd[r] = 1.0f / sqrtf(s * (1.0f / DM) + EPS); }
}
__device__ __forceinline__ void p_final(Frame& F0, const float* gfin) {
    Frame F = F0; { GAS unsigned char* wsg_ = (GAS unsigned char*)F.ws; F.tid = F.wave * 64 + lane_id(); asm volatile("" : "+v"(F.tid), "+s"(wsg_), "+s"(F.vcu), "+s"(F.G)); F.lane = F.tid & 63; F.ws = (unsigned char*)wsg_; }
    const int gw = F.vcu * NWAVES + F.wave, NGW = F.G * NWAVES; const float* rstd = (const float*)(F.ws + WS_RSTD);
    const float* part = (const float*)(F.ws + WS_PART); (void)rstd;
    for (int m = gw; m < MTOK; m += NGW) { GAS f32x4* xr = (GAS f32x4*)(F.X + (size_t)m * DM) + F.lane;
        const float rs = 1.0f / sqrtf(wave_sum(F.lane < 32 ? part[(size_t)m * 32 + F.lane] : 0.f) * (1.0f / DM) + EPS);
#if RESID_BF16
        const GAS v2u* xb = (const GAS v2u*)((const bf16*)(F.ws + WS_XB) + (size_t)m * DM) + F.lane;
#pragma unroll
        for (int jj = 0; jj < 8; ++jj) { const f32x4 g = *((const f32x4*)gfin + F.lane + 64 * jj); const v2u w = xb[64 * jj];
            xr[64 * jj] = (f32x4){bflo(w.x), bfhi(w.x), bflo(w.y), bfhi(w.y)} * rs * g; } }
#else
#pragma unroll
        for (int jj = 0; jj < 8; ++jj) { const f32x4 g = *((const f32x4*)gfin + F.lane + 64 * jj); xr[64 * jj] = xr[64 * jj] * rs * g; } }
#endif
}

namespace idx {
constexpr int IDX_STATE = 131072 + 128;
typedef LAS unsigned* lhist_t;
__device__ __forceinline__ int crow16(int r, int hi) { return (r & 3) + 8 * (r >> 2) + 4 * hi; }
struct QState { f16x8 qf[4][4]; f32x4 wv; };
struct KFrag { f16x8 k[4]; };
__device__ __forceinline__ void load_k(const GAS char* ws, int kt, int c, int hi, KFrag& K) {
    const GAS char* p = ws + (unsigned)((unsigned)WS_KI + (unsigned)((32 * kt + c) * 64 + 8 * hi) * 2u);
#pragma unroll
    for (int ks = 0; ks < 4; ++ks) K.k[ks] = *(const GAS f16x8*)(p + ks * 32);
}
typedef float f32x2 __attribute__((ext_vector_type(2)));
__device__ __forceinline__ void relu_fma(const f32x16& a, float w, f32x2 (&s2)[8]) {
    const f32x2 w2 = (f32x2){w, w};
#pragma unroll
    for (int i = 0; i < 8; ++i) { f32x2 p; { const float f0 = a[2 * i], f1 = a[2 * i + 1]; const int x0 = __builtin_bit_cast(int, f0), x1 = __builtin_bit_cast(int, f1);
            p.x = __builtin_bit_cast(float, x0 > 0 ? x0 : 0); p.y = __builtin_bit_cast(float, x1 > 0 ? x1 : 0); } s2[i] = p * w2 + s2[i]; }
}
__device__ __forceinline__ void score_tile2(const KFrag& Ka, const KFrag& Kb, const LAS char* qlds, const f32x4 wv, f32x16& sa, f32x16& sb) {
    f32x2 a2[8], b2[8];
#pragma unroll
    for (int i = 0; i < 8; ++i) { a2[i] = (f32x2){0.f, 0.f}; b2[i] = (f32x2){0.f, 0.f}; }
#pragma unroll
    for (int h = 0; h < 4; ++h) { f32x16 aa = {}, ab = {};
#pragma unroll
        for (int ks = 0; ks < 4; ++ks) { const f16x8 qf = *(const LAS f16x8*)(qlds + (h * 4 + ks) * 1024);
            aa = __builtin_amdgcn_mfma_f32_32x32x16_f16(Ka.k[ks], qf, aa, 0, 0, 0); ab = __builtin_amdgcn_mfma_f32_32x32x16_f16(Kb.k[ks], qf, ab, 0, 0, 0); }
        relu_fma(aa, wv[h], a2); relu_fma(ab, wv[h], b2); }
#pragma unroll
    for (int i = 0; i < 8; ++i) { sa[2 * i] = a2[i].x; sa[2 * i + 1] = a2[i].y; sb[2 * i] = b2[i].x; sb[2 * i + 1] = b2[i].y; }
}
__device__ __forceinline__ void score_tile1(const KFrag& Ka, const LAS char* qlds, const f32x4 wv, f32x16& sa) {
    f32x2 a2[8];
#pragma unroll
    for (int i = 0; i < 8; ++i) a2[i] = (f32x2){0.f, 0.f};
#pragma unroll
    for (int h = 0; h < 4; ++h) { f32x16 aa = {};
#pragma unroll
        for (int ks = 0; ks < 4; ++ks) aa = __builtin_amdgcn_mfma_f32_32x32x16_f16(Ka.k[ks], *(const LAS f16x8*)(qlds + (h * 4 + ks) * 1024), aa, 0, 0, 0);
        relu_fma(aa, wv[h], a2); }
#pragma unroll
    for (int i = 0; i < 8; ++i) { sa[2 * i] = a2[i].x; sa[2 * i + 1] = a2[i].y; }
}
__device__ __forceinline__ unsigned skey22(float s) { unsigned u = __builtin_bit_cast(unsigned, s); u ^= (unsigned)((int)u >> 31) | 0x80000000u; return u >> 10; }

template <int PASS, bool CAUSAL>
__device__ __forceinline__ void hist_tile(const f32x16& sc, int kt, int q, int c, int hi, lhist_t hrow, unsigned pfx) {
#pragma unroll
    for (int r = 0; r < 16; ++r) { const unsigned k22 = skey22(sc[r]); unsigned bin, inc;
        if (PASS == 0) { bin = k22 >> 11; inc = 1u; } else { bin = k22 & 2047u; inc = (k22 >> 11) == pfx ? 1u : 0u; }
        if (CAUSAL) { const int s = 32 * kt + crow16(r, hi); inc = s <= q ? inc : 0u; }
        __hip_atomic_fetch_add(hrow + ((bin >> 1) ^ (unsigned)c), inc << ((bin & 1u) * 16u), __ATOMIC_RELAXED, __HIP_MEMORY_SCOPE_WORKGROUP);
        if ((r & 3) == 3) __builtin_amdgcn_sched_barrier(0); }
}
template <int PASS>
__device__ __forceinline__ void hist_pass(const GAS char* ws, int q0, int qb32, int wave, int c, int hi, const LAS char* qlds, const f32x4 wv, lhist_t hist, unsigned pfx) {
    const int q = q0 + c; lhist_t hrow = hist + c * 1024;
    KFrag Ka, Kb;
    if (wave < qb32) { load_k(ws, wave, c, hi, Ka); load_k(ws, wave + 8 < qb32 ? wave + 8 : wave, c, hi, Kb); }
#pragma unroll 1
    for (int kt = wave; kt < qb32; kt += 16) { const bool has2 = kt + 8 < qb32;
        f32x16 sa, sb; score_tile2(Ka, Kb, qlds, wv, sa, sb);
        { const int kn = kt + 16 < qb32 ? kt + 16 : kt, kn2 = kn + 8 < qb32 ? kn + 8 : kn; load_k(ws, kn, c, hi, Ka); load_k(ws, kn2, c, hi, Kb); }
        hist_tile<PASS, false>(sa, kt, q, c, hi, hrow, pfx);
        if (has2) hist_tile<PASS, false>(sb, kt + 8, q, c, hi, hrow, pfx); }
    if (wave == (qb32 & 7)) { load_k(ws, qb32, c, hi, Ka); f32x16 sa; score_tile1(Ka, qlds, wv, sa); hist_tile<PASS, true>(sa, qb32, q, c, hi, hrow, pfx); }
}
constexpr int LROW = 1025;
template <bool CAUSAL>
__device__ __forceinline__ void lhist_tile(const f32x16& sc, int kt, int q, int c, int hi, lhist_t hrow, float ka, float kc) {
#pragma unroll
    for (int r = 0; r < 16; ++r) { const int b = (int)__builtin_amdgcn_fmed3f(__builtin_fmaf(sc[r], ka, kc), 0.f, 1023.f); unsigned inc = 1u;
        if (CAUSAL) { const int s = 32 * kt + crow16(r, hi); inc = s <= q ? 1u : 0u; }
        __hip_atomic_fetch_add(hrow + b, inc, __ATOMIC_RELAXED, __HIP_MEMORY_SCOPE_WORKGROUP);
        if ((r & 3) == 3) __builtin_amdgcn_sched_barrier(0); }
}
__device__ __forceinline__ void lhist_pass(const GAS char* ws, int q0, int qb32, int wave, int c, int hi, const LAS char* qlds, const f32x4 wv, lhist_t hist, float ka, float kc, int step, bool diag) {
    const int q = q0 + c; lhist_t hrow = hist + c * LROW;
    KFrag Ka, Kb;
    if (wave < qb32) { load_k(ws, wave, c, hi, Ka); load_k(ws, wave + 8 < qb32 ? wave + 8 : wave, c, hi, Kb); }
#pragma unroll 1
    for (int kt = wave; kt < qb32; kt += step) { const bool has2 = kt + 8 < qb32;
        f32x16 sa, sb; score_tile2(Ka, Kb, qlds, wv, sa, sb);
        { const int kn = kt + step < qb32 ? kt + step : kt, kn2 = kn + 8 < qb32 ? kn + 8 : kn; load_k(ws, kn, c, hi, Ka); load_k(ws, kn2, c, hi, Kb); }
        lhist_tile<false>(sa, kt, q, c, hi, hrow, ka, kc);
        if (has2) lhist_tile<false>(sb, kt + 8, q, c, hi, hrow, ka, kc); }
    if (diag && wave == (qb32 & 7)) { load_k(ws, qb32, c, hi, Ka); f32x16 sa; score_tile1(Ka, qlds, wv, sa); lhist_tile<true>(sa, qb32, q, c, hi, hrow, ka, kc); }
}
__device__ __forceinline__ void lin_scan(const LAS unsigned* hrow, int cq, int lane, unsigned& sl_out, unsigned& T_out) {
    unsigned sl = 0;
#pragma unroll
    for (int j = 0; j < 16; ++j) sl += hrow[16 * lane + j];
    unsigned T = sl;
#pragma unroll
    for (int o = 1; o < 64; o <<= 1) { const unsigned v = __shfl_down(T, o); T += (lane + o < 64) ? v : 0u; }
    sl_out = sl; T_out = T;
}
__device__ __forceinline__ int lin_locate(const LAS unsigned* hrow, int cq, int lane, unsigned sl, unsigned T, unsigned need, unsigned& need_out, unsigned& cnt_out) {
    const unsigned long long bal = __ballot(T >= need);
    if (bal == 0ull) { need_out = need; cnt_out = 0u; return -1; }
    const int L = 63 - __builtin_clzll(bal);
    int bin = -1; unsigned nn = need, cb = 0u;
    if (lane == L) { unsigned cum = T - sl;
#pragma unroll 1
        for (int j = 15; j >= 0 && bin < 0; --j) { const unsigned w = hrow[16 * lane + j];
            if (cum + w >= need) { bin = 16 * lane + j; nn = need - cum; cb = w; } else cum += w; } }
    bin = __shfl(bin, L); nn = __shfl(nn, L); cb = __shfl(cb, L); need_out = nn; cnt_out = cb; return bin;
}
__device__ __forceinline__ f32x4 load_wv(const GAS char* ws, int q) {
    unsigned o = (unsigned)WS_WI + (unsigned)q * 16u; asm volatile("" : "+v"(o));
    const f32x4 w = *(const GAS f32x4*)(ws + o);
    const float sa = fmaxf((__builtin_fabsf(w[0]) + __builtin_fabsf(w[1])) + (__builtin_fabsf(w[2]) + __builtin_fabsf(w[3])), 1e-30f);
    const float sc = __uint_as_float(__float_as_uint(40.0f / sa) & 0x7f800000u);
    return w * sc;
}
__device__ __forceinline__ int select_bin(const LAS unsigned* hrow, int cq, int lane, unsigned need, unsigned& need_out) {
    unsigned sl = 0;
#pragma unroll
    for (int j = 0; j < 16; ++j) { const unsigned w = hrow[(16 * lane + j) ^ cq]; sl += (w & 0xffffu) + (w >> 16); }
    unsigned T = sl;
#pragma unroll
    for (int o = 1; o < 64; o <<= 1) { const unsigned v = __shfl_down(T, o); T += (lane + o < 64) ? v : 0u; }
    const unsigned long long bal = __ballot(T >= need);
    if (bal == 0ull) { need_out = need; return -1; }
    const int L = 63 - __builtin_clzll(bal);
    int bin = -1; unsigned nn = need;
    if (lane == L) { unsigned cum = T - sl;
#pragma unroll 1
        for (int j = 15; j >= 0 && bin < 0; --j) { const unsigned w = hrow[(16 * lane + j) ^ cq]; const unsigned chi = w >> 16, clo = w & 0xffffu;
            if (cum + chi >= need) { bin = 32 * lane + 2 * j + 1; nn = need - cum; } else { cum += chi;
                if (cum + clo >= need) { bin = 32 * lane + 2 * j; nn = need - cum; } else cum += clo; } } }
    bin = __shfl(bin, L); nn = __shfl(nn, L); need_out = nn; return bin;
}
__device__ __forceinline__ void item(const Frame& F, int qb32) {
    lhist_t hist = (lhist_t)(F.lds); LAS unsigned* sta = (LAS unsigned*)(F.lds + IDX_STATE); LAS unsigned* need = sta + 32;
    LAS unsigned* Gw = (LAS unsigned*)(F.lds); LAS unsigned* Tw = (LAS unsigned*)(F.lds + 65536);
    const GAS char* ws = (const GAS char*)F.ws;
    int lane_ = lane_id();
    int wave_ = F.wave; asm volatile("" : "+s"(wave_));
    const int lane = lane_, wave = wave_, tid = wave * 64 + lane, c = lane & 31, hi = lane >> 5, q0 = 32 * qb32, q = q0 + c;
    LAS char* qall = (LAS char*)(F.lds + IDX_STATE + 1024);
    const LAS char* qlds = qall + lane * 16;
    if (wave == 0) {
#pragma unroll
        for (int h = 0; h < 4; ++h)
#pragma unroll
            for (int ks = 0; ks < 4; ++ks) *(LAS f16x8*)(qall + (h * 4 + ks) * 1024 + lane * 16) = *(const GAS f16x8*)(ws + (unsigned)((unsigned)WS_QI + (unsigned)(q * 256 + 8 * hi) * 2u) + (h * 64 + 16 * ks) * 2); }
    LAS unsigned* lcnt = sta + 96; LAS unsigned* slowf = sta + 128;
    LAS unsigned* lists = (LAS unsigned*)(F.lds + IDX_STATE + 1024 + 16384);
    constexpr unsigned LCAP = 56;
    if (tid < 32) { sta[tid] = 0u; need[tid] = (unsigned)TOPK; lcnt[tid] = 0u; } if (tid >= 32 && tid < 35) slowf[tid - 32] = 0u;
    const bool sel_needed = q0 + 31 >= TOPK;
    bool fast = false;
    if (sel_needed) {
        LAS float* kaf = (LAS float*)(sta + 160); LAS float* kcf = (LAS float*)(sta + 192);
        #ifndef IDX_CBCAP
#define IDX_CBCAP LCAP
#endif
#ifndef IDX_FORCEZOOM
#define IDX_FORCEZOOM 0
#endif
#ifndef IDX_SMAX
#define IDX_SMAX 16
#endif
#ifndef IDX_BRK_A
#define IDX_BRK_A 3.5f
#define IDX_BRK_B 5.0f
#endif
        const int S_ = qb32 >> 4, pstep = 16 * (S_ < 1 ? 1 : (S_ > IDX_SMAX ? IDX_SMAX : S_));
        LAS float* kza = (LAS float*)(sta + 224); LAS float* kzc = (LAS float*)(sta + 64);
        int nlp = 2;
#pragma unroll 1
        for (int lp = 0; lp < nlp; ++lp) {
#pragma unroll
            for (int i = 0; i < 64; ++i) hist[tid + 512 * i] = 0u;
            if (tid < 32) hist[32768 + tid] = 0u;
            LDS_WAIT(); __syncthreads();
            { float ka_ = 1.0f, kc_ = 256.0f; if (lp >= 1) { ka_ = kaf[c]; kc_ = kcf[c]; }
              const f32x4 wv = load_wv(ws, q); lhist_pass(ws, q0, qb32, wave, c, hi, qlds, wv, hist, ka_, kc_, lp == 0 ? pstep : 16, lp >= 1); }
            LDS_WAIT(); __syncthreads();
#pragma unroll 1
            for (int i = 0; i < 4; ++i) { const int cq = 4 * wave + i; unsigned sl, T; lin_scan(hist + cq * LROW, cq, lane, sl, T);
                if (lp == 0) {
                    const unsigned total = (unsigned)__builtin_amdgcn_readfirstlane((int)T);
                    const float rmid = 256.0f * (float)total / (float)(q0 + cq + 1), sq = __builtin_sqrtf(rmid);
                    const float fa = __builtin_floorf(rmid - IDX_BRK_A * sq - 2.0f), fb = __builtin_ceilf(rmid + IDX_BRK_B * sq + 8.0f);
                    const unsigned ra = fa < 1.0f ? 1u : (unsigned)fa, rb = (unsigned)fb; unsigned n0, n1;
                    const int ba = lin_locate(hist + cq * LROW, cq, lane, sl, T, ra, n0, n1); int bb = lin_locate(hist + cq * LROW, cq, lane, sl, T, rb, n0, n1);
                    if (bb < 0) bb = 0;
                    if (lane == 0) { const float lo = (float)(bb - 256), hiw = (float)(ba - 255); const float ka_ = 1022.0f / (hiw - lo); kaf[cq] = ka_; kcf[cq] = 1.0f - lo * ka_; } }
                else { unsigned nn, cb; const int bin = lin_locate(hist + cq * LROW, cq, lane, sl, T, (unsigned)TOPK, nn, cb);
                    if (lane == 0) { sta[cq] = (unsigned)bin; need[cq] = nn;
                        const float kc0 = kcf[cq]; const int zb = (int)__builtin_floorf(__builtin_amdgcn_fmed3f(kc0, 0.f, 1023.f));
                        if (!(bin >= 1 && bin <= 1022)) __hip_atomic_fetch_or(slowf + (lp - 1), 1u, __ATOMIC_RELAXED, __HIP_MEMORY_SCOPE_WORKGROUP);
                        else if (!(bin == zb || cb <= IDX_CBCAP)) __hip_atomic_fetch_or(slowf + (lp - 1), lp == 1 ? 8u : 2u, __ATOMIC_RELAXED, __HIP_MEMORY_SCOPE_WORKGROUP);
                        if (lp == 1) { const float Z = 1022.0f / 3.0f; kza[cq] = kaf[cq] * Z; kzc[cq] = (kc0 - (float)(bin - 1)) * Z + 1.0f; } } } }
            LDS_WAIT(); __syncthreads();
            if (lp == 1) { const int f1 = __builtin_amdgcn_readfirstlane((int)slowf[0]);
                if (f1 == 8 || (IDX_FORCEZOOM && f1 == 0)) { nlp = 3; if (tid < 32) { kaf[tid] = kza[tid]; kcf[tid] = kzc[tid]; } } }
        }
        { const int f1 = __builtin_amdgcn_readfirstlane((int)slowf[0]), f2 = __builtin_amdgcn_readfirstlane((int)slowf[1]); fast = nlp == 2 ? f1 == 0 : f2 == 0; }
        if (fast) {
            const f32x4 wv = load_wv(ws, q);
            const float loT = (float)(int)sta[c], hiT = loT + 1.0f, ka_ = kaf[c], kc_ = kcf[c];
#define MASK_TILE_F(SC, KT, CAUSAL) do { unsigned gb = 0u, eb = 0u, tb = 0u; \
            _Pragma("unroll") for (int r = 15; r >= 0; --r) { const float u2_ = __builtin_fmaf(SC[r], ka_, kc_); \
                bool g_ = u2_ >= hiT, e_ = u2_ >= loT; if (CAUSAL) { const bool ok_ = 32 * (KT) + crow16(r, hi) <= q; g_ = g_ && ok_; e_ = e_ && ok_; } \
                gb = gb + gb + (g_ ? 1u : 0u); eb = eb + eb + (e_ ? 1u : 0u); \
                if ((r & 3) == 0) __builtin_amdgcn_sched_barrier(0); } \
            eb &= ~gb;                                              \
            if (eb != 0u) { \
                _Pragma("unroll") for (int r = 0; r < 16; ++r) if (eb & (1u << r)) { const float t_ = SC[r]; \
                    if (t_ == 0.f) tb |= 1u << ((r & 3) + 8 * (r >> 2)); \
                    else { const unsigned p_ = __hip_atomic_fetch_add(lcnt + c, 1u, __ATOMIC_RELAXED, __HIP_MEMORY_SCOPE_WORKGROUP); \
                           if (p_ < LCAP) { unsigned u_ = __float_as_uint(t_); u_ ^= (unsigned)((int)u_ >> 31) | 0x80000000u; \
                               *(LAS v2u*)(lists + 2 * (c * LCAP + p_)) = (v2u){16383u - (unsigned)(32 * (KT) + crow16(r, hi)), u_}; } } } } \
            gb = (gb | (gb << 8)) & 0x00ff00ffu; gb = (gb | (gb << 4)) & 0x0f0f0f0fu;     \
            gb <<= 4 * hi; tb <<= 4 * hi; gb |= (unsigned)__shfl_xor((int)gb, 32); tb |= (unsigned)__shfl_xor((int)tb, 32); \
            if (hi == 0) { Gw[c * 512 + (KT)] = gb; Tw[c * 512 + (KT)] = tb; } } while (0)
            KFrag Ka, Kb;
            if (wave < qb32) { load_k(ws, wave, c, hi, Ka); load_k(ws, wave + 8 < qb32 ? wave + 8 : wave, c, hi, Kb); }
#pragma unroll 1
            for (int kt = wave; kt < qb32; kt += 16) { const bool has2 = kt + 8 < qb32;
                f32x16 sa, sb; score_tile2(Ka, Kb, qlds, wv, sa, sb);
                { const int kn = kt + 16 < qb32 ? kt + 16 : kt, kn2 = kn + 8 < qb32 ? kn + 8 : kn; load_k(ws, kn, c, hi, Ka); load_k(ws, kn2, c, hi, Kb); }
                MASK_TILE_F(sa, kt, false);
                if (has2) MASK_TILE_F(sb, kt + 8, false); }
            if (wave == (qb32 & 7)) { load_k(ws, qb32, c, hi, Ka); f32x16 sa; score_tile1(Ka, qlds, wv, sa); MASK_TILE_F(sa, qb32, true); }
#undef MASK_TILE_F
            LDS_WAIT(); __syncthreads();
#pragma unroll 1
            for (int i = 0; i < 4; ++i) { const int cq = 4 * wave + i; const unsigned n = lcnt[cq], rk = need[cq];
                if (n > LCAP) { if (lane == 0) slowf[2] = 1u; }
                else { v2u e = (v2u){0u, 0u}; if (lane < (int)n) e = *(const LAS v2u*)(lists + 2 * (cq * LCAP + lane));
                    const unsigned long long ev = ((unsigned long long)e.y << 32) | e.x; unsigned above = 0u;
#pragma unroll 1
                    for (unsigned j = 0; j < n; ++j) { const unsigned long long ej = ((unsigned long long)(unsigned)__builtin_amdgcn_readlane((int)e.y, (int)j) << 32) | (unsigned)__builtin_amdgcn_readlane((int)e.x, (int)j);
                        above += ej > ev ? 1u : 0u; }
                    if (lane < (int)n && above < rk) { const unsigned sidx = 16383u - e.x;
                        __hip_atomic_fetch_or(Gw + cq * 512 + (sidx >> 5), 1u << (sidx & 31u), __ATOMIC_RELAXED, __HIP_MEMORY_SCOPE_WORKGROUP); }
                    if (lane == 0) need[cq] = rk > n ? rk - n : 0u; } }
            LDS_WAIT(); __syncthreads();
            fast = __builtin_amdgcn_readfirstlane((int)slowf[2]) == 0;
        }
    } else { LDS_WAIT(); __syncthreads(); }
#ifndef PROBE_IDXFB
#define PROBE_IDXFB 1
#endif
#ifndef PROBE_IDXFB_MASK
#define PROBE_IDXFB_MASK 7
#endif
    const int slow_reason = 7;
    if (!fast)
#pragma unroll 1
    for (int fbrep_ = 0, fbn_ = rep_count((sel_needed && (slow_reason & PROBE_IDXFB_MASK)) ? PROBE_IDXFB : 1); fbrep_ < fbn_; ++fbrep_) {
        __syncthreads();
        if (tid < 32) { sta[tid] = 0u; need[tid] = (unsigned)TOPK; }
        const f32x4 wv = load_wv(ws, q);
        const bool all = q < TOPK; lhist_t hrow = hist + c * 1024;
#pragma unroll 1
        for (int mode = sel_needed ? 0 : 2; mode < 3; ++mode) {
            if (mode < 2) {
#pragma unroll 1
                for (int i = 0; i < 64; ++i) hist[tid + 512 * i] = 0u; }
            LDS_WAIT(); __syncthreads();
            unsigned a = sta[c]; if (all) a = 0u;
#pragma unroll 1
            for (int kt = wave; kt <= qb32; kt += 8) { KFrag Ka; load_k(ws, kt, c, hi, Ka); f32x16 sa; score_tile1(Ka, qlds, wv, sa);
                unsigned gb = 0u, tb = 0u;
#pragma unroll
                for (int r = 15; r >= 0; --r) { const int c0 = (r & 3) + 8 * (r >> 2); const unsigned k22 = skey22(sa[r]); const bool ok = 32 * kt + c0 + 4 * hi <= q;
                    if (mode == 2) { gb = gb + gb + ((ok && (all || k22 > a)) ? 1u : 0u); tb = tb + tb + ((ok && !all && k22 == a) ? 1u : 0u); }
                    else { const unsigned bin = mode == 0 ? k22 >> 11 : k22 & 2047u; const unsigned inc = (ok && (mode == 0 || (k22 >> 11) == a)) ? 1u : 0u;
                        __hip_atomic_fetch_add(hrow + ((bin >> 1) ^ (unsigned)c), inc << ((bin & 1u) * 16u), __ATOMIC_RELAXED, __HIP_MEMORY_SCOPE_WORKGROUP); }
                    if ((r & 3) == 0) __builtin_amdgcn_sched_barrier(0); }
                if (mode == 2) { gb = (gb | (gb << 8)) & 0x00ff00ffu; gb = (gb | (gb << 4)) & 0x0f0f0f0fu; tb = (tb | (tb << 8)) & 0x00ff00ffu; tb = (tb | (tb << 4)) & 0x0f0f0f0fu;
                    gb <<= 4 * hi; tb <<= 4 * hi; gb |= (unsigned)__shfl_xor((int)gb, 32); tb |= (unsigned)__shfl_xor((int)tb, 32);
                    if (hi == 0) { Gw[c * 512 + kt] = gb; Tw[c * 512 + kt] = tb; } } }
            LDS_WAIT(); __syncthreads();
            if (mode < 2) {
#pragma unroll 1
                for (int i = 0; i < 4; ++i) { const int cq = 4 * wave + i; unsigned nn; const int bin = select_bin(hist + cq * 1024, cq, lane, need[cq], nn);
                    if (lane == 0 && bin >= 0) { sta[cq] = mode == 0 ? (unsigned)bin : ((sta[cq] << 11) | (unsigned)bin); need[cq] = nn; } }
                LDS_WAIT(); __syncthreads(); }
        }
    }
    LDS_WAIT(); __syncthreads();
    const int kt_end = 8 * (q0 / 256 + 1);
    GAS unsigned* MK = (GAS unsigned*)(F.ws + WS_MASK);
#pragma unroll 1
    for (int i = 0; i < 4; ++i) { const int cq = 4 * wave + i; const unsigned r = need[cq]; unsigned base = 0u;
#pragma unroll 1
        for (int k0 = 0; k0 < kt_end; k0 += 64) { const int kt = k0 + lane; const bool live = kt <= qb32;
            const unsigned g = live ? Gw[cq * 512 + kt] : 0u, t = live ? Tw[cq * 512 + kt] : 0u; const unsigned p = __builtin_popcount(t);
            unsigned C = p;
#pragma unroll
            for (int o = 1; o < 64; o <<= 1) { const unsigned v = __shfl_up(C, o); C += (lane >= o) ? v : 0u; }
            const unsigned before = base + C - p;
            unsigned keep = t;
            if (before >= r) keep = 0u;
            else if (before + p > r) { unsigned left = r - before, m = 0u, tt = t;
#pragma unroll 1
                while (left) { const unsigned lowbit = tt & (0u - tt); m |= lowbit; tt ^= lowbit; --left; }
                keep = m; }
            if (kt < kt_end) MK[((size_t)(kt >> 1) * HROWS + (q0 + cq)) * 2 + (kt & 1)] = g | keep;
            base += __shfl(C, 63); } }
    __syncthreads();
}
}

namespace att {
constexpr int D = 128, NW = 8, QBLK = 32, KVBLK = 64, QB = 256, STR = 768;
constexpr float SCALE = 0.08838834764831845f, THR = 8.f;
constexpr int SHM_V = KVBLK * D * 2, SHM_K = KVBLK * D * 2;
constexpr int ATT_LDS = 2 * SHM_V + 2 * SHM_K + NW * 64 * 4;
constexpr int BIAS_OFF = ATT_LDS;
constexpr int QL_OFF = ATT_LDS + 3200;
typedef short s16x4 __attribute__((ext_vector_type(4)));
typedef LAS char* lp_t;
#define KSWZ(row, colB) ((row) * 256 + ((colB) ^ (((row) & 7) << 4)))
#define SBAR() __builtin_amdgcn_sched_barrier(0)
__device__ __forceinline__ int v_st(int k, int c) { const int kk = (k & ~0xC) | ((k & 4) << 1) | ((k & 8) >> 1); return ((kk >> 3) * 4 + (c >> 5)) * 512 + ((kk & 7) * 32 + (c & 31)) * 2; }
__device__ __forceinline__ int v_rd_base(int lane) { return ((lane & 3) << 3) | (((lane >> 2) & 3) << 6) | (((lane >> 4) & 1) << 5) | (((lane >> 5) & 1) << 8); }
constexpr int v_rd_off(int d0, int ks, int half) { return d0 * 512 + ks * 4096 + half * 2048; }
__device__ __forceinline__ int crow(int r, int hi) { return (r & 3) + 8 * (r >> 2) + 4 * hi; }
__device__ __forceinline__ unsigned cvtpk(float lo, float hi) { unsigned r; asm volatile("v_cvt_pk_bf16_f32 %0, %1, %2" : "=v"(r) : "v"(lo), "v"(hi)); return r; }
__device__ __forceinline__ bf16x8 load8(const unsigned short* p) { return *reinterpret_cast<const bf16x8*>(p); }

__device__ __forceinline__ void partialSM(f32x16& p0, f32x16& p1, float& m_reg, float& mn, float& alpha) {
    float pmax = p0[0]; for (int r = 1; r < 16; ++r) pmax = fmaxf(pmax, p0[r]); for (int r = 0; r < 16; ++r) pmax = fmaxf(pmax, p1[r]);
    { auto rr = __builtin_amdgcn_permlane32_swap(__float_as_uint(pmax), __float_as_uint(pmax), false, false);
      pmax = fmaxf(__uint_as_float(rr[0]), __uint_as_float(rr[1])); }
    constexpr float C2 = 1.4426950408889634f * SCALE;
    if (__builtin_expect(__all((pmax - m_reg) * SCALE <= THR), 1)) { mn = m_reg; alpha = 1.f; }
    else { mn = fmaxf(m_reg, pmax); alpha = __builtin_amdgcn_exp2f((m_reg - mn) * C2); m_reg = mn; }
    const float mnL = -mn * C2;
    for (int r = 0; r < 16; ++r) p0[r] = fmaf(p0[r], C2, mnL); for (int r = 0; r < 16; ++r) p1[r] = fmaf(p1[r], C2, mnL);
    for (int r = 0; r < 16; ++r) p0[r] = __builtin_amdgcn_exp2f(p0[r]);
}
__device__ __forceinline__ void finishSM(f32x16& p0, f32x16& p1, float alpha, float& l_reg, bf16x8& pa0, bf16x8& pa1, bf16x8& pa2, bf16x8& pa3) {
    for (int r = 0; r < 16; ++r) p1[r] = __builtin_amdgcn_exp2f(p1[r]);
    float ps = 0; for (int r = 0; r < 16; ++r) ps += p0[r]; for (int r = 0; r < 16; ++r) ps += p1[r];
    { auto rr = __builtin_amdgcn_permlane32_swap(__float_as_uint(ps), __float_as_uint(ps), false, false);
      ps = __uint_as_float(rr[0]) + __uint_as_float(rr[1]); }
    l_reg = l_reg * alpha + ps;
#define PK4(P, B_, OUT) do { unsigned a0 = cvtpk(P[B_+0], P[B_+1]), a1 = cvtpk(P[B_+2], P[B_+3]);                          \
        unsigned b0 = cvtpk(P[B_+4], P[B_+5]), b1 = cvtpk(P[B_+6], P[B_+7]);                                             \
        auto r0 = __builtin_amdgcn_permlane32_swap(a0, b0, false, false); auto r1 = __builtin_amdgcn_permlane32_swap(a1, b1, false, false); \
        v4u w = {r0[0], r1[0], r0[1], r1[1]}; OUT = *reinterpret_cast<bf16x8*>(&w); } while (0)
    PK4(p0, 0, pa0); PK4(p0, 8, pa1); PK4(p1, 0, pa2); PK4(p1, 8, pa3);
#undef PK4
}
template <int KB>
__device__ __forceinline__ void qkt(f32x16& p0, f32x16& p1, const LAS char* K_lds, int r32, int hi, const bf16x8* qr) {
    p0 = f32x16{}; p1 = f32x16{};
    const LAS char* kb[4];
#pragma unroll
    for (int dd = 0; dd < 4; ++dd) kb[dd] = K_lds + KB * SHM_K + KSWZ(r32, (dd * 16 + hi * 8) * 2);
#pragma unroll
    for (int d0 = 0; d0 < 8; ++d0) { const LAS char* a = kb[d0 & 3] + (d0 >> 2) * 128;
        bf16x8 b0 = *reinterpret_cast<const LAS bf16x8*>(a);
        bf16x8 b1 = *reinterpret_cast<const LAS bf16x8*>(a + 32 * 256);
        p0 = __builtin_amdgcn_mfma_f32_32x32x16_bf16(b0, qr[d0], p0, 0, 0, 0);
        p1 = __builtin_amdgcn_mfma_f32_32x32x16_bf16(b1, qr[d0], p1, 0, 0, 0); }
}
template <int VB>
__device__ __forceinline__ void pv_tile(f32x16* o, int vb0, bf16x8 pa0, bf16x8 pa1, bf16x8 pa2, bf16x8 pa3) {
#define TRRD(dst, off) asm volatile("ds_read_b64_tr_b16 %0, %1 offset:%2" : "=&v"(dst) : "v"(vb0), "i"(off) : "memory")
#define PV_D0(d0) do { s16x4 l0, l1, l2, l3, h0, h1, h2, h3; constexpr int b_ = VB * SHM_V + v_rd_off(d0, 0, 0); \
        TRRD(l0, b_); TRRD(h0, b_ + 2048); TRRD(l1, b_ + 4096); TRRD(h1, b_ + 6144); TRRD(l2, b_ + 8192); TRRD(h2, b_ + 10240); TRRD(l3, b_ + 12288); TRRD(h3, b_ + 14336); \
        asm volatile("s_waitcnt lgkmcnt(0)" ::: "memory"); SBAR();   \
        o[d0] = __builtin_amdgcn_mfma_f32_32x32x16_bf16(pa0, (bf16x8){l0[0], l0[1], l0[2], l0[3], h0[0], h0[1], h0[2], h0[3]}, o[d0], 0, 0, 0);   \
        o[d0] = __builtin_amdgcn_mfma_f32_32x32x16_bf16(pa1, (bf16x8){l1[0], l1[1], l1[2], l1[3], h1[0], h1[1], h1[2], h1[3]}, o[d0], 0, 0, 0);   \
        o[d0] = __builtin_amdgcn_mfma_f32_32x32x16_bf16(pa2, (bf16x8){l2[0], l2[1], l2[2], l2[3], h2[0], h2[1], h2[2], h2[3]}, o[d0], 0, 0, 0);   \
        o[d0] = __builtin_amdgcn_mfma_f32_32x32x16_bf16(pa3, (bf16x8){l3[0], l3[1], l3[2], l3[3], h3[0], h3[1], h3[2], h3[3]}, o[d0], 0, 0, 0); } while (0)
    PV_D0(0); PV_D0(1); PV_D0(2); PV_D0(3);
#undef PV_D0
#undef TRRD
}
__device__ __forceinline__ void apply_mask(f32x16& p0, f32x16& p1, v2u mw, int hi) {
    const int m0 = (int)(mw.x >> (4 * hi)), m1 = (int)(mw.y >> (4 * hi)); const unsigned NEG = 0xff800000u;
#pragma unroll
    for (int r = 0; r < 16; ++r) { const int c = (r & 3) + 8 * (r >> 2);
        const unsigned a0 = (unsigned)((m0 << (31 - c)) >> 31), a1 = (unsigned)((m1 << (31 - c)) >> 31);
        p0[r] = __uint_as_float((__float_as_uint(p0[r]) & a0) | (NEG & ~a0)); p1[r] = __uint_as_float((__float_as_uint(p1[r]) & a1) | (NEG & ~a1)); }
}
__device__ __forceinline__ void bias_tile(f32x16& p0, f32x16& p1, const GAS char* ws, unsigned pko  , int pq, const LAS float* bT, int hi) {
    const unsigned ho = pko + (unsigned)hi * 16u;
#pragma unroll
    for (int r = 0; r < 16; ++r) { const int c = (r & 3) + 8 * (r >> 2);
        int d0 = pq - *(const GAS int*)(ws + (unsigned)(ho + c * 4)); d0 = d0 < 0 ? 0 : (d0 > 128 ? 128 : d0); p0[r] += bT[d0];
        int d1 = pq - *(const GAS int*)(ws + (unsigned)(ho + (c + 32) * 4)); d1 = d1 < 0 ? 0 : (d1 > 128 ? 128 : d1); p1[r] += bT[d1];
        if ((r & 3) == 3) asm volatile("" ::: "memory"); }
}
struct BlockRef { int P0, h, t0, nt, pidx; };
struct Seam { bf16x8 qr[8]; bf16x8 st_v0, st_v1, st_k0, st_k1; };
typedef const GAS char* gp_t;
#define VMW() asm volatile("s_waitcnt vmcnt(0)" ::: "memory")
#define LD8W(off) (*reinterpret_cast<const GAS bf16x8*>(ws + (unsigned)(off)))
#define SLOAD_H(ko_, k0) do { const unsigned so0_ = so0, so1_ = so1; \
        const unsigned t_ = (unsigned)(k0) * (STR * 2u) + (ko_); \
        S.st_v0 = LD8W(t_ + (unsigned)(WS_VA - WS_KA) + so0_); S.st_v1 = LD8W(t_ + (unsigned)(WS_VA - WS_KA) + so1_); S.st_k0 = LD8W(t_ + so0_); S.st_k1 = LD8W(t_ + so1_); } while (0)
#define SWRITE_HK(bf) do { const int kws_ = kws; \
        *(LAS bf16x8*)(K_lds + (bf) * SHM_K + kws_) = S.st_k0; *(LAS bf16x8*)(K_lds + (bf) * SHM_K + kws_ + 32 * 256) = S.st_k1; } while (0)
#define SWRITE_HV(bf) do { const int vs0_ = vst0, vs1_ = vst1; \
        *(LAS bf16x8*)(V_lds + (bf) * SHM_V + vs0_) = S.st_v0; *(LAS bf16x8*)(V_lds + (bf) * SHM_V + vs1_) = S.st_v1; } while (0)
#define SWRITE_H(bf) do { SWRITE_HV(bf); SWRITE_HK(bf); } while (0)
__device__ __forceinline__ unsigned q_off(const BlockRef& r) { return (unsigned)WS_QA + (unsigned)(r.P0 * STR + r.h * 128) * 2u; }
__device__ __forceinline__ unsigned k_off(const BlockRef& r) { return (unsigned)WS_KA + (unsigned)(r.h * 128) * 2u; }
__device__ __forceinline__ void prime(const BlockRef& cur, gp_t ws, lp_t lds, Seam& S, int tid) {
    const int wid = __builtin_amdgcn_readfirstlane(tid >> 6), lane = tid & 63, r32 = lane & 31, hi = lane >> 5;
    lp_t K_lds = lds + 2 * SHM_V;
    const unsigned qo = (unsigned)((wid * QBLK + r32) * STR + hi * 8) * 2u;
    const unsigned so0 = (unsigned)((tid >> 4) * STR + (tid & 15) * 8) * 2u, so1 = so0 + 32u * STR * 2u; const int kws = KSWZ(tid >> 4, (tid & 15) * 16);
    const unsigned qb_ = q_off(cur) + qo, ko_ = k_off(cur);
#pragma unroll
    for (int d0 = 0; d0 < 8; ++d0) S.qr[d0] = LD8W(qb_ + d0 * 32);
    SLOAD_H(ko_, cur.t0 * KVBLK); VMW(); SWRITE_HK(0);
    __syncthreads();
}
__device__ __forceinline__ void block(const BlockRef& cur, const BlockRef& nxt, gp_t ws, lp_t lds, Seam& S, int b, int tid) {
    const int wid = __builtin_amdgcn_readfirstlane(tid >> 6), lane = tid & 63, r32 = lane & 31, hi = lane >> 5;
    const int NT = cur.nt, T0 = cur.t0, NTA = cur.P0 / KVBLK + QB / KVBLK;
    const int qrow = cur.P0 + wid * QBLK + r32;
    lp_t V_lds = lds; lp_t K_lds = lds + 2 * SHM_V;
    LAS float* wsf = (LAS float*)(lds + 2 * SHM_V + 2 * SHM_K) + wid * 64; LAS float* li_l = wsf; LAS float* al_l = wsf + 32;
    const LAS float* bT = (const LAS float*)(lds + BIAS_OFF) + cur.h * 132;
    float m_reg = -1e30f, l_reg = 0; f32x16 o[4]; o[0] = zero16(); o[1] = zero16(); o[2] = zero16(); o[3] = zero16();
    const int vb0 = (int)(unsigned)(uintptr_t)V_lds + v_rd_base(lane);
    const unsigned so0 = (unsigned)((tid >> 4) * STR + (tid & 15) * 8) * 2u, so1 = so0 + 32u * STR * 2u; const int kws = KSWZ(tid >> 4, (tid & 15) * 16), vst0 = v_st(tid >> 4, (tid & 15) * 8), vst1 = v_st(32 + (tid >> 4), (tid & 15) * 8);
    const unsigned ko_ = k_off(cur);
    const unsigned pbo = (unsigned)WS_POS + (unsigned)b * (SEQ * 4u);
    const int pq = *(const GAS int*)(ws + (unsigned)(pbo + (unsigned)qrow * 4u));
    const int qmin = *(const GAS int*)(ws + (unsigned)((unsigned)WS_KMAX + (unsigned)(1024 + b * 512 + (cur.P0 >> 5) + wid) * 4u));
    const unsigned mo = (unsigned)WS_MASK + (unsigned)qrow * 8u;
    int nearfirst = NTA;
    { const unsigned kmo = (unsigned)WS_KMAX + (unsigned)b * 1024u;
#pragma unroll 1
      for (int t0 = 0; t0 < NTA; t0 += 64) { const int t_ = t0 + lane; const int km = *(const GAS int*)(ws + (unsigned)(kmo + (unsigned)(t_ < NTA ? t_ : NTA - 1) * 4u));
          const unsigned long long bal = __ballot(t_ < NTA && qmin - km < 128);
          if (bal) { nearfirst = t0 + (int)__builtin_ctzll(bal); break; } } }
#define MLOAD(t) (*(const GAS v2u*)(ws + (unsigned)((unsigned)(T0 + (t)) * (HROWS * 8u) + mo)))
#define RESC(a) do { if (__any((a) < 1.f)) { if (hi == 0) al_l[r32] = (a); asm volatile("s_waitcnt lgkmcnt(0)" ::: "memory");              \
                     for (int d_ = 0; d_ < 4; ++d_) for (int r = 0; r < 16; ++r) o[d_][r] *= al_l[crow(r, hi)]; } } while (0)
#define KBASE(t) ((T0 + (t)) * KVBLK)
#define MASKT(P0_, P1_, t, MW) do { if (T0 + (t) >= nearfirst) bias_tile(P0_, P1_, ws, pbo + (unsigned)KBASE(t) * 4u, pq, bT, hi); apply_mask(P0_, P1_, MW, hi); } while (0)
    f32x16 pA0, pA1, pB0, pB1; float mnA, mnB, alA, alB; bf16x8 pa0, pa1, pa2, pa3;
    v2u mwc = MLOAD(0);
    SWRITE_HV(0); SBAR();
    if (NT > 1) { SLOAD_H(ko_, KBASE(1)); }
    SBAR(); qkt<0>(pA0, pA1, K_lds, r32, hi, S.qr);
    MASKT(pA0, pA1, 0, mwc); partialSM(pA0, pA1, m_reg, mnA, alA);
    if (NT > 1) { VMW(); SWRITE_H(1); }
    __syncthreads();
#define HALF_STEP(PX0, PX1, mnX, alX, PY0, PY1, alY, t, KB, VB, SB) do {                                                      \
        mwc = MLOAD(t);                                                                                                        \
        SBAR(); qkt<KB>(PX0, PX1, K_lds, r32, hi, S.qr);                                                                      \
        finishSM(PY0, PY1, alY, l_reg, pa0, pa1, pa2, pa3); SBAR();                                                           \
        if ((t) + 1 < NT) { SLOAD_H(ko_, KBASE((t) + 1)); SBAR(); }                                                           \
        pv_tile<VB>(o, vb0, pa0, pa1, pa2, pa3); MASKT(PX0, PX1, (t), mwc); partialSM(PX0, PX1, m_reg, mnX, alX);             \
        __syncthreads();                                                                                                      \
        if ((t) + 1 < NT) { VMW(); SWRITE_H(SB); }                                                                            \
        RESC(alX); __syncthreads(); } while (0)
#pragma unroll 1
    for (int t = 1; t + 1 < NT; t += 2) {
        HALF_STEP(pB0, pB1, mnB, alB, pA0, pA1, alA, t, 1, 0, 0);
        HALF_STEP(pA0, pA1, mnA, alA, pB0, pB1, alB, t + 1, 0, 1, 1);
    }
    mwc = MLOAD(NT - 1);
    SBAR(); qkt<1>(pB0, pB1, K_lds, r32, hi, S.qr); SBAR();
    { const unsigned kn_ = k_off(nxt); SLOAD_H(kn_, nxt.t0 * KVBLK); } SBAR();
    int lane_t = lane; asm volatile("" : "+v"(lane_t));
    { const unsigned qn_ = q_off(nxt) + (unsigned)((wid * QBLK + (lane_t & 31)) * STR + (lane_t >> 5) * 8) * 2u;
#pragma unroll
      for (int d0 = 0; d0 < 8; ++d0) S.qr[d0] = LD8W(qn_ + d0 * 32); }
    SBAR();
    finishSM(pA0, pA1, alA, l_reg, pa0, pa1, pa2, pa3); SBAR();
    pv_tile<0>(o, vb0, pa0, pa1, pa2, pa3);
    MASKT(pB0, pB1, NT - 1, mwc); partialSM(pB0, pB1, m_reg, mnB, alB); __syncthreads(); RESC(alB);
    finishSM(pB0, pB1, alB, l_reg, pa0, pa1, pa2, pa3); SBAR(); pv_tile<1>(o, vb0, pa0, pa1, pa2, pa3);
    SBAR(); VMW(); SWRITE_HK(0); SBAR();
    if (cur.pidx >= 0) {
        const unsigned po = (unsigned)WS_APART + (unsigned)cur.pidx * (QB * 128u * 4u) + (unsigned)((wid * QBLK + 4 * (lane_t >> 5)) * 128 + (lane_t & 31)) * 4u;
#pragma unroll
        for (int r = 0; r < 16; ++r) { const int orc = (r & 3) + 8 * (r >> 2);
#pragma unroll
            for (int d0 = 0; d0 < 4; ++d0) *(GAS float*)((GAS char*)ws + (unsigned)(po + (unsigned)(orc * 128 + d0 * 32) * 4u)) = o[d0][r]; }
        if ((lane_t >> 5) == 0) { typedef float f2_t __attribute__((ext_vector_type(2)));
            *(GAS f2_t*)((GAS char*)ws + (unsigned)((unsigned)WS_AML + (unsigned)(cur.pidx * QB + wid * QBLK + (lane_t & 31)) * 8u)) = (f2_t){m_reg, l_reg}; }
    } else {
    if (hi == 0) li_l[r32] = l_reg; asm volatile("s_waitcnt lgkmcnt(0)" ::: "memory");
    float rli[16];
#pragma unroll
    for (int r = 0; r < 16; ++r) rli[r] = __builtin_amdgcn_rcpf(li_l[crow(r, hi)]);
    const unsigned oo = (unsigned)WS_OBR + (unsigned)HROWS * 768u * 2u + (unsigned)((cur.P0 + wid * QBLK + 4 * (lane_t >> 5)) * STR + cur.h * 128 + (lane_t & 31)) * 2u;
#pragma unroll
    for (int r = 0; r < 16; ++r) { const int orc = (r & 3) + 8 * (r >> 2);
#pragma unroll
        for (int d0 = 0; d0 < 4; ++d0) { const float v = o[d0][r] * rli[r];
            const float vn = __uint_as_float((unsigned)__builtin_amdgcn_update_dpp(0, (int)__float_as_uint(v), 0xB1, 0xF, 0xF, false));
            if ((r32 & 1) == 0) *(GAS unsigned*)((GAS char*)ws + (unsigned)(oo + (unsigned)(orc * STR + d0 * 32) * 2u)) = cvtpk(v, vn); } }
    }
    __syncthreads();
#undef MLOAD
#undef RESC
#undef KBASE
#undef MASKT
#undef HALF_STEP
}
#undef LD8W
#undef VMW
#undef SLOAD_H
#undef SWRITE_HK
#undef SWRITE_HV
#undef SWRITE_H
}

constexpr int ATT_NIT = 480, ATT_QSPLIT = 48;
__device__ __forceinline__ att::BlockRef att_ref(int i) { att::BlockRef r; int qb, h, part = -1;
    if (i < 96) { qb = 47 - i / 6; h = i % 6; }
    else if (i < 336) { const int j = i - 96, p = j / 30, q = j % 30;
        if (q < 12) { qb = 63 - 2 * p; part = q / 6; h = q % 6; } else if (q < 18) { qb = 31 - p; h = q - 12; } else { qb = 62 - 2 * p; part = (q - 18) / 6; h = (q - 18) % 6; } }
    else { const int j = i - 336; qb = 23 - j / 6; h = j % 6; }
    r.P0 = qb * 256; r.h = h; const int nta = 4 * (qb + 1);
    if (part < 0) { r.t0 = 0; r.nt = nta; r.pidx = -1; } else { r.t0 = part * (nta / 2); r.nt = nta / 2; r.pidx = ((qb - ATT_QSPLIT) * 6 + h) * 2 + part; }
    return r; }
__device__ __forceinline__ int att_item(int k, int G, int c) { return (k & 1) ? (k + 1) * G - 1 - c : k * G + c; }
__device__ __forceinline__ int att_head_item(int h, int j) {
    if (j < 16) return 6 * j + h;
    if (j < 56) { const int jj = j - 16, p = jj / 5, q5 = jj % 5; const int q = q5 == 0 ? h : q5 == 1 ? 6 + h : q5 == 2 ? 12 + h : q5 == 3 ? 18 + h : 24 + h; return 96 + 30 * p + q; }
    return 336 + 6 * (j - 56) + h;
}
__device__ __forceinline__ int att_xcd_item(int x, int n) { const int g = 3 * x + n % 3, h = g >> 2, j = (g & 3) + 4 * (n / 3); return att_head_item(h, j); }
__device__ __forceinline__ void p_attn(Frame& F0, int b) {
    Frame F = F0; GAS unsigned char* wsg_ = (GAS unsigned char*)F.ws; F.tid = F.wave * 64 + lane_id(); asm volatile("" : "+v"(F.tid), "+s"(wsg_), "+s"(F.vcu), "+s"(F.G)); F.lane = F.tid & 63;
    att::gp_t ws = (att::gp_t)wsg_;
    att::lp_t lds = (att::lp_t)F.lds;
    { LAS float* bT = (LAS float*)(lds + att::BIAS_OFF);
        for (int i = F.tid; i < 6 * 129; i += NTHR) { const int h = i / 129, d = i % 129;
            const int bk = d < 16 ? d : 16 + (d >= 19) + (d >= 21) + (d >= 24) + (d >= 27) + (d >= 31) + (d >= 35) + (d >= 40) + (d >= 46) + (d >= 52) + (d >= 59) + (d >= 67) + (d >= 77) + (d >= 87) + (d >= 99) + (d >= 113);
            bT[h * 132 + d] = (F.rel[bk * 6 + h] - F.rel[31 * 6 + h]) * (1.0f / att::SCALE); } }
    LDS_WAIT(); __syncthreads();
    const bool xcd = F.G == 256; const int x = F.vcu >> 5, rk = F.vcu & 31;
    int k = 0, i = xcd ? att_xcd_item(x, rk) : att_item(0, F.G, F.vcu);
    if (i >= ATT_NIT) return;
    att::BlockRef cur = att_ref(i); att::Seam S;
    att::prime(cur, ws, lds, S, F.tid);
#pragma unroll 1
    for (;;) { int in;
        if (xcd) in = (k == 0 && 63 - rk < 60) ? att_xcd_item(x, 63 - rk) : ATT_NIT; else in = att_item(k + 1, F.G, F.vcu);
        const bool last = in >= ATT_NIT;
        const att::BlockRef nxt = last ? cur : att_ref(in);
        att::block(cur, nxt, ws, lds, S, b, F.tid);
        if (last) break;
        cur = nxt; ++k; }
}
__device__ __forceinline__ void p_attn_combine(Frame& F0) {
    Frame F = F0; { GAS unsigned char* wsg_ = (GAS unsigned char*)F.ws; F.tid = F.wave * 64 + lane_id(); asm volatile("" : "+v"(F.tid), "+s"(wsg_), "+s"(F.vcu), "+s"(F.G)); F.lane = F.tid & 63; F.ws = (unsigned char*)wsg_; }
    typedef float f2_t __attribute__((ext_vector_type(2)));
    const float* AP = (const float*)(F.ws + WS_APART); const f2_t* ML = (const f2_t*)(F.ws + WS_AML); bf16* OA = (bf16*)(F.ws + WS_OBR) + (size_t)HROWS * 768;
    constexpr float C2 = 1.4426950408889634f * att::SCALE;
    const int total = 96 * 256 * 16;
#pragma unroll 1
    for (int i = F.vcu * NTHR + F.tid; i < total; i += F.G * NTHR) { const int c8 = (i & 15) * 8, row = (i >> 4) & 255, blk = i >> 12;
        const f2_t a = ML[(size_t)(2 * blk) * 256 + row], bq = ML[(size_t)(2 * blk + 1) * 256 + row];
        const float m = fmaxf(a.x, bq.x), f0 = __builtin_amdgcn_exp2f((a.x - m) * C2), f1 = __builtin_amdgcn_exp2f((bq.x - m) * C2), inv = 1.0f / (a.y * f0 + bq.y * f1);
        const f32x4* p0 = (const f32x4*)(AP + ((size_t)(2 * blk) * 256 + row) * 128 + c8); const f32x4* p1 = (const f32x4*)(AP + ((size_t)(2 * blk + 1) * 256 + row) * 128 + c8);
        const f32x4 x0 = (p0[0] * f0 + p1[0] * f1) * inv, x1 = (p0[1] * f0 + p1[1] * f1) * inv;
        const int qb = ATT_QSPLIT + blk / 6, h = blk % 6;
        *(v4u*)(OA + (size_t)(qb * 256 + row) * 768 + h * 128 + c8) = pack8bf(x0, x1); }
}

constexpr int PT128 = 136, PT64 = 72;
#define MFMA16(a, b, c) __builtin_amdgcn_mfma_f32_16x16x32_bf16((a), (b), (c), 0, 0, 0)
__device__ __forceinline__ bf16x8 ldsfrag(const LAS unsigned short* base, int row, int pitch, int k) { return *(const LAS bf16x8*)(base + row * pitch + k); }
__device__ __forceinline__ float log2_gamma(int h) {
    const float x = __builtin_amdgcn_exp2f(-5.0f - (float)h);
    return -x * (1.0f + x * (0.5f + x * (0.33333334f + x * (0.25f + x * (0.2f + x * 0.16666667f))))) * 1.4426950408889634f;
}
__device__ __forceinline__ void unpack8(const v4u w, float (&f)[8]) { f[0] = bflo(w.x); f[1] = bfhi(w.x); f[2] = bflo(w.y); f[3] = bfhi(w.y); f[4] = bflo(w.z); f[5] = bfhi(w.z); f[6] = bflo(w.w); f[7] = bfhi(w.w); }
__device__ __forceinline__ v4u pack8f(const float (&f)[8]) { v4u w; w.x = pk2(f[0], f[1]); w.y = pk2(f[2], f[3]); w.z = pk2(f[4], f[5]); w.w = pk2(f[6], f[7]); return w; }

__device__ __forceinline__ void mix_sg_item(const Frame& F, const float* sgn, const float* sgw, const float* sgb, int n, int g) {
    LAS unsigned short* Wm = (LAS unsigned short*)(F.lds);
    LAS unsigned short* vnT = (LAS unsigned short*)(F.lds + 34816);
    LAS unsigned short* strip = (LAS unsigned short*)(F.lds + 69632) + F.wave * (16 * PT128);
    LAS float* rs = (LAS float*)(F.lds + 104448);
    const bf16* VS = (const bf16*)(F.ws + WS_VS); const bf16* US = (const bf16*)(F.ws + WS_US); bf16* OS = (bf16*)(F.ws + WS_OBR) + (size_t)2 * HROWS * 768;
    int lane_ = lane_id();
    const int r0 = n * 128, lane = lane_, w = F.wave, tid = w * 64 + lane, fr = lane & 15, fq = lane >> 4;
#pragma unroll 4
    for (int i = 0; i < 16; ++i) { const int t = w * 16 + i; const v4u x = *(const v4u*)(VS + (size_t)(r0 + t) * 512 + lane * 8); float f[8]; unpack8(x, f); float ss = 0.f;
#pragma unroll
        for (int j = 0; j < 8; ++j) ss += f[j] * f[j];
        ss = wave_sum(ss); if (lane == 0) rs[t] = 1.0f / sqrtf(ss * (1.0f / 512.0f) + EPS); }
    { const int t = tid >> 2, s0 = (tid & 3) * 32; const float* wr = sgw + ((size_t)g * 128 + t) * 128 + s0;
#pragma unroll
        for (int q = 0; q < 4; ++q) { const f32x4 a = *(const f32x4*)(wr + 8 * q), b = *(const f32x4*)(wr + 8 * q + 4); float f[8] = {a[0], a[1], a[2], a[3], b[0], b[1], b[2], b[3]};
#pragma unroll
            for (int j = 0; j < 8; ++j) f[j] = (s0 + 8 * q + j <= t) ? f[j] : 0.f;
            *(LAS v4u*)(Wm + t * PT128 + s0 + 8 * q) = pack8f(f); } }
    LDS_WAIT(); __syncthreads();
    { const int s = tid >> 2, d0 = (tid & 3) * 32; const float r = rs[s];
#pragma unroll
        for (int q = 0; q < 4; ++q) { const v4u x = *(const v4u*)(VS + (size_t)(r0 + s) * 512 + g * 128 + d0 + 8 * q); float f[8]; unpack8(x, f);
            const f32x4 ga = *(const f32x4*)(sgn + g * 128 + d0 + 8 * q), gb = *(const f32x4*)(sgn + g * 128 + d0 + 8 * q + 4); const float gg[8] = {ga[0], ga[1], ga[2], ga[3], gb[0], gb[1], gb[2], gb[3]};
#pragma unroll
            for (int j = 0; j < 8; ++j) vnT[(d0 + 8 * q + j) * PT128 + s] = (unsigned short)f2bf(f[j] * r * gg[j]); } }
    LDS_WAIT(); __syncthreads();
    f32x4 acc[8];
#pragma unroll
    for (int cb = 0; cb < 8; ++cb) acc[cb] = zero4();
    const int nks = (16 * w + 15) / 32 + 1;
#pragma unroll 1
    for (int ks = 0; ks < nks; ++ks) { const bf16x8 a = ldsfrag(Wm, 16 * w + fr, PT128, 32 * ks + 8 * fq);
#pragma unroll
        for (int cb = 0; cb < 8; ++cb) acc[cb] = MFMA16(a, ldsfrag(vnT, 16 * cb + fr, PT128, 32 * ks + 8 * fq), acc[cb]); }
#pragma unroll
    for (int reg = 0; reg < 4; ++reg) { const int tl = 4 * fq + reg; const float bias = sgb[g * 128 + 16 * w + tl];
#pragma unroll
        for (int cb = 0; cb < 8; ++cb) strip[tl * PT128 + 16 * cb + fr] = (unsigned short)f2bf(acc[cb][reg] + bias); }
    LDS_WAIT(); asm volatile("" ::: "memory");
#pragma unroll
    for (int i = 0; i < 4; ++i) { const int c = lane + 64 * i, row = c >> 4, col = (c & 15) * 8; const size_t r = (size_t)(r0 + 16 * w + row);
        const v4u m = *(const LAS v4u*)(strip + row * PT128 + col); const v4u u = *(const v4u*)(US + r * 512 + g * 128 + col); float fm[8], fu[8]; unpack8(m, fm); unpack8(u, fu);
#pragma unroll
        for (int j = 0; j < 8; ++j) fm[j] *= fu[j];
        *(v4u*)(OS + r * 768 + g * 128 + col) = pack8f(fm); }
    { const int i0 = tid * 2;
#pragma unroll
        for (int i = i0; i < i0 + 2; ++i) { const int row = i >> 3, c8 = (i & 7) * 8; *(v4u*)(OS + (size_t)(r0 + row) * 768 + 512 + g * 64 + c8) = zero4u(); } }
    __syncthreads();
}
__device__ __forceinline__ void mix_r1_item(const Frame& F, int h, int n) {
    LAS unsigned short* VT = (LAS unsigned short*)(F.lds);
    LAS unsigned short* KdT = (LAS unsigned short*)(F.lds + 34816);
    const bf16* QKR = (const bf16*)(F.ws + WS_QKR); const bf16* VR = (const bf16*)(F.ws + WS_VR); float* KV = (float*)(F.ws + WS_KVST) + ((size_t)h * 128 + n) * 8192;
    int lane_ = lane_id();
    const int r0 = n * 128, lane = lane_, w = F.wave, tid = w * 64 + lane, fr = lane & 15, fq = lane >> 4; const float lg2 = log2_gamma(h);
    { const int s = tid >> 2, v0 = (tid & 3) * 32;
#pragma unroll
        for (int q = 0; q < 4; ++q) { const v4u x = *(const v4u*)(VR + (size_t)(r0 + s) * 768 + h * 128 + v0 + 8 * q);
            const unsigned xs[4] = {x.x, x.y, x.z, x.w};
#pragma unroll
            for (int j = 0; j < 4; ++j) { VT[(v0 + 8 * q + 2 * j) * PT128 + s] = (unsigned short)(xs[j] & 0xffffu); VT[(v0 + 8 * q + 2 * j + 1) * PT128 + s] = (unsigned short)(xs[j] >> 16); } } }
    { const int s = tid >> 2, d0 = (tid & 3) * 16; const float dec = __builtin_amdgcn_exp2f((float)(127 - s) * lg2);
#pragma unroll
        for (int q = 0; q < 2; ++q) { const v4u x = *(const v4u*)(QKR + (size_t)(r0 + s) * 768 + 384 + h * 64 + d0 + 8 * q); float f[8]; unpack8(x, f);
#pragma unroll
            for (int j = 0; j < 8; ++j) KdT[(d0 + 8 * q + j) * PT128 + s] = (unsigned short)f2bf(f[j] * dec); } }
    LDS_WAIT(); __syncthreads();
    f32x4 acc[4];
#pragma unroll
    for (int cb = 0; cb < 4; ++cb) acc[cb] = zero4();
#pragma unroll
    for (int ks = 0; ks < 4; ++ks) { const bf16x8 a = ldsfrag(VT, 16 * w + fr, PT128, 32 * ks + 8 * fq);
#pragma unroll
        for (int cb = 0; cb < 4; ++cb) acc[cb] = MFMA16(a, ldsfrag(KdT, 16 * cb + fr, PT128, 32 * ks + 8 * fq), acc[cb]); }
#pragma unroll
    for (int cb = 0; cb < 4; ++cb)
#pragma unroll
        for (int reg = 0; reg < 4; ++reg) KV[(16 * w + 4 * fq + reg) * 64 + 16 * cb + fr] = acc[cb][reg];
    __syncthreads();
}
__device__ __forceinline__ void mix_r2(const Frame& F) {
    float* KVb = (float*)(F.ws + WS_KVST); LAS float* car = (LAS float*)(F.lds);
    const int tid = F.wave * 64 + lane_id(), el = tid & 63, seg = tid >> 6;
#pragma unroll 1
    for (int blk = F.vcu; blk < RH * 8192 / 64; blk += F.G) { const int e0 = blk * 64 + el, h = e0 >> 13, e = e0 & 8191;
        const float cd = __builtin_amdgcn_exp2f(128.0f * log2_gamma(h));
        float* p = KVb + (size_t)h * 128 * 8192 + (size_t)(seg * 16) * 8192 + e; float kv[16];
#pragma unroll
        for (int n = 0; n < 16; ++n) kv[n] = p[(size_t)n * 8192];
        float st = 0.f;
#pragma unroll
        for (int n = 0; n < 16; ++n) { const float t = kv[n]; kv[n] = st; st = st * cd + t; }
        car[seg * 64 + el] = st; LDS_WAIT(); __syncthreads();
        float cin = 0.f, cd16 = cd; cd16 *= cd16; cd16 *= cd16; cd16 *= cd16; cd16 *= cd16;
#pragma unroll 1
        for (int s2 = 0; s2 < seg; ++s2) cin = cin * cd16 + car[s2 * 64 + el];
        float f = 1.f;
#pragma unroll
        for (int n = 0; n < 16; ++n) { p[(size_t)n * 8192] = kv[n] + cin * f; f *= cd; }
        __syncthreads(); }
}
__device__ __forceinline__ void mix_r3_item(const Frame& F, const float* retn, int h, int n) {
    LAS unsigned short* Qs = (LAS unsigned short*)(F.lds);
    LAS unsigned short* Ks = (LAS unsigned short*)(F.lds + 18432);
    LAS unsigned short* VT = (LAS unsigned short*)(F.lds + 36864);
    LAS unsigned short* PT = (LAS unsigned short*)(F.lds + 71680);
    LAS unsigned short* strip = (LAS unsigned short*)(F.lds + 90112) + F.wave * (16 * PT128);
    const bf16* QKR = (const bf16*)(F.ws + WS_QKR); const bf16* VR = (const bf16*)(F.ws + WS_VR); const bf16* GR = (const bf16*)(F.ws + WS_GR); bf16* OR = (bf16*)(F.ws + WS_OBR);
    const float* KV = (const float*)(F.ws + WS_KVST) + ((size_t)h * 128 + n) * 8192;
    int lane_ = lane_id();
    const int r0 = n * 128, lane = lane_, w = F.wave, tid = w * 64 + lane, fr = lane & 15, fq = lane >> 4; const float lg2 = log2_gamma(h);
    { const int s = tid >> 2, d0 = (tid & 3) * 16; const bf16* src = QKR + (size_t)(r0 + s) * 768 + h * 64 + d0;
#pragma unroll
        for (int q = 0; q < 2; ++q) { *(LAS v4u*)(Qs + s * PT64 + d0 + 8 * q) = *(const v4u*)(src + 8 * q); *(LAS v4u*)(Ks + s * PT64 + d0 + 8 * q) = *(const v4u*)(src + 384 + 8 * q); } }
    { const int s = tid >> 2, v0 = (tid & 3) * 32;
#pragma unroll
        for (int q = 0; q < 4; ++q) { const v4u x = *(const v4u*)(VR + (size_t)(r0 + s) * 768 + h * 128 + v0 + 8 * q);
            const unsigned xs[4] = {x.x, x.y, x.z, x.w};
#pragma unroll
            for (int j = 0; j < 4; ++j) { VT[(v0 + 8 * q + 2 * j) * PT128 + s] = (unsigned short)(xs[j] & 0xffffu); VT[(v0 + 8 * q + 2 * j + 1) * PT128 + s] = (unsigned short)(xs[j] >> 16); } } }
    { const int v = tid >> 2, d0 = (tid & 3) * 16; const float* src = KV + v * 64 + d0;
#pragma unroll
        for (int q = 0; q < 2; ++q) *(LAS v4u*)(PT + v * PT64 + d0 + 8 * q) = pack8bf(*(const f32x4*)(src + 8 * q), *(const f32x4*)(src + 8 * q + 4)); }
    LDS_WAIT(); __syncthreads();
    const bf16x8 qa0 = ldsfrag(Qs, 16 * w + fr, PT64, 8 * fq), qa1 = ldsfrag(Qs, 16 * w + fr, PT64, 32 + 8 * fq);
    f32x4 acc[8];
#pragma unroll
    for (int cb = 0; cb < 8; ++cb) { acc[cb] = zero4();
        acc[cb] = MFMA16(qa0, ldsfrag(PT, 16 * cb + fr, PT64, 8 * fq), acc[cb]); acc[cb] = MFMA16(qa1, ldsfrag(PT, 16 * cb + fr, PT64, 32 + 8 * fq), acc[cb]); }
#pragma unroll
    for (int reg = 0; reg < 4; ++reg) { const float f = 0.125f * __builtin_amdgcn_exp2f((float)(16 * w + 4 * fq + reg + 1) * lg2);
#pragma unroll
        for (int cb = 0; cb < 8; ++cb) acc[cb][reg] *= f; }
    const int nb = (w | 1) + 1;
#pragma unroll 1
    for (int cb = 0; cb < nb; ++cb) { f32x4 sa = zero4();
        sa = MFMA16(qa0, ldsfrag(Ks, 16 * cb + fr, PT64, 8 * fq), sa); sa = MFMA16(qa1, ldsfrag(Ks, 16 * cb + fr, PT64, 32 + 8 * fq), sa);
        const int s = 16 * cb + fr;
#pragma unroll
        for (int reg = 0; reg < 4; ++reg) { const int t = 16 * w + 4 * fq + reg; const float p = (s <= t) ? sa[reg] * 0.125f * __builtin_amdgcn_exp2f((float)(t - s) * lg2) : 0.f;
            strip[(4 * fq + reg) * PT128 + s] = (unsigned short)f2bf(p); } }
    LDS_WAIT(); asm volatile("" ::: "memory");
    const int nks = (w >> 1) + 1;
#pragma unroll 1
    for (int ks = 0; ks < nks; ++ks) { const bf16x8 a = ldsfrag(strip, fr, PT128, 32 * ks + 8 * fq);
#pragma unroll
        for (int cb = 0; cb < 8; ++cb) acc[cb] = MFMA16(a, ldsfrag(VT, 16 * cb + fr, PT128, 32 * ks + 8 * fq), acc[cb]); }
    LDS_WAIT(); asm volatile("" ::: "memory");
#pragma unroll
    for (int reg = 0; reg < 4; ++reg) { float sum = 0.f;
#pragma unroll
        for (int cb = 0; cb < 8; ++cb) sum += acc[cb][reg];
        sum += __shfl_xor(sum, 1); sum += __shfl_xor(sum, 2); sum += __shfl_xor(sum, 4); sum += __shfl_xor(sum, 8);
        const float mu = sum * (1.0f / 128.0f); float q = 0.f;
#pragma unroll
        for (int cb = 0; cb < 8; ++cb) { const float d = acc[cb][reg] - mu; q += d * d; }
        q += __shfl_xor(q, 1); q += __shfl_xor(q, 2); q += __shfl_xor(q, 4); q += __shfl_xor(q, 8);
        const float rsd = 1.0f / sqrtf(q * (1.0f / 128.0f) + EPS);
#pragma unroll
        for (int cb = 0; cb < 8; ++cb) strip[(4 * fq + reg) * PT128 + 16 * cb + fr] = (unsigned short)f2bf((acc[cb][reg] - mu) * rsd); }
    LDS_WAIT(); asm volatile("" ::: "memory");
#pragma unroll
    for (int i = 0; i < 4; ++i) { const int c = lane + 64 * i, row = c >> 4, col = (c & 15) * 8; const size_t r = (size_t)(r0 + 16 * w + row);
        const v4u y = *(const LAS v4u*)(strip + row * PT128 + col); const v4u gg = *(const v4u*)(GR + r * 768 + h * 128 + col); float fy[8], fg[8]; unpack8(y, fy); unpack8(gg, fg);
        const f32x4 na = *(const f32x4*)(retn + h * 128 + col), nb2 = *(const f32x4*)(retn + h * 128 + col + 4); const float nn[8] = {na[0], na[1], na[2], na[3], nb2[0], nb2[1], nb2[2], nb2[3]};
#pragma unroll
        for (int j = 0; j < 8; ++j) fy[j] = fy[j] * nn[j] * fg[j];
        *(v4u*)(OR + r * 768 + h * 128 + col) = pack8f(fy); }
    __syncthreads();
}
__device__ __forceinline__ void p_mix2(Frame& F0, const Args& a, int l) {
    Frame F = F0; { GAS unsigned char* wsg_ = (GAS unsigned char*)F.ws; F.tid = F.wave * 64 + lane_id(); asm volatile("" : "+v"(F.tid), "+s"(wsg_), "+s"(F.vcu), "+s"(F.G)); F.lane = F.tid & 63; F.ws = (unsigned char*)wsg_; }
    const float* sgn = (const float*)a.in[10] + (size_t)l * 512; const float* sgw = (const float*)a.in[11] + (size_t)l * 4 * 128 * 128; const float* sgb = (const float*)a.in[12] + (size_t)l * 512;
#pragma unroll 1
    for (int rp = 0, nr = rep_count(PROBE_SGR1); rp < nr; ++rp) {
#pragma unroll 1
    for (int it = F.vcu; it < 512; it += F.G) mix_sg_item(F, sgn, sgw, sgb, it >> 2, it & 3);
#pragma unroll 1
    for (int it = F.vcu; it < 768; it += F.G) mix_r1_item(F, it % 6, it / 6);
    }
#pragma unroll 1
    for (int rp = 0, nr = rep_count(PROBE_IDX); rp < nr; ++rp)
#pragma unroll 1
    for (int pq = F.vcu; pq < 256; pq += F.G) {
#pragma unroll 1
        for (int hh = 0; hh < 2; ++hh) idx::item(F, hh ? 511 - pq : pq); }
}
__device__ __forceinline__ void p_mix3(Frame& F0) {
    Frame F = F0; { GAS unsigned char* wsg_ = (GAS unsigned char*)F.ws; F.tid = F.wave * 64 + lane_id(); asm volatile("" : "+v"(F.tid), "+s"(wsg_), "+s"(F.vcu), "+s"(F.G)); F.lane = F.tid & 63; F.ws = (unsigned char*)wsg_; }
    mix_r2(F);
}
__device__ __forceinline__ void p_mix4(Frame& F0, const Args& a, int l) {
    Frame F = F0; { GAS unsigned char* wsg_ = (GAS unsigned char*)F.ws; F.tid = F.wave * 64 + lane_id(); asm volatile("" : "+v"(F.tid), "+s"(wsg_), "+s"(F.vcu), "+s"(F.G)); F.lane = F.tid & 63; F.ws = (unsigned char*)wsg_; }
    const float* retn = (const float*)a.in[9] + (size_t)l * 768;
#pragma unroll 1
    for (int rp = 0, nr = rep_count(PROBE_R3); rp < nr; ++rp)
#pragma unroll 1
    for (int it = F.vcu; it < 768; it += F.G) mix_r3_item(F, retn, it % 6, it / 6);
}
#ifndef PROBE_GU
#define PROBE_GU 1
#endif
#ifndef PROBE_GU_SKIP
#define PROBE_GU_SKIP 0
#endif
#ifndef PROBE_BARS
#define PROBE_BARS 0
#endif
#ifndef PROBE_RS
#define PROBE_RS 0
#endif
#ifndef WGM_GU
#define WGM_GU 4
#endif
#ifndef WGM_DOWN
#define WGM_DOWN 4
#endif
#ifndef WGM_PROJ
#define WGM_PROJ 8
#endif
#ifndef WGM_OUT
#define WGM_OUT 4
#endif
#ifndef WGM_MERGE
#define WGM_MERGE 4
#endif
#ifndef OUT_SPLIT
#define OUT_SPLIT 1
#endif
#ifndef DOWN_SEAM
#define DOWN_SEAM 0
#endif
#ifndef DOWN_REV
#define DOWN_REV 0
#endif
#ifndef DOWN_SPLIT
#define DOWN_SPLIT 2
#endif
#ifndef FFN_PARTS
#define FFN_PARTS 2
#endif
constexpr int FROWS = MTOK / FFN_PARTS;
#ifndef PROBE_PROJ_SKIP
#define PROBE_PROJ_SKIP 0
#endif
#ifndef PROBE_DOWN_SKIP
#define PROBE_DOWN_SKIP 0
#endif
#ifndef PROBE_DOWN
#define PROBE_DOWN 1
#endif
#ifndef PROBE_PROJ
#define PROBE_PROJ 1
#endif
#ifndef PROBE_MIX2
#define PROBE_MIX2 1
#endif
#ifndef PROBE_MIX4
#define PROBE_MIX4 1
#endif
#ifndef PROBE_MERGE
#define PROBE_MERGE 1
#endif
#ifndef PROBE_CONV
#define PROBE_CONV 1
#endif
#define REP(K) _Pragma("unroll 1") for (int rep_ = 0, nrep_ = rep_count(K); rep_ < nrep_; ++rep_)
#ifndef EN_GU
#define EN_GU 1
#endif
#ifndef EN_DOWN
#define EN_DOWN 1
#endif
#ifndef EN_PROJ
#define EN_PROJ 1
#endif
#ifndef EN_MERGE
#define EN_MERGE 1
#endif
#ifndef EN_OUT
#define EN_OUT 1
#endif

#ifndef PG8_SP2
#define PG8_SP2 true
#endif
#ifndef PG8_ALIGN
#define PG8_ALIGN true
#endif
__global__ void __launch_bounds__(NTHR, 2) mega_fwd(Args args) {
    extern __shared__ __attribute__((aligned(16))) unsigned char lds[];
    Frame F;
    F.lds = (LAS unsigned char*)lds; F.MISC = (volatile LAS unsigned*)(F.lds + MISC_OFF);
    F.tid = threadIdx.x; F.lane = F.tid & 63; F.wave = __builtin_amdgcn_readfirstlane(F.tid >> 6);
    F.G = gridDim.x; { const int bx = blockIdx.x; F.vcu = (F.G % 8 == 0) ? (bx % 8) * (F.G / 8) + bx / 8 : bx; }
    F.ws = args.ws; F.ctl = (gu32*)(args.ws + WS_CTL);
    F.xin = (const float*)args.in[0]; F.pos = (const int*)args.in[1]; F.rel = (const float*)args.in[2]; F.X = args.out;
    for (int u = F.tid; u < (LDS_BYTES - LDSCTL_OFF) / 4; u += NTHR) ((LAS unsigned*)(F.lds + LDSCTL_OFF))[u] = 0u;
    __syncthreads();
    XcdBarrier bar; bar.bar = (unsigned*)(F.ctl + CW_BAR); bar.x = 0; bar.st = nullptr;
    if (!MK_PER_PHASE) bar = xcd_barrier_post((unsigned*)(F.ctl + CW_BAR), F.MISC + 8);
    const int lo = args.ph_lo, hi = args.ph_hi; int ph = 0;
#define IN() (lo <= ph && ph < hi)
#define SEAM() do { if (!MK_PER_PHASE && lo <= ph && ph + 1 < hi) xcd_barrier(bar, F.wave); ++ph; } while (0)
#define SITE_PTRS() GAS unsigned char* wsg_ = (GAS unsigned char*)args.ws; int sG_ = F.G, sB_ = (int)blockIdx.x; asm volatile("" : "+s"(wsg_), "+s"(sG_), "+s"(sB_)); unsigned char* ws = (unsigned char*)wsg_; float* const part = (float*)(ws + WS_PART); const float* const rstd = (const float*)(ws + WS_RSTD); bf16* const XB = (bf16*)(ws + WS_XB); (void)part; (void)rstd; (void)XB

    if (IN()) p_prologue(F);
    SEAM();
#pragma unroll 1
    for (int l = 0; l < DEPTH; ++l) {
        if (IN()) REP(PROBE_CONV) p_convert(F, args, l);
#pragma unroll 1
        for (int s = 0; s < 3; ++s) {
            if (IN()) p_rowstat(F);
            SEAM();
            if (s != 1) {
#pragma unroll 1
                for (int h = 0; h < FFN_PARTS; ++h) {
                    const size_t r0 = (size_t)h * FROWS;
                    if (IN()) { SITE_PTRS(); const bf16* Wgu = (const bf16*)(ws + (s ? WS_WGU2 : WS_WGU1)); pg8::Gemm g{XB + r0 * DM, Wgu, FROWS, 2 * DFF, DM}; pg8::StaticOrder S; S.init(FROWS, 2 * DFF, sG_, sB_, WGM_GU);
#if EN_GU
                        REP(PROBE_GU) { EpiSwiGLU E{(bf16*)(ws + WS_HID), rstd + r0, (PROBE_GU_SKIP && rep_ + 1 < nrep_) ? 1 : 0};
                        if (PROBE_GU_SKIP == 2 && rep_ + 1 < nrep_) g.kmul = 0; else g.kmul = 1;
                        pg8::gemm_phase<EpiSwiGLU, pg8::StaticOrder, PG8_ALIGN, PG8_SP2>(F.lds + RING_OFF, g, S, E, F.wave); }
#endif
                    }
                    SEAM();
#pragma unroll 1
                    for (int dp = 0; dp < DOWN_SPLIT; ++dp) {
                    const int dq = DOWN_REV ? DOWN_SPLIT - 1 - dp : dp;
                    const size_t rd = r0 + (size_t)dq * (FROWS / DOWN_SPLIT), rl = (size_t)dq * (FROWS / DOWN_SPLIT);
                    if (IN()) { SITE_PTRS(); const bf16* Wd = (const bf16*)(ws + (s ? WS_WD2 : WS_WD1)); pg8::Gemm g{(const bf16*)(ws + WS_HID) + rl * DFF, Wd, FROWS / DOWN_SPLIT, DM, DFF}; pg8::StaticOrder S; S.init(FROWS / DOWN_SPLIT, DM, sG_, sB_, WGM_DOWN);
                        const float* base = (l == 0 && s == 0) ? F.xin : (RESID_BF16 ? (const float*)nullptr : (const float*)F.X);
#if EN_DOWN
                        REP(PROBE_DOWN) { EpiResid E{base ? base + rd * DM : base, F.X + rd * DM, XB + rd * DM, part + rd * 32, rep_ + 1 == nrep_ ? 0.5f : 0.0f, (PROBE_DOWN_SKIP && rep_ + 1 < nrep_) ? 1 : 0};
                        pg8::gemm_phase<EpiResid, pg8::StaticOrder, PG8_ALIGN, PG8_SP2, HID_BLK != 0>(F.lds + RING_OFF, g, S, E, F.wave); }
#endif
                    }
                    if (dp + 1 == DOWN_SPLIT) SEAM(); else if (DOWN_SEAM) SEAM();
                    }
                }
            } else {
#pragma unroll 1
                for (int b = 0; b < BATCH; ++b) {
                    const size_t r0 = (size_t)b * HROWS;
                    if (IN()) { SITE_PTRS(); pg8::Gemm g{XB + r0 * DM, (const bf16*)(ws + WS_WIN), HROWS, NPROJ, DM}; pg8::StaticOrder S; S.init(HROWS, NPROJ, sG_, sB_, WGM_PROJ);
                        const float* rc = (const float*)(ws + WS_ROPE) + r0 * 32;
                        EpiProj E{rstd + r0, rc, rc + (size_t)MTOK * 32, (bf16*)(ws + WS_QKR), (bf16*)(ws + WS_VR), (bf16*)(ws + WS_GR), (bf16*)(ws + WS_QA), (bf16*)(ws + WS_KA), (bf16*)(ws + WS_VA),
                                  (bf16*)(ws + WS_US), (bf16*)(ws + WS_VS), (bf16*)(ws + WS_GATE), (unsigned short*)(ws + WS_QI), (unsigned short*)(ws + WS_KI), (float*)(ws + WS_WI)};
#if EN_PROJ
                        REP(PROBE_PROJ) { E.skip = (PROBE_PROJ_SKIP && rep_ + 1 < nrep_) ? 1 : 0;
                        pg8::gemm_phase<EpiProj, pg8::StaticOrder, PG8_ALIGN, PG8_SP2>(F.lds + RING_OFF, g, S, E, F.wave); }
#endif
                    }
                    SEAM();
                    if (IN()) REP(PROBE_MIX2) p_mix2(F, args, l);
                    SEAM();
                    if (IN()) p_mix3(F);
                    SEAM();
                    if (IN()) REP(PROBE_MIX4) { p_mix4(F, args, l); p_attn(F, b); }
                    SEAM();
                    if (IN()) p_attn_combine(F);
                    SEAM();
                    if (IN()) { SITE_PTRS(); pg8::Gemm g{(const bf16*)(ws + WS_OBR), (const bf16*)(ws + WS_WBR), 3 * HROWS, 3 * DM, 768}; MergeOrder S; S.init(sG_, sB_, WGM_MERGE);
                        EpiMerge E{(const bf16*)(ws + WS_GATE), (bf16*)(ws + WS_MRG)};
#if EN_MERGE
                        REP(PROBE_MERGE)
                        pg8::gemm_phase<EpiMerge, MergeOrder, PG8_ALIGN, PG8_SP2>(F.lds + RING_OFF, g, S, E, F.wave);
#endif
                    }
                    SEAM();
#pragma unroll 1
                    for (int op = 0; op < OUT_SPLIT; ++op) {
                    const size_t ro = r0 + (size_t)op * (HROWS / OUT_SPLIT), rl = (size_t)op * (HROWS / OUT_SPLIT);
                    if (IN()) { SITE_PTRS(); pg8::Gemm g{(const bf16*)(ws + WS_MRG) + rl * DM, (const bf16*)(ws + WS_WOUT), HROWS / OUT_SPLIT, DM, DM}; pg8::StaticOrder S; S.init(HROWS / OUT_SPLIT, DM, sG_, sB_, WGM_OUT);
                        EpiResid E{RESID_BF16 ? (const float*)nullptr : (const float*)(F.X + ro * DM), F.X + ro * DM, XB + ro * DM, part + ro * 32, 1.0f};
#if EN_OUT
                        pg8::gemm_phase<EpiResid, pg8::StaticOrder, PG8_ALIGN, PG8_SP2>(F.lds + RING_OFF, g, S, E, F.wave);
#endif
                    }
                    SEAM();
                    }
                }
            }
        }
    }
#if PROBE_BARS
    if (!MK_PER_PHASE) {
#pragma unroll 1
        for (int rp = 0, nr = rep_count(PROBE_BARS); rp < nr; ++rp) xcd_barrier(bar, F.wave); }
#endif
#if PROBE_RS
#pragma unroll 1
    for (int rp = 0, nr = rep_count(PROBE_RS); rp < nr; ++rp) if (lo == 0) { p_rowstat(F); xcd_barrier(bar, F.wave); }
#endif
    if (IN()) p_final(F, (const float*)args.in[21]);
#undef IN
#undef SEAM
}
constexpr int N_PHASES = 1 + DEPTH * (3 + 2 * (1 + (DOWN_SEAM ? DOWN_SPLIT : 1)) * FFN_PARTS + BATCH * (6 + OUT_SPLIT)) + 1;

extern "C" void kernel_launch(void* const* d_in, const int* in_sizes, int n_in, void* d_out, int out_size, void* d_ws, size_t ws_size, hipStream_t stream) {
    static int grid = 0;
    if (grid == 0) {
        if (n_in != 22 || in_sizes[0] != MTOK * DM || out_size != MTOK * DM || ws_size < WS_END) { fprintf(stderr, "kernel_launch: unexpected shapes (n_in %d, in0 %d, out %d, ws %zu)\n", n_in, n_in > 0 ? in_sizes[0] : -1, out_size, ws_size); grid = -1; return; }
        int dev = 0, cus = 0, per_cu = 0;
        if (hipGetDevice(&dev) != hipSuccess || hipDeviceGetAttribute(&cus, hipDeviceAttributeMultiprocessorCount, dev) != hipSuccess) { grid = -1; return; }
        if (hipFuncSetAttribute((const void*)mega_fwd, hipFuncAttributeMaxDynamicSharedMemorySize, LDS_BYTES) != hipSuccess) { fprintf(stderr, "kernel_launch: hipFuncSetAttribute failed\n"); grid = -1; return; }
        if (hipOccupancyMaxActiveBlocksPerMultiprocessor(&per_cu, (const void*)mega_fwd, NTHR, LDS_BYTES) != hipSuccess || per_cu < 1) fprintf(stderr, "kernel_launch: occupancy query says %d\n", per_cu);
        (void)hipGetLastError();
        grid = cus;
    }
    if (grid < 0) return;
    if (hipMemsetAsync((char*)d_ws + WS_CTL, 0, CTL_ZERO_BYTES, stream) != hipSuccess) return;
    Args a{};
    for (int i = 0; i < 22; ++i) a.in[i] = d_in[i];
    a.out = (float*)d_out; a.ws = (unsigned char*)d_ws;
#if MK_PER_PHASE
    for (int p = 0; p < N_PHASES; ++p) { a.ph_lo = p; a.ph_hi = p + 1; hipLaunchKernelGGL(mega_fwd, dim3(grid), dim3(NTHR), LDS_BYTES, stream, a); }
#else
    a.ph_lo = 0; a.ph_hi = N_PHASES; hipLaunchKernelGGL(mega_fwd, dim3(grid), dim3(NTHR), LDS_BYTES, stream, a);
#endif
}
```

```cpp
#define RESID_GROUP 4
#include <hip/hip_runtime.h>
#include <cstdio>
#include <cstdint>

#ifndef PG8_WGM
#define PG8_WGM 8
#endif
#ifndef MK_PER_PHASE
#define MK_PER_PHASE 0
#endif

namespace pg8 {
#define PG8_LAS __attribute__((address_space(3)))
typedef unsigned short bf16_t;
typedef short bf16x8 __attribute__((ext_vector_type(8)));
typedef float f32x4 __attribute__((ext_vector_type(4)));
typedef unsigned u32x4 __attribute__((ext_vector_type(4)));
constexpr int BM = 256, BK = 64, HALF = 128, HTB = HALF * BK * 2  , STAGE_BYTES = 8 * HTB, NXCD = 8, WGM = PG8_WGM;

__host__ __device__ __forceinline__ int lds_byte(int r, int c) { const int st = (r >> 4) * 2 + (c >> 5), rr = r & 15, cc = c & 31, ob = rr * 64 + cc * 2; return st * 1024 + (ob ^ (((ob >> 9) & 1) << 5)); }
__host__ __device__ __forceinline__ void stage_rc(int b, int& R, int& C) { const int st = b / 1024, sb = b % 1024, swz = sb ^ (((sb >> 9) & 1) << 5); R = (st >> 1) * 16 + swz / 64; C = (st & 1) * 32 + (swz % 64) / 2; }
__host__ __device__ __forceinline__ int perm32(int rho) { const int n = rho >> 4, i = rho & 15; return 8 * (i >> 2) + 4 * n + (i & 3); }

struct Unit { int pm, pn; };
struct Gemm { const bf16_t* A; const bf16_t* Bt; int M, N, K; int kmul = 1; };

struct StaticOrder {
    int nM, nN, nwg, G, c, wgm;
    __host__ __device__ void init(int M, int N, int G_, int c_, int wgm_ = WGM) { nM = M / BM; nN = N / BM; nwg = nM * nN; G = G_; c = c_; wgm = wgm_; }
    __host__ __device__ bool next(int i, Unit& u) const {
        const long L = (long)i * G + c; if (L >= nwg) return false;
        int wgid = (int)L; { const int q = nwg / NXCD, r = nwg % NXCD, xcd = wgid % NXCD, off = wgid / NXCD; wgid = (xcd < r ? xcd * (q + 1) : r * (q + 1) + (xcd - r) * q) + off; }
        const int nig = wgm * nN, gid = wgid / nig, fm = gid * wgm, gsz = (nM - fm) < wgm ? (nM - fm) : wgm;
        u.pm = fm + ((wgid % nig) % gsz); u.pn = (wgid % nig) / gsz; return true;
    }
    __device__ __forceinline__ void a_ready(const Unit&) const {}
    __device__ __forceinline__ void done(const Unit&) const {}
    __device__ __forceinline__ int ktiles(const Unit&, int full) const { return full; }
};

template <class Epi, class Sched, bool ALIGN_EPI = false, bool SP2 = false, bool BLK = false>
__device__ __forceinline__ void gemm_phase(PG8_LAS unsigned char* lds, const Gemm g, const Sched& S, const Epi& E, const int wave_sgpr) {
    unsigned m_ = ~0u; asm volatile("" : "+s"(m_)); int tid_ = wave_sgpr * 64 + (int)__builtin_amdgcn_mbcnt_hi(m_, __builtin_amdgcn_mbcnt_lo(m_, 0u)); asm volatile("" : "+v"(tid_));
    const int tid = tid_, wid = __builtin_amdgcn_readfirstlane(tid >> 6), lane = tid & 63, wr = wid >> 2, wc = wid & 3, fr = lane & 15, fq = lane >> 4;
    const int K = g.K; int nt = K / BK;
    unsigned voffA[2], voffB[2];
#pragma unroll
    for (int i = 0; i < 2; ++i) { int R, C; stage_rc(tid * 16 + i * 8192, R, C); const int p32 = perm32(R & 31);
        const int Rb = Epi::PMODE == 2 ? ((R >> 5) * 64 + (p32 >> 3) * 16 + (p32 & 7)) : (Epi::PMODE == 1 ? ((R & ~31) + p32) : R);
        voffA[i] = (unsigned)(R * (BLK ? BK : K) + C) * 2u; voffB[i] = (unsigned)(Rb * (BLK ? BK : K) + C) * 2u; }
    const size_t kstep = (BLK ? (size_t)(BM * BK * 2) : (size_t)(BK * 2)) * (size_t)g.kmul;
    const size_t hstep = BLK ? (size_t)(HALF * BK * 2) : (size_t)HALF * K * 2;
    const size_t hstepB = Epi::PMODE == 2 ? (size_t)8 * K * 2 : hstep;
    const size_t tstep = (size_t)BM * K * 2;
    const unsigned ldsw = (unsigned)wid * 1024u;
    const int aoff = lds_byte(wr * 64 + fr, fq * 8), boff = lds_byte(wc * 32 + fr, fq * 8);
#define PG8_SA(b, h) (((b) * 2 + (h)) * HTB)
#define PG8_SB(b, h) ((4 + (b) * 2 + (h)) * HTB)
#define PG8_STAGE(bufoff, gbase, voff) do { _Pragma("unroll") for (int _i = 0; _i < 2; ++_i) \
        __builtin_amdgcn_global_load_lds((const unsigned*)((const char*)(gbase) + (voff)[_i]), (PG8_LAS unsigned*)(lds + (bufoff) + ldsw + _i * 8192), 16, 0, 0); } while (0)
#define PG8_LDA(dst, b, h) do { _Pragma("unroll") for (int m = 0; m < 4; ++m) _Pragma("unroll") for (int k = 0; k < 2; ++k) dst[m][k] = *(const PG8_LAS bf16x8*)(lds + PG8_SA(b, h) + aoff + m * 2048 + k * 1024); } while (0)
#define PG8_LDB(dst, b, h) do { _Pragma("unroll") for (int n = 0; n < 2; ++n) _Pragma("unroll") for (int k = 0; k < 2; ++k) dst[n][k] = *(const PG8_LAS bf16x8*)(lds + PG8_SB(b, h) + boff + n * 2048 + k * 1024); } while (0)
#define PG8_MMA(ai, bj, At, Bt) do { __builtin_amdgcn_s_setprio(1); _Pragma("unroll") for (int m = 0; m < 4; ++m) _Pragma("unroll") for (int n = 0; n < 2; ++n) _Pragma("unroll") for (int k = 0; k < 2; ++k) \
        acc[ai][bj][m][n] = __builtin_amdgcn_mfma_f32_16x16x32_bf16(Bt[n][k], At[m][k], acc[ai][bj][m][n], 0, 0, 0); __builtin_amdgcn_s_setprio(0); } while (0)
#define PG8_WAIT_V(n) asm volatile("s_waitcnt vmcnt(" #n ")" ::: "memory")
#define PG8_WAIT_L(n) asm volatile("s_waitcnt lgkmcnt(" #n ")" ::: "memory")
#define PG8_BAR __builtin_amdgcn_s_barrier()
#define PG8_SCHED __builtin_amdgcn_sched_barrier(0)
    Unit cur, nxt; int ui = 0;
    if (!S.next(0, cur)) return;
    nt = S.ktiles(cur, K / BK);
    f32x4 acc[2][2][4][2];
#pragma unroll
    for (int a = 0; a < 2; ++a)
#pragma unroll
        for (int b = 0; b < 2; ++b)
#pragma unroll
            for (int m = 0; m < 4; ++m)
#pragma unroll
                for (int n = 0; n < 2; ++n) { float zf_ = 0.f; asm volatile("" : "+v"(zf_)); acc[a][b][m][n] = (f32x4){zf_, zf_, zf_, zf_}; }
    bf16x8 At[4][2], B0[2][2], B1[2][2];
    const char* cA = (const char*)g.A + (size_t)cur.pm * tstep; const char* cB = (const char*)g.Bt + (size_t)cur.pn * tstep;
    S.a_ready(cur);
    if constexpr (SP2) {
        PG8_STAGE(PG8_SB(0, 0), cB, voffB); PG8_STAGE(PG8_SB(0, 1), cB + hstepB, voffB); PG8_STAGE(PG8_SA(0, 0), cA, voffA); PG8_STAGE(PG8_SA(0, 1), cA + hstep, voffA);
        if (wr == 1) PG8_BAR;
        PG8_WAIT_V(2); PG8_BAR;
        PG8_STAGE(PG8_SB(1, 0), cB + kstep, voffB); PG8_STAGE(PG8_SA(1, 0), cA + kstep, voffA); PG8_STAGE(PG8_SB(1, 1), cB + hstepB + kstep, voffB);
        PG8_WAIT_V(6); PG8_BAR;
    } else {
        PG8_STAGE(PG8_SB(0, 0), cB, voffB); PG8_STAGE(PG8_SA(0, 0), cA, voffA); PG8_STAGE(PG8_SB(0, 1), cB + hstepB, voffB); PG8_STAGE(PG8_SA(0, 1), cA + hstep, voffA);
        if (wr == 1) PG8_BAR;
        PG8_WAIT_V(4); PG8_BAR;
        PG8_STAGE(PG8_SB(1, 0), cB + kstep, voffB); PG8_STAGE(PG8_SA(1, 0), cA + kstep, voffA); PG8_STAGE(PG8_SB(1, 1), cB + hstepB + kstep, voffB);
        PG8_WAIT_V(6); PG8_BAR;
    }
    for (;;) {
        const bool has_next = S.next(ui + 1, nxt);
        const char* nA = has_next ? (const char*)g.A + (size_t)nxt.pm * tstep : cA; const char* nB = has_next ? (const char*)g.Bt + (size_t)nxt.pn * tstep : cB;
        for (int t = 0; t < nt; t += 2) {
            const bool last = (t == nt - 2);
            const char* a1 = cA + (size_t)(t + 1) * kstep;
            const char* a2 = last ? nA : cA + (size_t)(t + 2) * kstep; const char* b2 = last ? nB : cB + (size_t)(t + 2) * kstep;
            const char* a3 = a2 + kstep; const char* b3 = b2 + kstep;
            if (last && has_next) S.a_ready(nxt);
            if constexpr (SP2) {
            PG8_LDB(B0, 0, 0); PG8_LDB(B1, 0, 1); PG8_SCHED; PG8_LDA(At, 0, 0); PG8_STAGE(PG8_SA(1, 1), a1 + hstep, voffA);
            PG8_WAIT_V(8); PG8_WAIT_L(0); PG8_BAR; PG8_MMA(0, 0, At, B0); PG8_MMA(0, 1, At, B1); PG8_BAR; PG8_SCHED;
            PG8_LDA(At, 0, 1); PG8_STAGE(PG8_SB(0, 0), b2, voffB); PG8_STAGE(PG8_SB(0, 1), b2 + hstepB, voffB); PG8_STAGE(PG8_SA(0, 0), a2, voffA);
            PG8_WAIT_V(8); PG8_WAIT_L(0); PG8_BAR; PG8_MMA(1, 0, At, B0); PG8_MMA(1, 1, At, B1); PG8_BAR; PG8_SCHED;
            PG8_LDB(B0, 1, 0); PG8_LDB(B1, 1, 1); PG8_SCHED; PG8_LDA(At, 1, 0); PG8_STAGE(PG8_SA(0, 1), a2 + hstep, voffA);
            PG8_WAIT_V(8); PG8_WAIT_L(0); PG8_BAR; PG8_MMA(0, 0, At, B0); PG8_MMA(0, 1, At, B1); PG8_BAR; PG8_SCHED;
            PG8_LDA(At, 1, 1); PG8_STAGE(PG8_SB(1, 0), b3, voffB); PG8_STAGE(PG8_SB(1, 1), b3 + hstepB, voffB); PG8_STAGE(PG8_SA(1, 0), a3, voffA);
            PG8_WAIT_V(8); PG8_WAIT_L(0); PG8_BAR; PG8_MMA(1, 0, At, B0); PG8_MMA(1, 1, At, B1); PG8_BAR; PG8_SCHED;
            } else {
            PG8_LDB(B0, 0, 0); PG8_SCHED; PG8_LDA(At, 0, 0); PG8_STAGE(PG8_SA(1, 1), a1 + hstep, voffA);
            PG8_WAIT_L(8); PG8_BAR; PG8_WAIT_L(0); PG8_MMA(0, 0, At, B0); PG8_BAR; PG8_SCHED;
            PG8_LDB(B1, 0, 1); PG8_STAGE(PG8_SB(0, 0), b2, voffB);
            PG8_BAR; PG8_WAIT_L(0); PG8_MMA(0, 1, At, B1); PG8_BAR;
            PG8_LDA(At, 0, 1); PG8_STAGE(PG8_SA(0, 0), a2, voffA);
            PG8_BAR; PG8_WAIT_L(0); PG8_MMA(1, 0, At, B0); PG8_BAR; PG8_SCHED;
            PG8_STAGE(PG8_SB(0, 1), b2 + hstepB, voffB);
            PG8_WAIT_V(6); PG8_BAR; PG8_MMA(1, 1, At, B1); PG8_BAR;
            PG8_LDB(B0, 1, 0); PG8_SCHED; PG8_LDA(At, 1, 0); PG8_STAGE(PG8_SA(0, 1), a2 + hstep, voffA);
            PG8_WAIT_L(8); PG8_BAR; PG8_WAIT_L(0); PG8_MMA(0, 0, At, B0); PG8_BAR; PG8_SCHED;
            PG8_LDB(B1, 1, 1); PG8_STAGE(PG8_SB(1, 0), b3, voffB);
            PG8_BAR; PG8_WAIT_L(0); PG8_MMA(0, 1, At, B1); PG8_BAR;
            PG8_LDA(At, 1, 1); PG8_STAGE(PG8_SA(1, 0), a3, voffA);
            PG8_BAR; PG8_WAIT_L(0); PG8_MMA(1, 0, At, B0); PG8_BAR; PG8_SCHED;
            PG8_STAGE(PG8_SB(1, 1), b3 + hstepB, voffB);
            PG8_WAIT_V(6); PG8_BAR; PG8_MMA(1, 1, At, B1); PG8_BAR;
            }
        }
        if constexpr (ALIGN_EPI) { if (wr == 0) PG8_BAR; }
        if constexpr (!Epi::AFTER_DRAIN) { E(acc, cur, wr, wc, fr, fq); S.done(cur); }
        if (!has_next) break;
        bool keep_acc = false; if constexpr (Epi::CHAIN) keep_acc = E.keep(cur);
        if (!keep_acc) {
#pragma unroll
        for (int a = 0; a < 2; ++a)
#pragma unroll
            for (int b = 0; b < 2; ++b)
#pragma unroll
                for (int m = 0; m < 4; ++m)
#pragma unroll
                    for (int n = 0; n < 2; ++n) { float zf_ = 0.f; asm volatile("" : "+v"(zf_)); acc[a][b][m][n] = (f32x4){zf_, zf_, zf_, zf_}; }
        }
        cur = nxt; cA = nA; cB = nB; ++ui; nt = S.ktiles(cur, K / BK);
        if constexpr (ALIGN_EPI) { if (wr == 1) PG8_BAR; }
    }
    PG8_WAIT_V(0);
    if constexpr (!ALIGN_EPI) { if (wr == 0) PG8_BAR; }
    PG8_BAR;
    if constexpr (Epi::AFTER_DRAIN) { E.fused(acc, cur, wr, wc, fr, fq, lds, wid, lane); S.done(cur); }
#undef PG8_SA
#undef PG8_SB
#undef PG8_STAGE
#undef PG8_LDA
#undef PG8_LDB
#undef PG8_MMA
#undef PG8_WAIT_V
#undef PG8_WAIT_L
#undef PG8_BAR
#undef PG8_SCHED
}
}

constexpr int NWAVES = 8, NTHR = 512;
constexpr int BATCH = 2, SEQ = 16384, DM = 2048, DEPTH = 2, MTOK = BATCH * SEQ, DFF = 5632;
constexpr int RH = 6, RDK = 64, RDV = 128, RCH = 128;
constexpr int AH = 6, AD = 128, IH = 4, IDIM = 64, TOPK = 256;
constexpr int SGG = 4, SGD = 128, SGC = 128;
constexpr int NPROJ = 12288;
constexpr int DIN = 12100;
constexpr float EPS = 1e-6f;
constexpr int HROWS = 16384;

constexpr size_t MiB = 1u << 20;
constexpr size_t WS_CTL = 0, CTL_ZERO_BYTES = 1 * MiB;
constexpr size_t WS_PART = 1 * MiB;
constexpr size_t WS_RSTD = 5 * MiB;
constexpr size_t WS_KMAX = 5 * MiB + 512 * 1024;
constexpr size_t WS_POS = 5 * MiB + 768 * 1024;
constexpr size_t WS_ROPE = 6 * MiB;
constexpr size_t WS_WGU1 = 16 * MiB, WS_WD1 = 60 * MiB, WS_WGU2 = 82 * MiB, WS_WD2 = 126 * MiB, WS_WIN = 148 * MiB, WS_WBR = 196 * MiB, WS_WOUT = 205 * MiB;
constexpr size_t WS_XB = 216 * MiB;
constexpr size_t WS_ACT = 344 * MiB;
constexpr size_t WS_HID = WS_ACT;
constexpr size_t WS_QKR = WS_ACT;
constexpr size_t WS_VR = WS_QKR + 24 * MiB, WS_GR = WS_VR + 24 * MiB, WS_QA = WS_GR + 24 * MiB, WS_KA = WS_QA + 24 * MiB, WS_VA = WS_KA + 24 * MiB;
constexpr size_t WS_QI = WS_VA + 24 * MiB;
constexpr size_t WS_KI = WS_QI + 8 * MiB;
constexpr size_t WS_WI = WS_KI + 2 * MiB;
constexpr size_t WS_US = WS_WI + 1 * MiB, WS_VS = WS_US + 16 * MiB;
constexpr size_t WS_GATE = WS_VS + 16 * MiB;
constexpr size_t WS_OBR = WS_GATE + 192 * MiB;
constexpr size_t WS_MRG = WS_OBR + 72 * MiB;
constexpr size_t WS_MASK = WS_MRG + 64 * MiB;
constexpr size_t WS_KVST = WS_MASK + 32 * MiB;
constexpr size_t WS_APART = WS_KVST + 24 * MiB;
constexpr size_t WS_AML = WS_APART + 24 * MiB;
constexpr size_t WS_END = WS_AML + 1 * MiB;
static_assert(WS_END <= 1030 * MiB, "workspace map");
static_assert(WS_HID + (size_t)HROWS * DFF * 2 <= WS_END, "hid overlay");
constexpr int CW_TMO = 0, CW_BAR = 4096;

constexpr int RING_OFF = 0, RING_BYTES = 131072;
constexpr int LDSCTL_OFF = RING_BYTES + 31744 + 128, MISC_OFF = LDSCTL_OFF;
constexpr int LDS_BYTES = LDSCTL_OFF + 256;
static_assert(LDS_BYTES <= 160 * 1024, "LDS");

#define GAS __attribute__((address_space(1)))
#define LAS __attribute__((address_space(3)))
typedef unsigned short bf16;
typedef unsigned v4u __attribute__((ext_vector_type(4)));
typedef unsigned v2u __attribute__((ext_vector_type(2)));
typedef float f32x4 __attribute__((ext_vector_type(4)));
typedef float f32x16 __attribute__((ext_vector_type(16)));
typedef short bf16x8 __attribute__((ext_vector_type(8)));
typedef _Float16 f16x8 __attribute__((ext_vector_type(8)));
typedef _Float16 f16x2 __attribute__((ext_vector_type(2)));
typedef GAS unsigned gu32;
#define RLX_AGENT __ATOMIC_RELAXED, __HIP_MEMORY_SCOPE_AGENT
#define LDS_WAIT() asm volatile("s_waitcnt lgkmcnt(0)" ::: "memory")
#define VM_WAIT() asm volatile("s_waitcnt vmcnt(0)" ::: "memory")
__device__ __forceinline__ unsigned f2bf(float f) { unsigned u = __builtin_bit_cast(unsigned, f); return (u + 0x7fffu + ((u >> 16) & 1u)) >> 16; }
__device__ __forceinline__ unsigned pk2(float lo, float hi) { unsigned r; asm volatile("v_cvt_pk_bf16_f32 %0, %1, %2" : "=v"(r) : "v"(lo), "v"(hi)); return r; }
__device__ __forceinline__ float bf2f(unsigned short b) { return __builtin_bit_cast(float, ((unsigned)b) << 16); }
__device__ __forceinline__ float bflo(unsigned w) { return __builtin_bit_cast(float, w << 16); }
__device__ __forceinline__ float bfhi(unsigned w) { return __builtin_bit_cast(float, w & 0xffff0000u); }
__device__ __forceinline__ unsigned pkh2(float lo, float hi) { f16x2 v = {(_Float16)lo, (_Float16)hi}; return __builtin_bit_cast(unsigned, v); }
__device__ __forceinline__ float fsigmoid(float x) { return __builtin_amdgcn_rcpf(1.0f + __builtin_amdgcn_exp2f(-1.4426950408889634f * x)); }
__device__ __forceinline__ float fsilu(float x) { return x * fsigmoid(x); }
__device__ __forceinline__ float fgelu_tanh(float x) { const float u = 1.5957691216057308f * (x + 0.044715f * x * x * x); return x * fsigmoid(u); }
__device__ __forceinline__ float wave_sum(float v) {
#pragma unroll
    for (int o = 1; o < 64; o <<= 1) v += __shfl_xor(v, o);
    return v;
}
__device__ __forceinline__ f32x4 zero4() { float z = 0.f; asm volatile("" : "+v"(z)); return (f32x4){z, z, z, z}; }
__device__ __forceinline__ f32x16 zero16() { float z = 0.f; asm volatile("" : "+v"(z)); return (f32x16){z, z, z, z, z, z, z, z, z, z, z, z, z, z, z, z}; }
__device__ __forceinline__ v4u zero4u() { unsigned z = 0u; asm volatile("" : "+v"(z)); return (v4u){z, z, z, z}; }
__device__ __forceinline__ int lane_id() { unsigned m = ~0u; asm volatile("" : "+s"(m)); return (int)__builtin_amdgcn_mbcnt_hi(m, __builtin_amdgcn_mbcnt_lo(m, 0u)); }
#ifndef PROBE_SGR1
#define PROBE_SGR1 1
#endif
#ifndef PROBE_R3
#define PROBE_R3 1
#endif
#ifndef PROBE_IDX
#define PROBE_IDX 1
#endif
__device__ __forceinline__ int rep_count(int k) { asm volatile("" : "+s"(k)); return k; }
#ifndef PROBE_IDXD
#define PROBE_IDXD 0
#endif
#define XB_TMO      128
#define XB_XCNT(j)  (256  + 64 * (j))
#define XB_XSUB(j)  (1280 + 64 * (j))
#define XB_XGEN(j)  (2304 + 64 * (j))
#define XB_TOP      3328
#define XB_TOPGEN   3392
#define XCD_BAR_WORDS 3456
#define XB_SPIN_CAP (1u << 18)

__device__ __forceinline__ unsigned xb_ld(unsigned* p)              { return __hip_atomic_load(p, __ATOMIC_RELAXED, __HIP_MEMORY_SCOPE_AGENT); }
__device__ __forceinline__ unsigned xb_add(unsigned* p, unsigned v) { return __hip_atomic_fetch_add(p, v, __ATOMIC_RELAXED, __HIP_MEMORY_SCOPE_AGENT); }
__device__ __forceinline__ unsigned xb_xcc_id() { return (unsigned)__builtin_amdgcn_s_getreg((3 << 11) | 20) & 0xFu; }
#define XB_SPIN(cond, bar) do { unsigned _sp = 0; while (cond) { __builtin_amdgcn_s_sleep(1); \
    if ((++_sp & 255u) == 0u) { if (xb_ld(&(bar)[XB_TMO])) break; if (_sp > XB_SPIN_CAP) { atomicAdd(&(bar)[XB_TMO], 1u); break; } } } } while (0)

struct XcdBarrier {
    unsigned* bar; unsigned x;
    volatile LAS unsigned* st;
};

__device__ __forceinline__ XcdBarrier xcd_barrier_post(unsigned* bar, volatile LAS unsigned* st) {
    XcdBarrier b; b.bar = bar; b.x = xb_xcc_id(); b.st = st;
    if (threadIdx.x == 0) (void)xb_add(&bar[XB_XCNT(b.x)], 1u);
    return b;
}
__device__ __forceinline__ void xcd_barrier_complete(unsigned* bar, unsigned x, unsigned& nloc, unsigned& nx) {
    const unsigned G = gridDim.x * gridDim.y * gridDim.z;
    unsigned sum, cnt, mine, sp = 0u;
    for (;;) {
        sum = 0u; cnt = 0u; mine = 0u;
#pragma unroll
        for (unsigned j = 0; j < 16; ++j) { const unsigned c = xb_ld(&bar[XB_XCNT(j)]); sum += c; cnt += (c > 0u) ? 1u : 0u; mine = (j == x) ? c : mine; }
        if (sum == G) break;
        __builtin_amdgcn_s_sleep(1);
        if ((++sp & 255u) == 0u) { if (xb_ld(&bar[XB_TMO])) break; if (sp > XB_SPIN_CAP) { atomicAdd(&bar[XB_TMO], 1u); break; } }
    }
    nloc = mine > 0u ? mine : 1u; nx = cnt > 0u ? cnt : 1u;
}

__device__ __forceinline__ void xcd_barrier(const XcdBarrier& b0, const int wave_sgpr) {
    XcdBarrier b = b0; asm volatile("" : "+s"(b.bar), "+s"(b.x));
    asm volatile("s_waitcnt vmcnt(0)" ::: "memory");
    __syncthreads();
    if (wave_sgpr == 0 && lane_id() == 0) {
        unsigned* bar = b.bar;
        __builtin_amdgcn_s_waitcnt(0);
        unsigned nloc = b.st[0], nx = b.st[1];
        if (nloc == 0u) { xcd_barrier_complete(bar, b.x, nloc, nx); b.st[0] = nloc; b.st[1] = nx; }
        const unsigned old = xb_add(&bar[XB_XSUB(b.x)], 1u);
        const unsigned gen = old / nloc;
        if (old + 1u == (gen + 1u) * nloc) {
            __builtin_amdgcn_fence(__ATOMIC_RELEASE, "agent");
            asm volatile("s_waitcnt vmcnt(0)" ::: "memory");
            const unsigned og = xb_add(&bar[XB_TOP], 1u);
            const unsigned tg = og / nx;
            if (og + 1u == (tg + 1u) * nx) xb_add(&bar[XB_TOPGEN], 1u);
            else XB_SPIN(xb_ld(&bar[XB_TOPGEN]) == tg, bar);
            __builtin_amdgcn_fence(__ATOMIC_ACQUIRE, "agent");
            xb_add(&bar[XB_XGEN(b.x)], 1u);
            asm volatile("s_waitcnt vmcnt(0)" ::: "memory");
        } else {
            XB_SPIN(xb_ld(&bar[XB_XGEN(b.x)]) == gen, bar);
            __builtin_amdgcn_fence(__ATOMIC_ACQUIRE, "agent");
            asm volatile("s_waitcnt vmcnt(0)" ::: "memory");
        }
    }
    __syncthreads();
}

using pg8::Unit; using pg8::HALF; using pg8::BM;
#ifndef NT_PROJ
#define NT_PROJ 0
#endif
#ifndef HID_BLK
#define HID_BLK 0
#endif
#ifndef RESID_GROUP
#define RESID_GROUP 1
#endif
#ifndef NT_GATE
#define NT_GATE 1
#endif
#ifndef NT_X
#define NT_X 0
#endif
__device__ __forceinline__ v4u pack8bf(const f32x4 a, const f32x4 b) { v4u w; w.x = pk2(a[0], a[1]); w.y = pk2(a[2], a[3]); w.z = pk2(b[0], b[1]); w.w = pk2(b[2], b[3]); return w; }
__device__ __forceinline__ v4u pack8h(const f32x4 a, const f32x4 b) { v4u w; w.x = pkh2(a[0], a[1]); w.y = pkh2(a[2], a[3]); w.z = pkh2(b[0], b[1]); w.w = pkh2(b[2], b[3]); return w; }

struct EpiSwiGLU {
    static constexpr bool PERM = true, AFTER_DRAIN = false, CHAIN = false; static constexpr int PMODE = 1;
    bf16* H; const float* rstd; int skip;
    __device__ __forceinline__ void operator()(const f32x4 (&acc)[2][2][4][2], const Unit& u, int wr, int wc, int fr, int fq) const {
        if (skip) {
#pragma unroll
            for (int a = 0; a < 2; ++a)
#pragma unroll
                for (int b = 0; b < 2; ++b)
#pragma unroll
                    for (int m = 0; m < 4; ++m) asm volatile("" :: "v"(acc[a][b][m][0]), "v"(acc[a][b][m][1]));
            return; }
        const int row0 = u.pm * BM + wr * 64 + fr, col0 = u.pn * 128 + wc * 32 + 8 * fq;
        const f32x4 rsv0 = *(const f32x4*)(rstd + u.pm * BM + (wr * 16 + fr) * 8), rsv1 = *(const f32x4*)(rstd + u.pm * BM + (wr * 16 + fr) * 8 + 4);
#pragma unroll
        for (int ai = 0; ai < 2; ++ai)
#pragma unroll
            for (int m = 0; m < 4; ++m) { const int r = row0 + ai * HALF + m * 16; const float rs = (ai ? rsv1 : rsv0)[m];
                f32x4 h0, h1;
                typedef float f2 __attribute__((ext_vector_type(2)));
                const float rn = rs * -1.4426950408889634f, r2 = rs * rs;
#pragma unroll
                for (int n = 0; n < 2; ++n)
#pragma unroll
                    for (int j = 0; j < 2; ++j) { const f2 g = {acc[ai][0][m][n][2 * j], acc[ai][0][m][n][2 * j + 1]}, uu = {acc[ai][1][m][n][2 * j], acc[ai][1][m][n][2 * j + 1]};
                        const f2 t = g * rn; f2 d = {__builtin_amdgcn_exp2f(t.x), __builtin_amdgcn_exp2f(t.y)}; d = d + 1.0f;
                        const f2 rc = {__builtin_amdgcn_rcpf(d.x), __builtin_amdgcn_rcpf(d.y)}; const f2 o = (g * uu) * (rc * r2);
                        if (n == 0) { h0[2 * j] = o.x; h0[2 * j + 1] = o.y; } else { h1[2 * j] = o.x; h1[2 * j + 1] = o.y; } }
                if (HID_BLK) *(v4u*)(H + (((size_t)(r >> 8) * (DFF / 64) + (col0 >> 6)) * 256 + (r & 255)) * 64 + (col0 & 63)) = pack8bf(h0, h1);
                else *(v4u*)(H + (size_t)r * DFF + col0) = pack8bf(h0, h1); }
    }
};
#ifndef RESID_BF16
#define RESID_BF16 1
#endif
struct EpiResid {
#if RESID_BF16
    static constexpr bool PERM = true, AFTER_DRAIN = false, CHAIN = false; static constexpr int PMODE = 2;
#else
    static constexpr bool PERM = false, AFTER_DRAIN = false, CHAIN = false; static constexpr int PMODE = 0;
#endif
    const float* base; float* X; bf16* XB; float* part; float coef; int skip = 0;
    __device__ __forceinline__ void operator()(const f32x4 (&acc)[2][2][4][2], const Unit& u, int wr, int wc, int fr, int fq) const {
        if (skip) {
#pragma unroll
            for (int a = 0; a < 2; ++a)
#pragma unroll
                for (int b = 0; b < 2; ++b)
#pragma unroll
                    for (int m = 0; m < 4; ++m) asm volatile("" :: "v"(acc[a][b][m][0]), "v"(acc[a][b][m][1]));
            return; }
#if RESID_BF16
        const int row0 = u.pm * BM + wr * 64 + fr, col0 = u.pn * BM + wc * 64 + 16 * fq;
#pragma unroll
        for (int ai = 0; ai < 2; ++ai)
#pragma unroll
            for (int m = 0; m < 4; ++m) { const int r = row0 + ai * HALF + m * 16; float ss = 0.f;
#pragma unroll
                for (int bj = 0; bj < 2; ++bj) { const size_t o = (size_t)r * DM + col0 + bj * 8;
                    f32x4 b0, b1;
                    if (base) { b0 = *(const f32x4*)(base + o); b1 = *(const f32x4*)(base + o + 4); }
                    else { const v4u bw = *(const v4u*)(XB + o); b0 = (f32x4){bflo(bw.x), bfhi(bw.x), bflo(bw.y), bfhi(bw.y)}; b1 = (f32x4){bflo(bw.z), bfhi(bw.z), bflo(bw.w), bfhi(bw.w)}; }
                    const f32x4 v0 = b0 + acc[ai][bj][m][0] * coef, v1 = b1 + acc[ai][bj][m][1] * coef;
                    *(v4u*)(XB + o) = pack8bf(v0, v1);
                    ss += ((v0[0] * v0[0] + v0[1] * v0[1]) + (v0[2] * v0[2] + v0[3] * v0[3])) + ((v1[0] * v1[0] + v1[1] * v1[1]) + (v1[2] * v1[2] + v1[3] * v1[3])); }
                { auto r16_ = __builtin_amdgcn_permlane16_swap(__float_as_uint(ss), __float_as_uint(ss), false, false); ss = __uint_as_float(r16_[0]) + __uint_as_float(r16_[1]);
                  auto r32_ = __builtin_amdgcn_permlane32_swap(__float_as_uint(ss), __float_as_uint(ss), false, false); ss = __uint_as_float(r32_[0]) + __uint_as_float(r32_[1]); }
                if (fq == 0) part[(size_t)r * 32 + u.pn * 4 + wc] = ss;
                if ((m & (RESID_GROUP - 1)) == RESID_GROUP - 1) asm volatile("" ::: "memory"); }
#else
        const int row0 = u.pm * BM + wr * 64 + fr, col0 = u.pn * BM + wc * 32 + 4 * fq;
#pragma unroll
        for (int ai = 0; ai < 2; ++ai)
#pragma unroll
            for (int m = 0; m < 4; ++m) { const int r = row0 + ai * HALF + m * 16; float ss = 0.f;
#pragma unroll
                for (int bj = 0; bj < 2; ++bj)
#pragma unroll
                    for (int n = 0; n < 2; ++n) { const size_t o = (size_t)r * DM + col0 + bj * HALF + n * 16;
                        const f32x4 b = NT_X ? __builtin_nontemporal_load((const f32x4*)(base + o)) : *(const f32x4*)(base + o); const f32x4 v = b + acc[ai][bj][m][n] * coef;
                        if (NT_X) __builtin_nontemporal_store(v, (f32x4*)(X + o)); else *(f32x4*)(X + o) = v;
                        v2u w; w.x = pk2(v[0], v[1]); w.y = pk2(v[2], v[3]); *(v2u*)(XB + o) = w;
                        ss += (v[0] * v[0] + v[1] * v[1]) + (v[2] * v[2] + v[3] * v[3]); }
                ss += __shfl_xor(ss, 16); ss += __shfl_xor(ss, 32);
                if (fq == 0) part[(size_t)r * 32 + u.pn * 4 + wc] = ss;
                if ((m & (RESID_GROUP - 1)) == RESID_GROUP - 1) asm volatile("" ::: "memory"); }
#endif
    }
};
struct EpiProj {
    static constexpr bool PERM = true, AFTER_DRAIN = false, CHAIN = false; static constexpr int PMODE = 1;
    const float* rstd; const float* rcos; const float* rsin;
    bf16 *QKR, *VR, *GR, *QA, *KA, *VA, *US, *VS, *GATE; unsigned short *QI, *KI; float* WI; int skip = 0;
    __device__ __forceinline__ void operator()(const f32x4 (&acc)[2][2][4][2], const Unit& u, int wr, int wc, int fr, int fq) const {
        if (skip) {
#pragma unroll
            for (int a = 0; a < 2; ++a)
#pragma unroll
                for (int b = 0; b < 2; ++b)
#pragma unroll
                    for (int m = 0; m < 4; ++m) asm volatile("" :: "v"(acc[a][b][m][0]), "v"(acc[a][b][m][1]));
            return; }
        const int row0 = u.pm * BM + wr * 64 + fr, pn = u.pn, cw = wc * 32 + 8 * fq;
        const f32x4 rsv0 = *(const f32x4*)(rstd + u.pm * BM + (wr * 16 + fr) * 8), rsv1 = *(const f32x4*)(rstd + u.pm * BM + (wr * 16 + fr) * 8 + 4);
        if (pn < 3) {
            const int slot = 4 * pn + wc;
#pragma unroll
            for (int ai = 0; ai < 2; ++ai)
#pragma unroll
                for (int m = 0; m < 4; ++m) { const int r = row0 + ai * HALF + m * 16; const float rs = (ai ? rsv1 : rsv0)[m];
                    const f32x4 c0 = *(const f32x4*)(rcos + (size_t)r * 32 + 8 * fq), c1 = *(const f32x4*)(rcos + (size_t)r * 32 + 8 * fq + 4);
                    const f32x4 s0 = *(const f32x4*)(rsin + (size_t)r * 32 + 8 * fq), s1 = *(const f32x4*)(rsin + (size_t)r * 32 + 8 * fq + 4);
                    const f32x4 a0 = acc[ai][0][m][0] * rs, a1 = acc[ai][0][m][1] * rs, b0 = acc[ai][1][m][0] * rs, b1 = acc[ai][1][m][1] * rs;
                    const f32x4 o10 = a0 * c0 - b0 * s0, o11 = a1 * c1 - b1 * s1, o20 = a0 * s0 + b0 * c0, o21 = a1 * s1 + b1 * c1;
                    bf16* d = QKR + (size_t)r * 768 + slot * 64 + 8 * fq;
                    *(v4u*)d = pack8bf(o10, o11); *(v4u*)(d + 32) = pack8bf(o20, o21); }
            return;
        }
        if (pn == 19) {
#pragma unroll
            for (int ai = 0; ai < 2; ++ai)
#pragma unroll
                for (int m = 0; m < 4; ++m) { const int r = row0 + ai * HALF + m * 16; const float rs = (ai ? rsv1 : rsv0)[m];
                    if (wc < 2) *(v4u*)(KI + (size_t)r * 64 + cw) = pack8h(acc[ai][0][m][0] * rs, acc[ai][0][m][1] * rs);
                    if (wc == 2 && fq == 0) *(f32x4*)(WI + (size_t)r * 4) = acc[ai][0][m][0] * (rs * 0.0625f); }
            return;
        }
        int mode; unsigned short* dst; int ld, c0;
        if (pn < 6) { mode = 0; dst = VR; ld = 768; c0 = (pn - 3) * 256; }
        else if (pn < 9) { mode = 1; dst = GR; ld = 768; c0 = (pn - 6) * 256; }
        else if (pn < 12) { mode = 0; dst = QA; ld = 768; c0 = (pn - 9) * 256; }
        else if (pn < 15) { mode = 0; dst = KA; ld = 768; c0 = (pn - 12) * 256; }
        else if (pn < 18) { mode = 0; dst = VA; ld = 768; c0 = (pn - 15) * 256; }
        else if (pn == 18) { mode = 4; dst = QI; ld = 256; c0 = 0; }
        else if (pn < 22) { mode = 2; dst = US; ld = 512; c0 = (pn - 20) * 256; }
        else if (pn < 24) { mode = 2; dst = VS; ld = 512; c0 = (pn - 22) * 256; }
        else { mode = 3; dst = GATE; ld = 6144; c0 = (pn - 24) * 256; }
#pragma unroll
        for (int ai = 0; ai < 2; ++ai)
#pragma unroll
            for (int m = 0; m < 4; ++m) { const int r = row0 + ai * HALF + m * 16; const float rs = (ai ? rsv1 : rsv0)[m];
#pragma unroll
                for (int bj = 0; bj < 2; ++bj) { f32x4 v0 = acc[ai][bj][m][0] * rs, v1 = acc[ai][bj][m][1] * rs;
                    if (mode == 1 || mode == 2) { typedef float f2 __attribute__((ext_vector_type(2)));
#pragma unroll
                        for (int j = 0; j < 4; ++j) { f2 x = (j < 2) ? (f2){v0[2 * j], v0[2 * j + 1]} : (f2){v1[2 * j - 4], v1[2 * j - 3]};
                            f2 t = (mode == 1) ? x * -1.4426950408889634f : (x * (x * x * 0.044715f + 1.0f)) * (-1.4426950408889634f * 1.5957691216057308f);
                            f2 d = {__builtin_amdgcn_exp2f(t.x), __builtin_amdgcn_exp2f(t.y)}; d = d + 1.0f; const f2 rc = {__builtin_amdgcn_rcpf(d.x), __builtin_amdgcn_rcpf(d.y)}; x = x * rc;
                            if (j < 2) { v0[2 * j] = x.x; v0[2 * j + 1] = x.y; } else { v1[2 * j - 4] = x.x; v1[2 * j - 3] = x.y; } } }
                    else if (mode == 3) { typedef float f2 __attribute__((ext_vector_type(2)));
#pragma unroll
                        for (int j = 0; j < 2; ++j) { f2 a = {v0[2 * j], v0[2 * j + 1]}, b = {v1[2 * j], v1[2 * j + 1]}; a = a * -1.4426950408889634f; b = b * -1.4426950408889634f;
                            f2 da = {__builtin_amdgcn_exp2f(a.x), __builtin_amdgcn_exp2f(a.y)}, db = {__builtin_amdgcn_exp2f(b.x), __builtin_amdgcn_exp2f(b.y)}; da = da + 1.0f; db = db + 1.0f;
                            v0[2 * j] = da.x; v0[2 * j + 1] = da.y; v1[2 * j] = db.x; v1[2 * j + 1] = db.y; } }
                    const v4u w = (mode == 4) ? pack8h(v0, v1) : pack8bf(v0, v1);
                    v4u* dp = (v4u*)(dst + (size_t)r * ld + c0 + bj * HALF + cw);
                    if ((NT_GATE && mode == 3) || NT_PROJ) __builtin_nontemporal_store(w, dp); else *dp = w; } }
    }
};
struct EpiMerge {
    static constexpr bool PERM = true, AFTER_DRAIN = false, CHAIN = true; static constexpr int PMODE = 2;
    const bf16* GATE; bf16* MRG;
    __device__ __forceinline__ bool keep(const Unit& u) const { return (u.pm >> 6) < 2; }
    static __device__ __forceinline__ void dens8(const v4u g, float (&o)[8]) { const float hi = 1152921504606846976.0f;
        o[0] = fminf(bflo(g.x), hi); o[1] = fminf(bfhi(g.x), hi); o[2] = fminf(bflo(g.y), hi); o[3] = fminf(bfhi(g.y), hi); o[4] = fminf(bflo(g.z), hi); o[5] = fminf(bfhi(g.z), hi); o[6] = fminf(bflo(g.w), hi); o[7] = fminf(bfhi(g.w), hi); }
    __device__ __forceinline__ void operator()(f32x4 (&acc)[2][2][4][2], const Unit& u, int wr, int wc, int fr, int fq) const {
        const int br = u.pm >> 6, pm = u.pm & 63, pn = u.pn & 7;
        const int row0 = pm * BM + wr * 64 + fr, col0 = pn * BM + wc * 64 + 16 * fq;
        if (br < 2) {
#pragma unroll
            for (int ai = 0; ai < 2; ++ai)
#pragma unroll
                for (int m = 0; m < 4; ++m) { const int r = row0 + ai * HALF + m * 16;
#pragma unroll
                    for (int bj = 0; bj < 2; ++bj) { const int c = col0 + bj * 8;
                        const bf16* gp = GATE + (size_t)r * 6144 + br * 2048 + c;
                        float f[8], d[8]; dens8(*(const v4u*)gp, f); dens8(*(const v4u*)(gp + 2048), d);
#pragma unroll
                        for (int j = 0; j < 8; ++j) f[j] = __builtin_amdgcn_rcpf(f[j]) * d[j];
                        f32x4 v0 = acc[ai][bj][m][0], v1 = acc[ai][bj][m][1];
                        v0[0] *= f[0]; v0[1] *= f[1]; v0[2] *= f[2]; v0[3] *= f[3]; v1[0] *= f[4]; v1[1] *= f[5]; v1[2] *= f[6]; v1[3] *= f[7];
                        acc[ai][bj][m][0] = v0; acc[ai][bj][m][1] = v1; } }
            return;
        }
#pragma unroll
        for (int ai = 0; ai < 2; ++ai)
#pragma unroll
            for (int m = 0; m < 4; ++m) { const int r = row0 + ai * HALF + m * 16;
#pragma unroll
                for (int bj = 0; bj < 2; ++bj) { const int c = col0 + bj * 8;
                    float f[8]; dens8(*(const v4u*)(GATE + (size_t)r * 6144 + 2 * 2048 + c), f);
#pragma unroll
                    for (int j = 0; j < 8; ++j) f[j] = __builtin_amdgcn_rcpf(f[j]);
                    f32x4 v0 = acc[ai][bj][m][0], v1 = acc[ai][bj][m][1];
                    v0[0] *= f[0]; v0[1] *= f[1]; v0[2] *= f[2]; v0[3] *= f[3]; v1[0] *= f[4]; v1[1] *= f[5]; v1[2] *= f[6]; v1[3] *= f[7];
                    *(v4u*)(MRG + (size_t)r * DM + c) = pack8bf(v0, v1); } }
    }
};
struct MergeOrder {
    pg8::StaticOrder so;
    __device__ void init(int G, int c, int wgm) { so.init(HROWS, DM, G, c, wgm); }
    __device__ bool next(int i, Unit& u) const { Unit t; if (!so.next(i / 3, t)) return false; const int br = i % 3; u.pm = 64 * br + t.pm; u.pn = 8 * br + t.pn; return true; }
    __device__ __forceinline__ void a_ready(const Unit&) const {}
    __device__ __forceinline__ void done(const Unit&) const {}
    __device__ __forceinline__ int ktiles(const Unit& u, int full) const { return (u.pm >> 6) == 2 ? 512 / 64 : full; }
};

struct Args { const void* in[22]; float* out; unsigned char* ws; int ph_lo, ph_hi; };
struct Frame {
    LAS unsigned char* lds; volatile LAS unsigned* MISC; gu32* ctl;
    int tid, lane, wave, vcu, G;
    unsigned char* ws;
    const float* xin; const int* pos; const float* rel;
    float* X;
};

__device__ __forceinline__ void conv_item(const float* W, int ldw, int sc, int cnt, int k0, int kvalid, const float* gain, bf16* WT, int drow0, int Kd, LAS float* scr, int lane, bool blk = false) {
#define WT_AT(n_, k_) (blk ? (WT + ((((size_t)((n_) >> 8) * (Kd / 64) + ((k_) >> 6)) * 256 + ((n_) & 255)) * 64 + ((k_) & 63))) : (WT + (size_t)(n_) * Kd + (k_)))
    const int c8 = lane & 7;
    if (k0 >= kvalid || cnt <= 0) {
#pragma unroll
        for (int j = 0; j < 4; ++j) { const int n = (lane >> 3) + 8 * j; *(GAS v4u*)WT_AT(drow0 + n, k0 + 8 * c8) = zero4u(); }
        return;
    }
    const int c4 = (lane & 7) * 4, kr = lane >> 3; const bool cok = c4 < cnt; const int cc = cok ? c4 : 0;
    f32x4 v[8];
#pragma unroll
    for (int i = 0; i < 8; ++i) v[i] = *(const f32x4*)(W + (size_t)(k0 + 8 * i + kr) * ldw + sc + cc);
#pragma unroll
    for (int i = 0; i < 8; ++i) { const int kk = 8 * i + kr; f32x4 x = cok ? v[i] : (f32x4){0.f, 0.f, 0.f, 0.f}; if (gain) x = x * gain[k0 + kk];
        LAS float* d = scr + kk * 33 + c4; d[0] = x[0]; d[1] = x[1]; d[2] = x[2]; d[3] = x[3]; }
    LDS_WAIT(); asm volatile("" ::: "memory");
#pragma unroll
    for (int j = 0; j < 4; ++j) { const int n = (lane >> 3) + 8 * j; const LAS float* s = scr + (8 * c8) * 33 + n;
        v4u o; o.x = pk2(s[0 * 33], s[1 * 33]); o.y = pk2(s[2 * 33], s[3 * 33]); o.z = pk2(s[4 * 33], s[5 * 33]); o.w = pk2(s[6 * 33], s[7 * 33]);
        *(GAS v4u*)WT_AT(drow0 + n, k0 + 8 * c8) = o; }
    LDS_WAIT(); asm volatile("" ::: "memory");
#undef WT_AT
}
__device__ __forceinline__ void proj_src_group(int g, int& sc, int& cnt) {
    const int r0 = 32 * g; cnt = 32;
    if (r0 < 768) { const int t = r0 / 256, w = r0 % 256, bj = w / 128, wcq = (w % 128) / 32; sc = (4 * t + wcq) * 64 + 32 * bj; }
    else if (r0 < 4864) sc = r0;
    else if (r0 < 5120) { const int w = r0 - 4864; if (w < 64) sc = 4864 + w; else if (w == 64) { sc = 4928; cnt = 4; } else { sc = 0; cnt = 0; } }
    else if (r0 < 6144) sc = 4932 + (r0 - 5120);
    else sc = 5956 + (r0 - 6144);
}
__device__ __forceinline__ void p_convert(Frame& F0, const Args& a, int l) {
    Frame F = F0; { GAS unsigned char* wsg_ = (GAS unsigned char*)F.ws; F.tid = F.wave * 64 + lane_id(); asm volatile("" : "+v"(F.tid), "+s"(wsg_), "+s"(F.vcu), "+s"(F.G)); F.lane = F.tid & 63; F.ws = (unsigned char*)wsg_; }
    LAS float* scr = (LAS float*)(F.lds + RING_OFF + F.wave * 16384);
    const int gw = F.vcu * NWAVES + F.wave, NGW = F.G * NWAVES;
    constexpr int I_GU = 352 * 32, I_D = 64 * 88, I_IN = 384 * 32, I_BR = 192 * 12, I_OUT = 64 * 32;
    constexpr int NITEMS = 2 * (I_GU + I_D) + I_IN + I_BR + I_OUT;
#pragma unroll 1
    for (int it = gw; it < NITEMS; it += NGW) {
        int r = it;
        int src_idx, ldw, sc, cnt = 32, k0, kvalid, gain_idx = -1, drow0, Kd; size_t src_off, dst_off; bool blk = false;
        if (r < 2 * (I_GU + I_D)) {
            const int which = r / (I_GU + I_D); r -= which * (I_GU + I_D);
            if (r < I_GU) { const int g = r / 32, kb = r % 32, pn = g / 8, w = g % 8, bj = w / 4;
                src_idx = (which ? 18 : 4) + bj; src_off = (size_t)l * DM * DFF; ldw = DFF; sc = 128 * pn + (w % 4) * 32; k0 = 64 * kb; kvalid = DM; gain_idx = which ? 17 : 3;
                dst_off = which ? WS_WGU2 : WS_WGU1; drow0 = 32 * g; Kd = DM; }
            else { r -= I_GU; const int g = r / 88, kb = r % 88;
                src_idx = which ? 20 : 6; src_off = (size_t)l * DFF * DM; ldw = DM; sc = 32 * g; k0 = 64 * kb; kvalid = DFF;
                dst_off = which ? WS_WD2 : WS_WD1; drow0 = 32 * g; Kd = DFF; blk = HID_BLK; }
        } else {
            r -= 2 * (I_GU + I_D);
            if (r < I_IN) { const int g = r / 32, kb = r % 32; proj_src_group(g, sc, cnt);
                src_idx = 8; src_off = (size_t)l * DM * DIN; ldw = DIN; k0 = 64 * kb; kvalid = DM; gain_idx = 7; dst_off = WS_WIN; drow0 = 32 * g; Kd = DM; }
            else { r -= I_IN;
                if (r < I_BR) { const int g = r / 12, kb = r % 12, br = g / 64; const int kbr = br == 2 ? 512 : 768;
                    src_idx = 13 + br; src_off = (size_t)l * kbr * DM; ldw = DM; sc = 32 * (g % 64); k0 = 64 * kb; kvalid = kbr; dst_off = WS_WBR; drow0 = 32 * g; Kd = 768; }
                else { r -= I_BR; const int g = r / 32, kb = r % 32;
                    src_idx = 16; src_off = (size_t)l * DM * DM; ldw = DM; sc = 32 * g; k0 = 64 * kb; kvalid = DM; dst_off = WS_WOUT; drow0 = 32 * g; Kd = DM; } }
        }
        const float* W = (const float*)a.in[src_idx] + src_off;
        const float* gain = gain_idx >= 0 ? (const float*)a.in[gain_idx] + (size_t)l * DM : nullptr;
        conv_item(W, ldw, sc, cnt, k0, kvalid, gain, (bf16*)(F.ws + dst_off), drow0, Kd, scr, F.lane, blk);
    }
}
__device__ __forceinline__ void p_prologue(Frame& F0) {
    Frame F = F0; { GAS unsigned char* wsg_ = (GAS unsigned char*)F.ws; F.tid = F.wave * 64 + lane_id(); asm volatile("" : "+v"(F.tid), "+s"(wsg_), "+s"(F.vcu), "+s"(F.G)); F.lane = F.tid & 63; F.ws = (unsigned char*)wsg_; }
    const int gw = F.vcu * NWAVES + F.wave, NGW = F.G * NWAVES;
    float* rcos = (float*)(F.ws + WS_ROPE); float* rsin = rcos + (size_t)MTOK * 32;
    const int j = F.lane & 31;
    const float invf = powf(10000.0f, -(float)(2 * j) / 64.0f);
    for (int t2 = gw; t2 < MTOK / 2; t2 += NGW) { const int t = 2 * t2 + (F.lane >> 5);
        const float ang = (float)F.pos[t] * invf;
        double rev = (double)ang * 0.15915494309189533577; rev -= __builtin_rint(rev);
        const float fr = (float)rev;
        rcos[(size_t)t * 32 + j] = __builtin_amdgcn_cosf(fr); rsin[(size_t)t * 32 + j] = __builtin_amdgcn_sinf(fr); }
    { int* pc = (int*)(F.ws + WS_POS); for (int i = F.vcu * NTHR + F.tid; i < MTOK; i += F.G * NTHR) pc[i] = F.pos[i]; }
    int* kmax = (int*)(F.ws + WS_KMAX);
    for (int kt = gw; kt < BATCH * 256; kt += NGW) { const int p0 = F.pos[kt * 64 + F.lane]; int p = p0, q0 = p0;
#pragma unroll
        for (int o = 1; o < 64; o <<= 1) { const int q = __shfl_xor(p, o); p = q > p ? q : p; }
#pragma unroll
        for (int o = 1; o < 32; o <<= 1) { const int q = __shfl_xor(q0, o); q0 = q < q0 ? q : q0; }
        if (F.lane == 0) kmax[kt] = p;
        if ((F.lane & 31) == 0) kmax[1024 + 2 * kt + (F.lane >> 5)] = q0; }
    bf16* XB = (bf16*)(F.ws + WS_XB); float* part = (float*)(F.ws + WS_PART);
    for (int m = gw; m < MTOK; m += NGW) {
        const GAS f32x4* xr = (const GAS f32x4*)(F.xin + (size_t)m * DM) + F.lane; float ss = 0.f;
        f32x4 vv[8];
#pragma unroll
        for (int jj = 0; jj < 8; ++jj) vv[jj] = xr[64 * jj];
#pragma unroll
        for (int jj = 0; jj < 8; ++jj) { const f32x4 v = vv[jj]; ss += (v[0] * v[0] + v[1] * v[1]) + (v[2] * v[2] + v[3] * v[3]);
            v2u w; w.x = pk2(v[0], v[1]); w.y = pk2(v[2], v[3]); *((GAS v2u*)(XB + (size_t)m * DM) + F.lane + 64 * jj) = w; }
        ss = wave_sum(ss);
        if (F.lane < 32) part[(size_t)m * 32 + F.lane] = F.lane == 0 ? ss : 0.f; }
}
__device__ __forceinline__ void p_rowstat(Frame& F0) {
    Frame F = F0; { GAS unsigned char* wsg_ = (GAS unsigned char*)F.ws; F.tid = F.wave * 64 + lane_id(); asm volatile("" : "+v"(F.tid), "+s"(wsg_), "+s"(F.vcu), "+s"(F.G)); F.lane = F.tid & 63; F.ws = (unsigned char*)wsg_; }
    const float* part = (const float*)(F.ws + WS_PART); float* rstd = (float*)(F.ws + WS_RSTD);
    for (int r = F.vcu * NTHR + F.tid; r < MTOK; r += F.G * NTHR) { const f32x4* p = (const f32x4*)(part + (size_t)r * 32); float s = 0.f;
#pragma unroll
        for (int jj = 0; jj < 8; ++jj) { const f32x4 v = p[jj]; s += (v[0] + v[1]) + (v[2] + v[3]); }
        rstd[(r & ~255) + (((r >> 6) & 1) * 16 + (r & 15)) * 8 + ((r >> 7) & 1) * 4 + ((r >> 4) & 3)] = 1.0f / sqrtf(s * (1.0f / DM) + EPS); }
}
__device__ __forceinline__ void p_final(Frame& F0, const float* gfin) {
    Frame F = F0; { GAS unsigned char* wsg_ = (GAS unsigned char*)F.ws; F.tid = F.wave * 64 + lane_id(); asm volatile("" : "+v"(F.tid), "+s"(wsg_), "+s"(F.vcu), "+s"(F.G)); F.lane = F.tid & 63; F.ws = (unsigned char*)wsg_; }
    const int gw = F.vcu * NWAVES + F.wave, NGW = F.G * NWAVES; const float* rstd = (const float*)(F.ws + WS_RSTD);
    const float* part = (const float*)(F.ws + WS_PART); (void)rstd;
#if RESID_BF16
    f32x4 gq[8];
#pragma unroll
    for (int jj = 0; jj < 8; ++jj) gq[jj] = *((const f32x4*)gfin + F.lane + 64 * jj);
#endif
    for (int m = gw; m < MTOK; m += NGW) { GAS f32x4* xr = (GAS f32x4*)(F.X + (size_t)m * DM) + F.lane;
#if RESID_BF16
        const GAS v2u* xb = (const GAS v2u*)((const bf16*)(F.ws + WS_XB) + (size_t)m * DM) + F.lane;
        v2u wq[8];
#pragma unroll
        for (int jj = 0; jj < 8; ++jj) wq[jj] = xb[64 * jj];
        const float rs = 1.0f / sqrtf(wave_sum(F.lane < 32 ? part[(size_t)m * 32 + F.lane] : 0.f) * (1.0f / DM) + EPS);
#pragma unroll
        for (int jj = 0; jj < 8; ++jj) { const v2u w = wq[jj];
            xr[64 * jj] = (f32x4){bflo(w.x), bfhi(w.x), bflo(w.y), bfhi(w.y)} * rs * gq[jj]; } }
#else
        const float rs = 1.0f / sqrtf(wave_sum(F.lane < 32 ? part[(size_t)m * 32 + F.lane] : 0.f) * (1.0f / DM) + EPS);
#pragma unroll
        for (int jj = 0; jj < 8; ++jj) { const f32x4 g = *((const f32x4*)gfin + F.lane + 64 * jj); xr[64 * jj] = xr[64 * jj] * rs * g; } }
#endif
}

namespace idx {
constexpr int IDX_STATE = 131072 + 128;
typedef LAS unsigned* lhist_t;
__device__ __forceinline__ int crow16(int r, int hi) { return (r & 3) + 8 * (r >> 2) + 4 * hi; }
struct QState { f16x8 qf[4][4]; f32x4 wv; };
struct KFrag { f16x8 k[4]; };
__device__ __forceinline__ void load_k(const GAS char* ws, int kt, int c, int hi, KFrag& K) {
    const GAS char* p = ws + (unsigned)((unsigned)WS_KI + (unsigned)((32 * kt + c) * 64 + 8 * hi) * 2u);
#pragma unroll
    for (int ks = 0; ks < 4; ++ks) K.k[ks] = *(const GAS f16x8*)(p + ks * 32);
}
typedef float f32x2 __attribute__((ext_vector_type(2)));
__device__ __forceinline__ void relu_fma(const f32x16& a, float w, f32x2 (&s2)[8]) {
    const f32x2 w2 = (f32x2){w, w};
#pragma unroll
    for (int i = 0; i < 8; ++i) { f32x2 p; { const float f0 = a[2 * i], f1 = a[2 * i + 1]; const int x0 = __builtin_bit_cast(int, f0), x1 = __builtin_bit_cast(int, f1);
            p.x = __builtin_bit_cast(float, x0 > 0 ? x0 : 0); p.y = __builtin_bit_cast(float, x1 > 0 ? x1 : 0); } s2[i] = p * w2 + s2[i]; }
}
__device__ __forceinline__ void score_tile2(const KFrag& Ka, const KFrag& Kb, const LAS char* qlds, const f32x4 wv, f32x16& sa, f32x16& sb) {
    f32x2 a2[8], b2[8];
#pragma unroll
    for (int i = 0; i < 8; ++i) { a2[i] = (f32x2){0.f, 0.f}; b2[i] = (f32x2){0.f, 0.f}; }
#pragma unroll
    for (int h = 0; h < 4; ++h) { f32x16 aa = {}, ab = {};
#pragma unroll
        for (int ks = 0; ks < 4; ++ks) { const f16x8 qf = *(const LAS f16x8*)(qlds + (h * 4 + ks) * 1024);
            aa = __builtin_amdgcn_mfma_f32_32x32x16_f16(Ka.k[ks], qf, aa, 0, 0, 0); ab = __builtin_amdgcn_mfma_f32_32x32x16_f16(Kb.k[ks], qf, ab, 0, 0, 0); }
        relu_fma(aa, wv[h], a2); relu_fma(ab, wv[h], b2); }
#pragma unroll
    for (int i = 0; i < 8; ++i) { sa[2 * i] = a2[i].x; sa[2 * i + 1] = a2[i].y; sb[2 * i] = b2[i].x; sb[2 * i + 1] = b2[i].y; }
}
__device__ __forceinline__ void score_tile1(const KFrag& Ka, const LAS char* qlds, const f32x4 wv, f32x16& sa) {
    f32x2 a2[8];
#pragma unroll
    for (int i = 0; i < 8; ++i) a2[i] = (f32x2){0.f, 0.f};
#pragma unroll
    for (int h = 0; h < 4; ++h) { f32x16 aa = {};
#pragma unroll
        for (int ks = 0; ks < 4; ++ks) aa = __builtin_amdgcn_mfma_f32_32x32x16_f16(Ka.k[ks], *(const LAS f16x8*)(qlds + (h * 4 + ks) * 1024), aa, 0, 0, 0);
        relu_fma(aa, wv[h], a2); }
#pragma unroll
    for (int i = 0; i < 8; ++i) { sa[2 * i] = a2[i].x; sa[2 * i + 1] = a2[i].y; }
}
__device__ __forceinline__ unsigned skey22(float s) { unsigned u = __builtin_bit_cast(unsigned, s); u ^= (unsigned)((int)u >> 31) | 0x80000000u; return u >> 10; }

template <int PASS, bool CAUSAL>
__device__ __forceinline__ void hist_tile(const f32x16& sc, int kt, int q, int c, int hi, lhist_t hrow, unsigned pfx) {
#pragma unroll
    for (int r = 0; r < 16; ++r) { const unsigned k22 = skey22(sc[r]); unsigned bin, inc;
        if (PASS == 0) { bin = k22 >> 11; inc = 1u; } else { bin = k22 & 2047u; inc = (k22 >> 11) == pfx ? 1u : 0u; }
        if (CAUSAL) { const int s = 32 * kt + crow16(r, hi); inc = s <= q ? inc : 0u; }
        __hip_atomic_fetch_add(hrow + ((bin >> 1) ^ (unsigned)c), inc << ((bin & 1u) * 16u), __ATOMIC_RELAXED, __HIP_MEMORY_SCOPE_WORKGROUP);
        if ((r & 3) == 3) __builtin_amdgcn_sched_barrier(0); }
}
template <int PASS>
__device__ __forceinline__ void hist_pass(const GAS char* ws, int q0, int qb32, int wave, int c, int hi, const LAS char* qlds, const f32x4 wv, lhist_t hist, unsigned pfx) {
    const int q = q0 + c; lhist_t hrow = hist + c * 1024;
    KFrag Ka, Kb;
    if (wave < qb32) { load_k(ws, wave, c, hi, Ka); load_k(ws, wave + 8 < qb32 ? wave + 8 : wave, c, hi, Kb); }
#pragma unroll 1
    for (int kt = wave; kt < qb32; kt += 16) { const bool has2 = kt + 8 < qb32;
        f32x16 sa, sb; score_tile2(Ka, Kb, qlds, wv, sa, sb);
        { const int kn = kt + 16 < qb32 ? kt + 16 : kt, kn2 = kn + 8 < qb32 ? kn + 8 : kn; load_k(ws, kn, c, hi, Ka); load_k(ws, kn2, c, hi, Kb); }
        hist_tile<PASS, false>(sa, kt, q, c, hi, hrow, pfx);
        if (has2) hist_tile<PASS, false>(sb, kt + 8, q, c, hi, hrow, pfx); }
    if (wave == (qb32 & 7)) { load_k(ws, qb32, c, hi, Ka); f32x16 sa; score_tile1(Ka, qlds, wv, sa); hist_tile<PASS, true>(sa, qb32, q, c, hi, hrow, pfx); }
}
constexpr int LROW = 1025;
template <bool CAUSAL>
__device__ __forceinline__ void lhist_tile(const f32x16& sc, int kt, int q, int c, int hi, lhist_t hrow, float ka, float kc) {
#pragma unroll
    for (int r = 0; r < 16; ++r) { const int b = (int)__builtin_amdgcn_fmed3f(__builtin_fmaf(sc[r], ka, kc), 0.f, 1023.f); unsigned inc = 1u;
        if (CAUSAL) { const int s = 32 * kt + crow16(r, hi); inc = s <= q ? 1u : 0u; }
        __hip_atomic_fetch_add(hrow + b, inc, __ATOMIC_RELAXED, __HIP_MEMORY_SCOPE_WORKGROUP);
        if ((r & 3) == 3) __builtin_amdgcn_sched_barrier(0); }
}
__device__ __forceinline__ void lhist_pass(const GAS char* ws, int q0, int qb32, int wave, int c, int hi, const LAS char* qlds, const f32x4 wv, lhist_t hist, float ka, float kc, int step, bool diag) {
    const int q = q0 + c; lhist_t hrow = hist + c * LROW;
    KFrag Ka, Kb;
    if (wave < qb32) { load_k(ws, wave, c, hi, Ka); load_k(ws, wave + 8 < qb32 ? wave + 8 : wave, c, hi, Kb); }
#pragma unroll 1
    for (int kt = wave; kt < qb32; kt += step) { const bool has2 = kt + 8 < qb32;
        f32x16 sa, sb; score_tile2(Ka, Kb, qlds, wv, sa, sb);
        { const int kn = kt + step < qb32 ? kt + step : kt, kn2 = kn + 8 < qb32 ? kn + 8 : kn; load_k(ws, kn, c, hi, Ka); load_k(ws, kn2, c, hi, Kb); }
        lhist_tile<false>(sa, kt, q, c, hi, hrow, ka, kc);
        if (has2) lhist_tile<false>(sb, kt + 8, q, c, hi, hrow, ka, kc); }
    if (diag && wave == (qb32 & 7)) { load_k(ws, qb32, c, hi, Ka); f32x16 sa; score_tile1(Ka, qlds, wv, sa); lhist_tile<true>(sa, qb32, q, c, hi, hrow, ka, kc); }
}
__device__ __forceinline__ void lin_scan(const LAS unsigned* hrow, int cq, int lane, unsigned& sl_out, unsigned& T_out) {
    unsigned sl = 0;
#pragma unroll
    for (int j = 0; j < 16; ++j) sl += hrow[16 * lane + j];
    unsigned T = sl;
#pragma unroll
    for (int o = 1; o < 64; o <<= 1) { const unsigned v = __shfl_down(T, o); T += (lane + o < 64) ? v : 0u; }
    sl_out = sl; T_out = T;
}
__device__ __forceinline__ int lin_locate(const LAS unsigned* hrow, int cq, int lane, unsigned sl, unsigned T, unsigned need, unsigned& need_out, unsigned& cnt_out) {
    const unsigned long long bal = __ballot(T >= need);
    if (bal == 0ull) { need_out = need; cnt_out = 0u; return -1; }
    const int L = 63 - __builtin_clzll(bal);
    int bin = -1; unsigned nn = need, cb = 0u;
    if (lane == L) { unsigned cum = T - sl;
#pragma unroll 1
        for (int j = 15; j >= 0 && bin < 0; --j) { const unsigned w = hrow[16 * lane + j];
            if (cum + w >= need) { bin = 16 * lane + j; nn = need - cum; cb = w; } else cum += w; } }
    bin = __shfl(bin, L); nn = __shfl(nn, L); cb = __shfl(cb, L); need_out = nn; cnt_out = cb; return bin;
}
__device__ __forceinline__ f32x4 load_wv(const GAS char* ws, int q) {
    unsigned o = (unsigned)WS_WI + (unsigned)q * 16u; asm volatile("" : "+v"(o));
    const f32x4 w = *(const GAS f32x4*)(ws + o);
    const float sa = fmaxf((__builtin_fabsf(w[0]) + __builtin_fabsf(w[1])) + (__builtin_fabsf(w[2]) + __builtin_fabsf(w[3])), 1e-30f);
    const float sc = __uint_as_float(__float_as_uint(40.0f / sa) & 0x7f800000u);
    return w * sc;
}
__device__ __forceinline__ int select_bin(const LAS unsigned* hrow, int cq, int lane, unsigned need, unsigned& need_out) {
    unsigned sl = 0;
#pragma unroll
    for (int j = 0; j < 16; ++j) { const unsigned w = hrow[(16 * lane + j) ^ cq]; sl += (w & 0xffffu) + (w >> 16); }
    unsigned T = sl;
#pragma unroll
    for (int o = 1; o < 64; o <<= 1) { const unsigned v = __shfl_down(T, o); T += (lane + o < 64) ? v : 0u; }
    const unsigned long long bal = __ballot(T >= need);
    if (bal == 0ull) { need_out = need; return -1; }
    const int L = 63 - __builtin_clzll(bal);
    int bin = -1; unsigned nn = need;
    if (lane == L) { unsigned cum = T - sl;
#pragma unroll 1
        for (int j = 15; j >= 0 && bin < 0; --j) { const unsigned w = hrow[(16 * lane + j) ^ cq]; const unsigned chi = w >> 16, clo = w & 0xffffu;
            if (cum + chi >= need) { bin = 32 * lane + 2 * j + 1; nn = need - cum; } else { cum += chi;
                if (cum + clo >= need) { bin = 32 * lane + 2 * j; nn = need - cum; } else cum += clo; } } }
    bin = __shfl(bin, L); nn = __shfl(nn, L); need_out = nn; return bin;
}
__device__ __forceinline__ void item(const Frame& F, int qb32) {
    lhist_t hist = (lhist_t)(F.lds); LAS unsigned* sta = (LAS unsigned*)(F.lds + IDX_STATE); LAS unsigned* need = sta + 32;
    LAS unsigned* Gw = (LAS unsigned*)(F.lds); LAS unsigned* Tw = (LAS unsigned*)(F.lds + 65536);
    const GAS char* ws = (const GAS char*)F.ws;
    int lane_ = lane_id();
    int wave_ = F.wave; asm volatile("" : "+s"(wave_));
    const int lane = lane_, wave = wave_, tid = wave * 64 + lane, c = lane & 31, hi = lane >> 5, q0 = 32 * qb32, q = q0 + c;
    LAS char* qall = (LAS char*)(F.lds + IDX_STATE + 1024);
    const LAS char* qlds = qall + lane * 16;
    if (wave == 0) {
#pragma unroll
        for (int h = 0; h < 4; ++h)
#pragma unroll
            for (int ks = 0; ks < 4; ++ks) *(LAS f16x8*)(qall + (h * 4 + ks) * 1024 + lane * 16) = *(const GAS f16x8*)(ws + (unsigned)((unsigned)WS_QI + (unsigned)(q * 256 + 8 * hi) * 2u) + (h * 64 + 16 * ks) * 2); }
    LAS unsigned* lcnt = sta + 96; LAS unsigned* slowf = sta + 128;
    LAS unsigned* lists = (LAS unsigned*)(F.lds + IDX_STATE + 1024 + 16384);
    constexpr unsigned LCAP = 56;
    if (tid < 32) { sta[tid] = 0u; need[tid] = (unsigned)TOPK; lcnt[tid] = 0u; } if (tid >= 32 && tid < 35) slowf[tid - 32] = 0u;
    const bool sel_needed = q0 + 31 >= TOPK;
    bool fast = false;
    if (sel_needed) {
        LAS float* kaf = (LAS float*)(sta + 160); LAS float* kcf = (LAS float*)(sta + 192);
        #ifndef IDX_CBCAP
#define IDX_CBCAP LCAP
#endif
#ifndef IDX_FORCEZOOM
#define IDX_FORCEZOOM 0
#endif
#ifndef IDX_SMAX
#define IDX_SMAX 16
#endif
#ifndef IDX_BRK_A
#define IDX_BRK_A 3.5f
#define IDX_BRK_B 5.0f
#endif
        const int S_ = qb32 >> 4, pstep = 16 * (S_ < 1 ? 1 : (S_ > IDX_SMAX ? IDX_SMAX : S_));
        LAS float* kza = (LAS float*)(sta + 224); LAS float* kzc = (LAS float*)(sta + 64);
        int nlp = 2;
#pragma unroll 1
        for (int lp = 0; lp < nlp; ++lp) {
#pragma unroll
            for (int i = 0; i < 64; ++i) hist[tid + 512 * i] = 0u;
            if (tid < 32) hist[32768 + tid] = 0u;
            LDS_WAIT(); __syncthreads();
            { float ka_ = 1.0f, kc_ = 256.0f; if (lp >= 1) { ka_ = kaf[c]; kc_ = kcf[c]; }
              const f32x4 wv = load_wv(ws, q); lhist_pass(ws, q0, qb32, wave, c, hi, qlds, wv, hist, ka_, kc_, lp == 0 ? pstep : 16, lp >= 1); }
            LDS_WAIT(); __syncthreads();
#pragma unroll 1
            for (int i = 0; i < 4; ++i) { const int cq = 4 * wave + i; unsigned sl, T; lin_scan(hist + cq * LROW, cq, lane, sl, T);
                if (lp == 0) {
                    const unsigned total = (unsigned)__builtin_amdgcn_readfirstlane((int)T);
                    const float rmid = 256.0f * (float)total / (float)(q0 + cq + 1), sq = __builtin_sqrtf(rmid);
                    const float fa = __builtin_floorf(rmid - IDX_BRK_A * sq - 2.0f), fb = __builtin_ceilf(rmid + IDX_BRK_B * sq + 8.0f);
                    const unsigned ra = fa < 1.0f ? 1u : (unsigned)fa, rb = (unsigned)fb; unsigned n0, n1;
                    const int ba = lin_locate(hist + cq * LROW, cq, lane, sl, T, ra, n0, n1); int bb = lin_locate(hist + cq * LROW, cq, lane, sl, T, rb, n0, n1);
                    if (bb < 0) bb = 0;
                    if (lane == 0) { const float lo = (float)(bb - 256), hiw = (float)(ba - 255); const float ka_ = 1022.0f / (hiw - lo); kaf[cq] = ka_; kcf[cq] = 1.0f - lo * ka_; } }
                else { unsigned nn, cb; const int bin = lin_locate(hist + cq * LROW, cq, lane, sl, T, (unsigned)TOPK, nn, cb);
                    if (lane == 0) { sta[cq] = (unsigned)bin; need[cq] = nn;
                        const float kc0 = kcf[cq]; const int zb = (int)__builtin_floorf(__builtin_amdgcn_fmed3f(kc0, 0.f, 1023.f));
                        if (!(bin >= 1 && bin <= 1022)) __hip_atomic_fetch_or(slowf + (lp - 1), 1u, __ATOMIC_RELAXED, __HIP_MEMORY_SCOPE_WORKGROUP);
                        else if (!(bin == zb || cb <= IDX_CBCAP)) __hip_atomic_fetch_or(slowf + (lp - 1), lp == 1 ? 8u : 2u, __ATOMIC_RELAXED, __HIP_MEMORY_SCOPE_WORKGROUP);
                        if (lp == 1) { const float Z = 1022.0f / 3.0f; kza[cq] = kaf[cq] * Z; kzc[cq] = (kc0 - (float)(bin - 1)) * Z + 1.0f; } } } }
            LDS_WAIT(); __syncthreads();
            if (lp == 1) { const int f1 = __builtin_amdgcn_readfirstlane((int)slowf[0]);
                if (f1 == 8 || (IDX_FORCEZOOM && f1 == 0)) { nlp = 3; if (tid < 32) { kaf[tid] = kza[tid]; kcf[tid] = kzc[tid]; } } }
        }
        { const int f1 = __builtin_amdgcn_readfirstlane((int)slowf[0]), f2 = __builtin_amdgcn_readfirstlane((int)slowf[1]); fast = nlp == 2 ? f1 == 0 : f2 == 0; }
        if (fast) {
            const f32x4 wv = load_wv(ws, q);
            const float loT = (float)(int)sta[c], hiT = loT + 1.0f, ka_ = kaf[c], kc_ = kcf[c];
#define MASK_TILE_F(SC, KT, CAUSAL) do { unsigned gb = 0u, eb = 0u, tb = 0u; \
            _Pragma("unroll") for (int r = 15; r >= 0; --r) { const float u2_ = __builtin_fmaf(SC[r], ka_, kc_); \
                bool g_ = u2_ >= hiT, e_ = u2_ >= loT; if (CAUSAL) { const bool ok_ = 32 * (KT) + crow16(r, hi) <= q; g_ = g_ && ok_; e_ = e_ && ok_; } \
                gb = gb + gb + (g_ ? 1u : 0u); eb = eb + eb + (e_ ? 1u : 0u); \
                if ((r & 3) == 0) __builtin_amdgcn_sched_barrier(0); } \
            eb &= ~gb;                                              \
            if (eb != 0u) { \
                _Pragma("unroll") for (int r = 0; r < 16; ++r) if (eb & (1u << r)) { const float t_ = SC[r]; \
                    if (t_ == 0.f) tb |= 1u << ((r & 3) + 8 * (r >> 2)); \
                    else { const unsigned p_ = __hip_atomic_fetch_add(lcnt + c, 1u, __ATOMIC_RELAXED, __HIP_MEMORY_SCOPE_WORKGROUP); \
                           if (p_ < LCAP) { unsigned u_ = __float_as_uint(t_); u_ ^= (unsigned)((int)u_ >> 31) | 0x80000000u; \
                               *(LAS v2u*)(lists + 2 * (c * LCAP + p_)) = (v2u){16383u - (unsigned)(32 * (KT) + crow16(r, hi)), u_}; } } } } \
            gb = (gb | (gb << 8)) & 0x00ff00ffu; gb = (gb | (gb << 4)) & 0x0f0f0f0fu;     \
            gb <<= 4 * hi; tb <<= 4 * hi; gb |= (unsigned)__shfl_xor((int)gb, 32); tb |= (unsigned)__shfl_xor((int)tb, 32); \
            if (hi == 0) { Gw[c * 512 + (KT)] = gb; Tw[c * 512 + (KT)] = tb; } } while (0)
            KFrag Ka, Kb;
            if (wave < qb32) { load_k(ws, wave, c, hi, Ka); load_k(ws, wave + 8 < qb32 ? wave + 8 : wave, c, hi, Kb); }
#pragma unroll 1
            for (int kt = wave; kt < qb32; kt += 16) { const bool has2 = kt + 8 < qb32;
                f32x16 sa, sb; score_tile2(Ka, Kb, qlds, wv, sa, sb);
                { const int kn = kt + 16 < qb32 ? kt + 16 : kt, kn2 = kn + 8 < qb32 ? kn + 8 : kn; load_k(ws, kn, c, hi, Ka); load_k(ws, kn2, c, hi, Kb); }
                MASK_TILE_F(sa, kt, false);
                if (has2) MASK_TILE_F(sb, kt + 8, false); }
            if (wave == (qb32 & 7)) { load_k(ws, qb32, c, hi, Ka); f32x16 sa; score_tile1(Ka, qlds, wv, sa); MASK_TILE_F(sa, qb32, true); }
#undef MASK_TILE_F
            LDS_WAIT(); __syncthreads();
#pragma unroll 1
            for (int i = 0; i < 4; ++i) { const int cq = 4 * wave + i; const unsigned n = lcnt[cq], rk = need[cq];
                if (n > LCAP) { if (lane == 0) slowf[2] = 1u; }
                else { v2u e = (v2u){0u, 0u}; if (lane < (int)n) e = *(const LAS v2u*)(lists + 2 * (cq * LCAP + lane));
                    const unsigned long long ev = ((unsigned long long)e.y << 32) | e.x; unsigned above = 0u;
#pragma unroll 1
                    for (unsigned j = 0; j < n; ++j) { const unsigned long long ej = ((unsigned long long)(unsigned)__builtin_amdgcn_readlane((int)e.y, (int)j) << 32) | (unsigned)__builtin_amdgcn_readlane((int)e.x, (int)j);
                        above += ej > ev ? 1u : 0u; }
                    if (lane < (int)n && above < rk) { const unsigned sidx = 16383u - e.x;
                        __hip_atomic_fetch_or(Gw + cq * 512 + (sidx >> 5), 1u << (sidx & 31u), __ATOMIC_RELAXED, __HIP_MEMORY_SCOPE_WORKGROUP); }
                    if (lane == 0) need[cq] = rk > n ? rk - n : 0u; } }
            LDS_WAIT(); __syncthreads();
            fast = __builtin_amdgcn_readfirstlane((int)slowf[2]) == 0;
        }
    } else { LDS_WAIT(); __syncthreads(); }
#ifndef PROBE_IDXFB
#define PROBE_IDXFB 1
#endif
#ifndef PROBE_IDXFB_MASK
#define PROBE_IDXFB_MASK 7
#endif
    const int slow_reason = 7;
    if (!fast)
#pragma unroll 1
    for (int fbrep_ = 0, fbn_ = rep_count((sel_needed && (slow_reason & PROBE_IDXFB_MASK)) ? PROBE_IDXFB : 1); fbrep_ < fbn_; ++fbrep_) {
        __syncthreads();
        if (tid < 32) { sta[tid] = 0u; need[tid] = (unsigned)TOPK; }
        const f32x4 wv = load_wv(ws, q);
        const bool all = q < TOPK; lhist_t hrow = hist + c * 1024;
#pragma unroll 1
        for (int mode = sel_needed ? 0 : 2; mode < 3; ++mode) {
            if (mode < 2) {
#pragma unroll 1
                for (int i = 0; i < 64; ++i) hist[tid + 512 * i] = 0u; }
            LDS_WAIT(); __syncthreads();
            unsigned a = sta[c]; if (all) a = 0u;
#pragma unroll 1
            for (int kt = wave; kt <= qb32; kt += 8) { KFrag Ka; load_k(ws, kt, c, hi, Ka); f32x16 sa; score_tile1(Ka, qlds, wv, sa);
                unsigned gb = 0u, tb = 0u;
#pragma unroll
                for (int r = 15; r >= 0; --r) { const int c0 = (r & 3) + 8 * (r >> 2); const unsigned k22 = skey22(sa[r]); const bool ok = 32 * kt + c0 + 4 * hi <= q;
                    if (mode == 2) { gb = gb + gb + ((ok && (all || k22 > a)) ? 1u : 0u); tb = tb + tb + ((ok && !all && k22 == a) ? 1u : 0u); }
                    else { const unsigned bin = mode == 0 ? k22 >> 11 : k22 & 2047u; const unsigned inc = (ok && (mode == 0 || (k22 >> 11) == a)) ? 1u : 0u;
                        __hip_atomic_fetch_add(hrow + ((bin >> 1) ^ (unsigned)c), inc << ((bin & 1u) * 16u), __ATOMIC_RELAXED, __HIP_MEMORY_SCOPE_WORKGROUP); }
                    if ((r & 3) == 0) __builtin_amdgcn_sched_barrier(0); }
                if (mode == 2) { gb = (gb | (gb << 8)) & 0x00ff00ffu; gb = (gb | (gb << 4)) & 0x0f0f0f0fu; tb = (tb | (tb << 8)) & 0x00ff00ffu; tb = (tb | (tb << 4)) & 0x0f0f0f0fu;
                    gb <<= 4 * hi; tb <<= 4 * hi; gb |= (unsigned)__shfl_xor((int)gb, 32); tb |= (unsigned)__shfl_xor((int)tb, 32);
                    if (hi == 0) { Gw[c * 512 + kt] = gb; Tw[c * 512 + kt] = tb; } } }
            LDS_WAIT(); __syncthreads();
            if (mode < 2) {
#pragma unroll 1
                for (int i = 0; i < 4; ++i) { const int cq = 4 * wave + i; unsigned nn; const int bin = select_bin(hist + cq * 1024, cq, lane, need[cq], nn);
                    if (lane == 0 && bin >= 0) { sta[cq] = mode == 0 ? (unsigned)bin : ((sta[cq] << 11) | (unsigned)bin); need[cq] = nn; } }
                LDS_WAIT(); __syncthreads(); }
        }
    }
    LDS_WAIT(); __syncthreads();
    const int kt_end = 8 * (q0 / 256 + 1);
    GAS unsigned* MK = (GAS unsigned*)(F.ws + WS_MASK);
#pragma unroll 1
    for (int i = 0; i < 4; ++i) { const int cq = 4 * wave + i; const unsigned r = need[cq]; unsigned base = 0u;
#pragma unroll 1
        for (int k0 = 0; k0 < kt_end; k0 += 64) { const int kt = k0 + lane; const bool live = kt <= qb32;
            const unsigned g = live ? Gw[cq * 512 + kt] : 0u, t = live ? Tw[cq * 512 + kt] : 0u; const unsigned p = __builtin_popcount(t);
            unsigned C = p;
#pragma unroll
            for (int o = 1; o < 64; o <<= 1) { const unsigned v = __shfl_up(C, o); C += (lane >= o) ? v : 0u; }
            const unsigned before = base + C - p;
            unsigned keep = t;
            if (before >= r) keep = 0u;
            else if (before + p > r) { unsigned left = r - before, m = 0u, tt = t;
#pragma unroll 1
                while (left) { const unsigned lowbit = tt & (0u - tt); m |= lowbit; tt ^= lowbit; --left; }
                keep = m; }
            if (kt < kt_end) MK[((size_t)(kt >> 1) * HROWS + (q0 + cq)) * 2 + (kt & 1)] = g | keep;
            base += __shfl(C, 63); } }
    __syncthreads();
}
}

namespace att {
constexpr int D = 128, NW = 8, QBLK = 32, KVBLK = 64, QB = 256, STR = 768;
constexpr float SCALE = 0.08838834764831845f, THR = 8.f;
constexpr int SHM_V = KVBLK * D * 2, SHM_K = KVBLK * D * 2;
constexpr int ATT_LDS = 2 * SHM_V + 2 * SHM_K + NW * 64 * 4;
constexpr int BIAS_OFF = ATT_LDS;
constexpr int QL_OFF = ATT_LDS + 3200;
typedef short s16x4 __attribute__((ext_vector_type(4)));
typedef LAS char* lp_t;
#define KSWZ(row, colB) ((row) * 256 + ((colB) ^ (((row) & 7) << 4)))
#define SBAR() __builtin_amdgcn_sched_barrier(0)
__device__ __forceinline__ int v_st(int k, int c) { const int kk = (k & ~0xC) | ((k & 4) << 1) | ((k & 8) >> 1); return ((kk >> 3) * 4 + (c >> 5)) * 512 + ((kk & 7) * 32 + (c & 31)) * 2; }
__device__ __forceinline__ int v_rd_base(int lane) { return ((lane & 3) << 3) | (((lane >> 2) & 3) << 6) | (((lane >> 4) & 1) << 5) | (((lane >> 5) & 1) << 8); }
constexpr int v_rd_off(int d0, int ks, int half) { return d0 * 512 + ks * 4096 + half * 2048; }
__device__ __forceinline__ int crow(int r, int hi) { return (r & 3) + 8 * (r >> 2) + 4 * hi; }
__device__ __forceinline__ unsigned cvtpk(float lo, float hi) { unsigned r; asm volatile("v_cvt_pk_bf16_f32 %0, %1, %2" : "=v"(r) : "v"(lo), "v"(hi)); return r; }
__device__ __forceinline__ bf16x8 load8(const unsigned short* p) { return *reinterpret_cast<const bf16x8*>(p); }

__device__ __forceinline__ void partialSM(f32x16& p0, f32x16& p1, float& m_reg, float& mn, float& alpha) {
    float pmax = p0[0]; for (int r = 1; r < 16; ++r) pmax = fmaxf(pmax, p0[r]); for (int r = 0; r < 16; ++r) pmax = fmaxf(pmax, p1[r]);
    { auto rr = __builtin_amdgcn_permlane32_swap(__float_as_uint(pmax), __float_as_uint(pmax), false, false);
      pmax = fmaxf(__uint_as_float(rr[0]), __uint_as_float(rr[1])); }
    constexpr float C2 = 1.4426950408889634f * SCALE;
    if (__builtin_expect(__all((pmax - m_reg) * SCALE <= THR), 1)) { mn = m_reg; alpha = 1.f; }
    else { mn = fmaxf(m_reg, pmax); alpha = __builtin_amdgcn_exp2f((m_reg - mn) * C2); m_reg = mn; }
    const float mnL = -mn * C2;
    for (int r = 0; r < 16; ++r) p0[r] = fmaf(p0[r], C2, mnL); for (int r = 0; r < 16; ++r) p1[r] = fmaf(p1[r], C2, mnL);
    for (int r = 0; r < 16; ++r) p0[r] = __builtin_amdgcn_exp2f(p0[r]);
}
__device__ __forceinline__ void finishSM(f32x16& p0, f32x16& p1, float alpha, float& l_reg, bf16x8& pa0, bf16x8& pa1, bf16x8& pa2, bf16x8& pa3) {
    for (int r = 0; r < 16; ++r) p1[r] = __builtin_amdgcn_exp2f(p1[r]);
    float ps = 0; for (int r = 0; r < 16; ++r) ps += p0[r]; for (int r = 0; r < 16; ++r) ps += p1[r];
    { auto rr = __builtin_amdgcn_permlane32_swap(__float_as_uint(ps), __float_as_uint(ps), false, false);
      ps = __uint_as_float(rr[0]) + __uint_as_float(rr[1]); }
    l_reg = l_reg * alpha + ps;
#define PK4(P, B_, OUT) do { unsigned a0 = cvtpk(P[B_+0], P[B_+1]), a1 = cvtpk(P[B_+2], P[B_+3]);                          \
        unsigned b0 = cvtpk(P[B_+4], P[B_+5]), b1 = cvtpk(P[B_+6], P[B_+7]);                                             \
        auto r0 = __builtin_amdgcn_permlane32_swap(a0, b0, false, false); auto r1 = __builtin_amdgcn_permlane32_swap(a1, b1, false, false); \
        v4u w = {r0[0], r1[0], r0[1], r1[1]}; OUT = *reinterpret_cast<bf16x8*>(&w); } while (0)
    PK4(p0, 0, pa0); PK4(p0, 8, pa1); PK4(p1, 0, pa2); PK4(p1, 8, pa3);
#undef PK4
}
template <int KB>
__device__ __forceinline__ void qkt(f32x16& p0, f32x16& p1, const LAS char* K_lds, int r32, int hi, const bf16x8* qr) {
    p0 = f32x16{}; p1 = f32x16{};
    const LAS char* kb[4];
#pragma unroll
    for (int dd = 0; dd < 4; ++dd) kb[dd] = K_lds + KB * SHM_K + KSWZ(r32, (dd * 16 + hi * 8) * 2);
#pragma unroll
    for (int d0 = 0; d0 < 8; ++d0) { const LAS char* a = kb[d0 & 3] + (d0 >> 2) * 128;
        bf16x8 b0 = *reinterpret_cast<const LAS bf16x8*>(a);
        bf16x8 b1 = *reinterpret_cast<const LAS bf16x8*>(a + 32 * 256);
        p0 = __builtin_amdgcn_mfma_f32_32x32x16_bf16(b0, qr[d0], p0, 0, 0, 0);
        p1 = __builtin_amdgcn_mfma_f32_32x32x16_bf16(b1, qr[d0], p1, 0, 0, 0); }
}
template <int VB>
__device__ __forceinline__ void pv_tile(f32x16* o, int vb0, bf16x8 pa0, bf16x8 pa1, bf16x8 pa2, bf16x8 pa3) {
#define TRRD(dst, off) asm volatile("ds_read_b64_tr_b16 %0, %1 offset:%2" : "=&v"(dst) : "v"(vb0), "i"(off) : "memory")
#define PV_D0(d0) do { s16x4 l0, l1, l2, l3, h0, h1, h2, h3; constexpr int b_ = VB * SHM_V + v_rd_off(d0, 0, 0); \
        TRRD(l0, b_); TRRD(h0, b_ + 2048); TRRD(l1, b_ + 4096); TRRD(h1, b_ + 6144); TRRD(l2, b_ + 8192); TRRD(h2, b_ + 10240); TRRD(l3, b_ + 12288); TRRD(h3, b_ + 14336); \
        asm volatile("s_waitcnt lgkmcnt(0)" ::: "memory"); SBAR();   \
        o[d0] = __builtin_amdgcn_mfma_f32_32x32x16_bf16(pa0, (bf16x8){l0[0], l0[1], l0[2], l0[3], h0[0], h0[1], h0[2], h0[3]}, o[d0], 0, 0, 0);   \
        o[d0] = __builtin_amdgcn_mfma_f32_32x32x16_bf16(pa1, (bf16x8){l1[0], l1[1], l1[2], l1[3], h1[0], h1[1], h1[2], h1[3]}, o[d0], 0, 0, 0);   \
        o[d0] = __builtin_amdgcn_mfma_f32_32x32x16_bf16(pa2, (bf16x8){l2[0], l2[1], l2[2], l2[3], h2[0], h2[1], h2[2], h2[3]}, o[d0], 0, 0, 0);   \
        o[d0] = __builtin_amdgcn_mfma_f32_32x32x16_bf16(pa3, (bf16x8){l3[0], l3[1], l3[2], l3[3], h3[0], h3[1], h3[2], h3[3]}, o[d0], 0, 0, 0); } while (0)
    PV_D0(0); PV_D0(1); PV_D0(2); PV_D0(3);
#undef PV_D0
#undef TRRD
}
__device__ __forceinline__ void apply_mask(f32x16& p0, f32x16& p1, v2u mw, int hi) {
    const int m0 = (int)(mw.x >> (4 * hi)), m1 = (int)(mw.y >> (4 * hi)); const unsigned NEG = 0xff800000u;
#pragma unroll
    for (int r = 0; r < 16; ++r) { const int c = (r & 3) + 8 * (r >> 2);
        const unsigned a0 = (unsigned)((m0 << (31 - c)) >> 31), a1 = (unsigned)((m1 << (31 - c)) >> 31);
        p0[r] = __uint_as_float((__float_as_uint(p0[r]) & a0) | (NEG & ~a0)); p1[r] = __uint_as_float((__float_as_uint(p1[r]) & a1) | (NEG & ~a1)); }
}
__device__ __forceinline__ void bias_tile(f32x16& p0, f32x16& p1, const GAS char* ws, unsigned pko  , int pq, const LAS float* bT, int hi) {
    const unsigned ho = pko + (unsigned)hi * 16u;
#pragma unroll
    for (int r = 0; r < 16; ++r) { const int c = (r & 3) + 8 * (r >> 2);
        int d0 = pq - *(const GAS int*)(ws + (unsigned)(ho + c * 4)); d0 = d0 < 0 ? 0 : (d0 > 128 ? 128 : d0); p0[r] += bT[d0];
        int d1 = pq - *(const GAS int*)(ws + (unsigned)(ho + (c + 32) * 4)); d1 = d1 < 0 ? 0 : (d1 > 128 ? 128 : d1); p1[r] += bT[d1];
        if ((r & 3) == 3) asm volatile("" ::: "memory"); }
}
struct BlockRef { int P0, h, t0, nt, pidx; };
struct Seam { bf16x8 qr[8]; bf16x8 st_v0, st_v1, st_k0, st_k1; };
typedef const GAS char* gp_t;
#define VMW() asm volatile("s_waitcnt vmcnt(0)" ::: "memory")
#define LD8W(off) (*reinterpret_cast<const GAS bf16x8*>(ws + (unsigned)(off)))
#define SLOAD_H(ko_, k0) do { const unsigned so0_ = so0, so1_ = so1; \
        const unsigned t_ = (unsigned)(k0) * (STR * 2u) + (ko_); \
        S.st_v0 = LD8W(t_ + (unsigned)(WS_VA - WS_KA) + so0_); S.st_v1 = LD8W(t_ + (unsigned)(WS_VA - WS_KA) + so1_); S.st_k0 = LD8W(t_ + so0_); S.st_k1 = LD8W(t_ + so1_); } while (0)
#define SWRITE_HK(bf) do { const int kws_ = kws; \
        *(LAS bf16x8*)(K_lds + (bf) * SHM_K + kws_) = S.st_k0; *(LAS bf16x8*)(K_lds + (bf) * SHM_K + kws_ + 32 * 256) = S.st_k1; } while (0)
#define SWRITE_HV(bf) do { const int vs0_ = vst0, vs1_ = vst1; \
        *(LAS bf16x8*)(V_lds + (bf) * SHM_V + vs0_) = S.st_v0; *(LAS bf16x8*)(V_lds + (bf) * SHM_V + vs1_) = S.st_v1; } while (0)
#define SWRITE_H(bf) do { SWRITE_HV(bf); SWRITE_HK(bf); } while (0)
__device__ __forceinline__ unsigned q_off(const BlockRef& r) { return (unsigned)WS_QA + (unsigned)(r.P0 * STR + r.h * 128) * 2u; }
__device__ __forceinline__ unsigned k_off(const BlockRef& r) { return (unsigned)WS_KA + (unsigned)(r.h * 128) * 2u; }
__device__ __forceinline__ void prime(const BlockRef& cur, gp_t ws, lp_t lds, Seam& S, int tid) {
    const int wid = __builtin_amdgcn_readfirstlane(tid >> 6), lane = tid & 63, r32 = lane & 31, hi = lane >> 5;
    lp_t K_lds = lds + 2 * SHM_V;
    const unsigned qo = (unsigned)((wid * QBLK + r32) * STR + hi * 8) * 2u;
    const unsigned so0 = (unsigned)((tid >> 4) * STR + (tid & 15) * 8) * 2u, so1 = so0 + 32u * STR * 2u; const int kws = KSWZ(tid >> 4, (tid & 15) * 16);
    const unsigned qb_ = q_off(cur) + qo, ko_ = k_off(cur);
#pragma unroll
    for (int d0 = 0; d0 < 8; ++d0) S.qr[d0] = LD8W(qb_ + d0 * 32);
    SLOAD_H(ko_, cur.t0 * KVBLK); VMW(); SWRITE_HK(0);
    __syncthreads();
}
__device__ __forceinline__ void block(const BlockRef& cur, const BlockRef& nxt, gp_t ws, lp_t lds, Seam& S, int b, int tid) {
    const int wid = __builtin_amdgcn_readfirstlane(tid >> 6), lane = tid & 63, r32 = lane & 31, hi = lane >> 5;
    const int NT = cur.nt, T0 = cur.t0, NTA = cur.P0 / KVBLK + QB / KVBLK;
    const int qrow = cur.P0 + wid * QBLK + r32;
    lp_t V_lds = lds; lp_t K_lds = lds + 2 * SHM_V;
    LAS float* wsf = (LAS float*)(lds + 2 * SHM_V + 2 * SHM_K) + wid * 64; LAS float* li_l = wsf; LAS float* al_l = wsf + 32;
    const LAS float* bT = (const LAS float*)(lds + BIAS_OFF) + cur.h * 132;
    float m_reg = -1e30f, l_reg = 0; f32x16 o[4]; o[0] = zero16(); o[1] = zero16(); o[2] = zero16(); o[3] = zero16();
    const int vb0 = (int)(unsigned)(uintptr_t)V_lds + v_rd_base(lane);
    const unsigned so0 = (unsigned)((tid >> 4) * STR + (tid & 15) * 8) * 2u, so1 = so0 + 32u * STR * 2u; const int kws = KSWZ(tid >> 4, (tid & 15) * 16), vst0 = v_st(tid >> 4, (tid & 15) * 8), vst1 = v_st(32 + (tid >> 4), (tid & 15) * 8);
    const unsigned ko_ = k_off(cur);
    const unsigned pbo = (unsigned)WS_POS + (unsigned)b * (SEQ * 4u);
    const int pq = *(const GAS int*)(ws + (unsigned)(pbo + (unsigned)qrow * 4u));
    const int qmin = *(const GAS int*)(ws + (unsigned)((unsigned)WS_KMAX + (unsigned)(1024 + b * 512 + (cur.P0 >> 5) + wid) * 4u));
    const unsigned mo = (unsigned)WS_MASK + (unsigned)qrow * 8u;
    int nearfirst = NTA;
    { const unsigned kmo = (unsigned)WS_KMAX + (unsigned)b * 1024u;
#pragma unroll 1
      for (int t0 = 0; t0 < NTA; t0 += 64) { const int t_ = t0 + lane; const int km = *(const GAS int*)(ws + (unsigned)(kmo + (unsigned)(t_ < NTA ? t_ : NTA - 1) * 4u));
          const unsigned long long bal = __ballot(t_ < NTA && qmin - km < 128);
          if (bal) { nearfirst = t0 + (int)__builtin_ctzll(bal); break; } } }
#define MLOAD(t) (*(const GAS v2u*)(ws + (unsigned)((unsigned)(T0 + (t)) * (HROWS * 8u) + mo)))
#define RESC(a) do { if (__any((a) < 1.f)) { if (hi == 0) al_l[r32] = (a); asm volatile("s_waitcnt lgkmcnt(0)" ::: "memory");              \
                     for (int d_ = 0; d_ < 4; ++d_) for (int r = 0; r < 16; ++r) o[d_][r] *= al_l[crow(r, hi)]; } } while (0)
#define KBASE(t) ((T0 + (t)) * KVBLK)
#define MASKT(P0_, P1_, t, MW) do { if (T0 + (t) >= nearfirst) bias_tile(P0_, P1_, ws, pbo + (unsigned)KBASE(t) * 4u, pq, bT, hi); apply_mask(P0_, P1_, MW, hi); } while (0)
    f32x16 pA0, pA1, pB0, pB1; float mnA, mnB, alA, alB; bf16x8 pa0, pa1, pa2, pa3;
    v2u mwc = MLOAD(0);
    SWRITE_HV(0); SBAR();
    if (NT > 1) { SLOAD_H(ko_, KBASE(1)); }
    SBAR(); qkt<0>(pA0, pA1, K_lds, r32, hi, S.qr);
    MASKT(pA0, pA1, 0, mwc); partialSM(pA0, pA1, m_reg, mnA, alA);
    if (NT > 1) { VMW(); SWRITE_H(1); }
    __syncthreads();
#define HALF_STEP(PX0, PX1, mnX, alX, PY0, PY1, alY, t, KB, VB, SB) do {                                                      \
        mwc = MLOAD(t);                                                                                                        \
        SBAR(); qkt<KB>(PX0, PX1, K_lds, r32, hi, S.qr);                                                                      \
        finishSM(PY0, PY1, alY, l_reg, pa0, pa1, pa2, pa3); SBAR();                                                           \
        if ((t) + 1 < NT) { SLOAD_H(ko_, KBASE((t) + 1)); SBAR(); }                                                           \
        pv_tile<VB>(o, vb0, pa0, pa1, pa2, pa3); MASKT(PX0, PX1, (t), mwc); partialSM(PX0, PX1, m_reg, mnX, alX);             \
        __syncthreads();                                                                                                      \
        if ((t) + 1 < NT) { VMW(); SWRITE_H(SB); }                                                                            \
        RESC(alX); __syncthreads(); } while (0)
#pragma unroll 1
    for (int t = 1; t + 1 < NT; t += 2) {
        HALF_STEP(pB0, pB1, mnB, alB, pA0, pA1, alA, t, 1, 0, 0);
        HALF_STEP(pA0, pA1, mnA, alA, pB0, pB1, alB, t + 1, 0, 1, 1);
    }
    mwc = MLOAD(NT - 1);
    SBAR(); qkt<1>(pB0, pB1, K_lds, r32, hi, S.qr); SBAR();
    { const unsigned kn_ = k_off(nxt); SLOAD_H(kn_, nxt.t0 * KVBLK); } SBAR();
    int lane_t = lane; asm volatile("" : "+v"(lane_t));
    { const unsigned qn_ = q_off(nxt) + (unsigned)((wid * QBLK + (lane_t & 31)) * STR + (lane_t >> 5) * 8) * 2u;
#pragma unroll
      for (int d0 = 0; d0 < 8; ++d0) S.qr[d0] = LD8W(qn_ + d0 * 32); }
    SBAR();
    finishSM(pA0, pA1, alA, l_reg, pa0, pa1, pa2, pa3); SBAR();
    pv_tile<0>(o, vb0, pa0, pa1, pa2, pa3);
    MASKT(pB0, pB1, NT - 1, mwc); partialSM(pB0, pB1, m_reg, mnB, alB); __syncthreads(); RESC(alB);
    finishSM(pB0, pB1, alB, l_reg, pa0, pa1, pa2, pa3); SBAR(); pv_tile<1>(o, vb0, pa0, pa1, pa2, pa3);
    SBAR(); VMW(); SWRITE_HK(0); SBAR();
    if (cur.pidx >= 0) {
        const unsigned po = (unsigned)WS_APART + (unsigned)cur.pidx * (QB * 128u * 4u) + (unsigned)((wid * QBLK + 4 * (lane_t >> 5)) * 128 + (lane_t & 31)) * 4u;
#pragma unroll
        for (int r = 0; r < 16; ++r) { const int orc = (r & 3) + 8 * (r >> 2);
#pragma unroll
            for (int d0 = 0; d0 < 4; ++d0) *(GAS float*)((GAS char*)ws + (unsigned)(po + (unsigned)(orc * 128 + d0 * 32) * 4u)) = o[d0][r]; }
        if ((lane_t >> 5) == 0) { typedef float f2_t __attribute__((ext_vector_type(2)));
            *(GAS f2_t*)((GAS char*)ws + (unsigned)((unsigned)WS_AML + (unsigned)(cur.pidx * QB + wid * QBLK + (lane_t & 31)) * 8u)) = (f2_t){m_reg, l_reg}; }
    } else {
    if (hi == 0) li_l[r32] = l_reg; asm volatile("s_waitcnt lgkmcnt(0)" ::: "memory");
    float rli[16];
#pragma unroll
    for (int r = 0; r < 16; ++r) rli[r] = __builtin_amdgcn_rcpf(li_l[crow(r, hi)]);
    const unsigned oo = (unsigned)WS_OBR + (unsigned)HROWS * 768u * 2u + (unsigned)((cur.P0 + wid * QBLK + 4 * (lane_t >> 5)) * STR + cur.h * 128 + (lane_t & 31)) * 2u;
#pragma unroll
    for (int r = 0; r < 16; ++r) { const int orc = (r & 3) + 8 * (r >> 2);
#pragma unroll
        for (int d0 = 0; d0 < 4; ++d0) { const float v = o[d0][r] * rli[r];
            const float vn = __uint_as_float((unsigned)__builtin_amdgcn_update_dpp(0, (int)__float_as_uint(v), 0xB1, 0xF, 0xF, false));
            if ((r32 & 1) == 0) *(GAS unsigned*)((GAS char*)ws + (unsigned)(oo + (unsigned)(orc * STR + d0 * 32) * 2u)) = cvtpk(v, vn); } }
    }
    __syncthreads();
#undef MLOAD
#undef RESC
#undef KBASE
#undef MASKT
#undef HALF_STEP
}
#undef LD8W
#undef VMW
#undef SLOAD_H
#undef SWRITE_HK
#undef SWRITE_HV
#undef SWRITE_H
}

constexpr int ATT_NIT = 480, ATT_QSPLIT = 48;
__device__ __forceinline__ att::BlockRef att_ref(int i) { att::BlockRef r; int qb, h, part = -1;
    if (i < 96) { qb = 47 - i / 6; h = i % 6; }
    else if (i < 336) { const int j = i - 96, p = j / 30, q = j % 30;
        if (q < 12) { qb = 63 - 2 * p; part = q / 6; h = q % 6; } else if (q < 18) { qb = 31 - p; h = q - 12; } else { qb = 62 - 2 * p; part = (q - 18) / 6; h = (q - 18) % 6; } }
    else { const int j = i - 336; qb = 23 - j / 6; h = j % 6; }
    r.P0 = qb * 256; r.h = h; const int nta = 4 * (qb + 1);
    if (part < 0) { r.t0 = 0; r.nt = nta; r.pidx = -1; } else { r.t0 = part * (nta / 2); r.nt = nta / 2; r.pidx = ((qb - ATT_QSPLIT) * 6 + h) * 2 + part; }
    return r; }
__device__ __forceinline__ int att_item(int k, int G, int c) { return (k & 1) ? (k + 1) * G - 1 - c : k * G + c; }
__device__ __forceinline__ int att_head_item(int h, int j) {
    if (j < 16) return 6 * j + h;
    if (j < 56) { const int jj = j - 16, p = jj / 5, q5 = jj % 5; const int q = q5 == 0 ? h : q5 == 1 ? 6 + h : q5 == 2 ? 12 + h : q5 == 3 ? 18 + h : 24 + h; return 96 + 30 * p + q; }
    return 336 + 6 * (j - 56) + h;
}
__device__ __forceinline__ int att_xcd_item(int x, int n) { const int g = 3 * x + n % 3, h = g >> 2, j = (g & 3) + 4 * (n / 3); return att_head_item(h, j); }
__device__ __forceinline__ void p_attn(Frame& F0, int b) {
    Frame F = F0; GAS unsigned char* wsg_ = (GAS unsigned char*)F.ws; F.tid = F.wave * 64 + lane_id(); asm volatile("" : "+v"(F.tid), "+s"(wsg_), "+s"(F.vcu), "+s"(F.G)); F.lane = F.tid & 63;
    att::gp_t ws = (att::gp_t)wsg_;
    att::lp_t lds = (att::lp_t)F.lds;
    { LAS float* bT = (LAS float*)(lds + att::BIAS_OFF);
        for (int i = F.tid; i < 6 * 129; i += NTHR) { const int h = i / 129, d = i % 129;
            const int bk = d < 16 ? d : 16 + (d >= 19) + (d >= 21) + (d >= 24) + (d >= 27) + (d >= 31) + (d >= 35) + (d >= 40) + (d >= 46) + (d >= 52) + (d >= 59) + (d >= 67) + (d >= 77) + (d >= 87) + (d >= 99) + (d >= 113);
            bT[h * 132 + d] = (F.rel[bk * 6 + h] - F.rel[31 * 6 + h]) * (1.0f / att::SCALE); } }
    LDS_WAIT(); __syncthreads();
    const bool xcd = F.G == 256; const int x = F.vcu >> 5, rk = F.vcu & 31;
    int k = 0, i = xcd ? att_xcd_item(x, rk) : att_item(0, F.G, F.vcu);
    if (i >= ATT_NIT) return;
    att::BlockRef cur = att_ref(i); att::Seam S;
    att::prime(cur, ws, lds, S, F.tid);
#pragma unroll 1
    for (;;) { int in;
        if (xcd) in = (k == 0 && 63 - rk < 60) ? att_xcd_item(x, 63 - rk) : ATT_NIT; else in = att_item(k + 1, F.G, F.vcu);
        const bool last = in >= ATT_NIT;
        const att::BlockRef nxt = last ? cur : att_ref(in);
        att::block(cur, nxt, ws, lds, S, b, F.tid);
        if (last) break;
        cur = nxt; ++k; }
}
__device__ __forceinline__ void p_attn_combine(Frame& F0) {
    Frame F = F0; { GAS unsigned char* wsg_ = (GAS unsigned char*)F.ws; F.tid = F.wave * 64 + lane_id(); asm volatile("" : "+v"(F.tid), "+s"(wsg_), "+s"(F.vcu), "+s"(F.G)); F.lane = F.tid & 63; F.ws = (unsigned char*)wsg_; }
    typedef float f2_t __attribute__((ext_vector_type(2)));
    const float* AP = (const float*)(F.ws + WS_APART); const f2_t* ML = (const f2_t*)(F.ws + WS_AML); bf16* OA = (bf16*)(F.ws + WS_OBR) + (size_t)HROWS * 768;
    constexpr float C2 = 1.4426950408889634f * att::SCALE;
    const int total = 96 * 256 * 16;
#pragma unroll 1
    for (int i = F.vcu * NTHR + F.tid; i < total; i += F.G * NTHR) { const int c8 = (i & 15) * 8, row = (i >> 4) & 255, blk = i >> 12;
        const f2_t a = ML[(size_t)(2 * blk) * 256 + row], bq = ML[(size_t)(2 * blk + 1) * 256 + row];
        const float m = fmaxf(a.x, bq.x), f0 = __builtin_amdgcn_exp2f((a.x - m) * C2), f1 = __builtin_amdgcn_exp2f((bq.x - m) * C2), inv = 1.0f / (a.y * f0 + bq.y * f1);
        const f32x4* p0 = (const f32x4*)(AP + ((size_t)(2 * blk) * 256 + row) * 128 + c8); const f32x4* p1 = (const f32x4*)(AP + ((size_t)(2 * blk + 1) * 256 + row) * 128 + c8);
        const f32x4 x0 = (p0[0] * f0 + p1[0] * f1) * inv, x1 = (p0[1] * f0 + p1[1] * f1) * inv;
        const int qb = ATT_QSPLIT + blk / 6, h = blk % 6;
        *(v4u*)(OA + (size_t)(qb * 256 + row) * 768 + h * 128 + c8) = pack8bf(x0, x1); }
}

constexpr int PT128 = 136, PT64 = 72;
#define MFMA16(a, b, c) __builtin_amdgcn_mfma_f32_16x16x32_bf16((a), (b), (c), 0, 0, 0)
__device__ __forceinline__ bf16x8 ldsfrag(const LAS unsigned short* base, int row, int pitch, int k) { return *(const LAS bf16x8*)(base + row * pitch + k); }
__device__ __forceinline__ float log2_gamma(int h) {
    const float x = __builtin_amdgcn_exp2f(-5.0f - (float)h);
    return -x * (1.0f + x * (0.5f + x * (0.33333334f + x * (0.25f + x * (0.2f + x * 0.16666667f))))) * 1.4426950408889634f;
}
__device__ __forceinline__ void unpack8(const v4u w, float (&f)[8]) { f[0] = bflo(w.x); f[1] = bfhi(w.x); f[2] = bflo(w.y); f[3] = bfhi(w.y); f[4] = bflo(w.z); f[5] = bfhi(w.z); f[6] = bflo(w.w); f[7] = bfhi(w.w); }
__device__ __forceinline__ v4u pack8f(const float (&f)[8]) { v4u w; w.x = pk2(f[0], f[1]); w.y = pk2(f[2], f[3]); w.z = pk2(f[4], f[5]); w.w = pk2(f[6], f[7]); return w; }

__device__ __forceinline__ void mix_sg_item(const Frame& F, const float* sgn, const float* sgw, const float* sgb, int n, int g) {
    LAS unsigned short* Wm = (LAS unsigned short*)(F.lds);
    LAS unsigned short* vnT = (LAS unsigned short*)(F.lds + 34816);
    LAS unsigned short* strip = (LAS unsigned short*)(F.lds + 69632) + F.wave * (16 * PT128);
    LAS float* rs = (LAS float*)(F.lds + 104448);
    const bf16* VS = (const bf16*)(F.ws + WS_VS); const bf16* US = (const bf16*)(F.ws + WS_US); bf16* OS = (bf16*)(F.ws + WS_OBR) + (size_t)2 * HROWS * 768;
    int lane_ = lane_id();
    const int r0 = n * 128, lane = lane_, w = F.wave, tid = w * 64 + lane, fr = lane & 15, fq = lane >> 4;
#pragma unroll 4
    for (int i = 0; i < 16; ++i) { const int t = w * 16 + i; const v4u x = *(const v4u*)(VS + (size_t)(r0 + t) * 512 + lane * 8); float f[8]; unpack8(x, f); float ss = 0.f;
#pragma unroll
        for (int j = 0; j < 8; ++j) ss += f[j] * f[j];
        ss = wave_sum(ss); if (lane == 0) rs[t] = 1.0f / sqrtf(ss * (1.0f / 512.0f) + EPS); }
    { const int t = tid >> 2, s0 = (tid & 3) * 32; const float* wr = sgw + ((size_t)g * 128 + t) * 128 + s0;
#pragma unroll
        for (int q = 0; q < 4; ++q) { const f32x4 a = *(const f32x4*)(wr + 8 * q), b = *(const f32x4*)(wr + 8 * q + 4); float f[8] = {a[0], a[1], a[2], a[3], b[0], b[1], b[2], b[3]};
#pragma unroll
            for (int j = 0; j < 8; ++j) f[j] = (s0 + 8 * q + j <= t) ? f[j] : 0.f;
            *(LAS v4u*)(Wm + t * PT128 + s0 + 8 * q) = pack8f(f); } }
    LDS_WAIT(); __syncthreads();
    { const int s = tid >> 2, d0 = (tid & 3) * 32; const float r = rs[s];
#pragma unroll
        for (int q = 0; q < 4; ++q) { const v4u x = *(const v4u*)(VS + (size_t)(r0 + s) * 512 + g * 128 + d0 + 8 * q); float f[8]; unpack8(x, f);
            const f32x4 ga = *(const f32x4*)(sgn + g * 128 + d0 + 8 * q), gb = *(const f32x4*)(sgn + g * 128 + d0 + 8 * q + 4); const float gg[8] = {ga[0], ga[1], ga[2], ga[3], gb[0], gb[1], gb[2], gb[3]};
#pragma unroll
            for (int j = 0; j < 8; ++j) vnT[(d0 + 8 * q + j) * PT128 + s] = (unsigned short)f2bf(f[j] * r * gg[j]); } }
    LDS_WAIT(); __syncthreads();
    f32x4 acc[8];
#pragma unroll
    for (int cb = 0; cb < 8; ++cb) acc[cb] = zero4();
    const int nks = (16 * w + 15) / 32 + 1;
#pragma unroll 1
    for (int ks = 0; ks < nks; ++ks) { const bf16x8 a = ldsfrag(Wm, 16 * w + fr, PT128, 32 * ks + 8 * fq);
#pragma unroll
        for (int cb = 0; cb < 8; ++cb) acc[cb] = MFMA16(a, ldsfrag(vnT, 16 * cb + fr, PT128, 32 * ks + 8 * fq), acc[cb]); }
#pragma unroll
    for (int reg = 0; reg < 4; ++reg) { const int tl = 4 * fq + reg; const float bias = sgb[g * 128 + 16 * w + tl];
#pragma unroll
        for (int cb = 0; cb < 8; ++cb) strip[tl * PT128 + 16 * cb + fr] = (unsigned short)f2bf(acc[cb][reg] + bias); }
    LDS_WAIT(); asm volatile("" ::: "memory");
#pragma unroll
    for (int i = 0; i < 4; ++i) { const int c = lane + 64 * i, row = c >> 4, col = (c & 15) * 8; const size_t r = (size_t)(r0 + 16 * w + row);
        const v4u m = *(const LAS v4u*)(strip + row * PT128 + col); const v4u u = *(const v4u*)(US + r * 512 + g * 128 + col); float fm[8], fu[8]; unpack8(m, fm); unpack8(u, fu);
#pragma unroll
        for (int j = 0; j < 8; ++j) fm[j] *= fu[j];
        *(v4u*)(OS + r * 768 + g * 128 + col) = pack8f(fm); }
    { const int i0 = tid * 2;
#pragma unroll
        for (int i = i0; i < i0 + 2; ++i) { const int row = i >> 3, c8 = (i & 7) * 8; *(v4u*)(OS + (size_t)(r0 + row) * 768 + 512 + g * 64 + c8) = zero4u(); } }
    __syncthreads();
}
__device__ __forceinline__ void mix_r1_item(const Frame& F, int h, int n) {
    LAS unsigned short* VT = (LAS unsigned short*)(F.lds);
    LAS unsigned short* KdT = (LAS unsigned short*)(F.lds + 34816);
    const bf16* QKR = (const bf16*)(F.ws + WS_QKR); const bf16* VR = (const bf16*)(F.ws + WS_VR); float* KV = (float*)(F.ws + WS_KVST) + ((size_t)h * 128 + n) * 8192;
    int lane_ = lane_id();
    const int r0 = n * 128, lane = lane_, w = F.wave, tid = w * 64 + lane, fr = lane & 15, fq = lane >> 4; const float lg2 = log2_gamma(h);
    { const int s = tid >> 2, v0 = (tid & 3) * 32;
#pragma unroll
        for (int q = 0; q < 4; ++q) { const v4u x = *(const v4u*)(VR + (size_t)(r0 + s) * 768 + h * 128 + v0 + 8 * q);
            const unsigned xs[4] = {x.x, x.y, x.z, x.w};
#pragma unroll
            for (int j = 0; j < 4; ++j) { VT[(v0 + 8 * q + 2 * j) * PT128 + s] = (unsigned short)(xs[j] & 0xffffu); VT[(v0 + 8 * q + 2 * j + 1) * PT128 + s] = (unsigned short)(xs[j] >> 16); } } }
    { const int s = tid >> 2, d0 = (tid & 3) * 16; const float dec = __builtin_amdgcn_exp2f((float)(127 - s) * lg2);
#pragma unroll
        for (int q = 0; q < 2; ++q) { const v4u x = *(const v4u*)(QKR + (size_t)(r0 + s) * 768 + 384 + h * 64 + d0 + 8 * q); float f[8]; unpack8(x, f);
#pragma unroll
            for (int j = 0; j < 8; ++j) KdT[(d0 + 8 * q + j) * PT128 + s] = (unsigned short)f2bf(f[j] * dec); } }
    LDS_WAIT(); __syncthreads();
    f32x4 acc[4];
#pragma unroll
    for (int cb = 0; cb < 4; ++cb) acc[cb] = zero4();
#pragma unroll
    for (int ks = 0; ks < 4; ++ks) { const bf16x8 a = ldsfrag(VT, 16 * w + fr, PT128, 32 * ks + 8 * fq);
#pragma unroll
        for (int cb = 0; cb < 4; ++cb) acc[cb] = MFMA16(a, ldsfrag(KdT, 16 * cb + fr, PT128, 32 * ks + 8 * fq), acc[cb]); }
#pragma unroll
    for (int cb = 0; cb < 4; ++cb)
#pragma unroll
        for (int reg = 0; reg < 4; ++reg) KV[(16 * w + 4 * fq + reg) * 64 + 16 * cb + fr] = acc[cb][reg];
    __syncthreads();
}
__device__ __forceinline__ void mix_r2(const Frame& F) {
    float* KVb = (float*)(F.ws + WS_KVST); LAS float* car = (LAS float*)(F.lds);
    const int tid = F.wave * 64 + lane_id(), el = tid & 63, seg = tid >> 6;
#pragma unroll 1
    for (int blk = F.vcu; blk < RH * 8192 / 64; blk += F.G) { const int e0 = blk * 64 + el, h = e0 >> 13, e = e0 & 8191;
        const float cd = __builtin_amdgcn_exp2f(128.0f * log2_gamma(h));
        float* p = KVb + (size_t)h * 128 * 8192 + (size_t)(seg * 16) * 8192 + e; float kv[16];
#pragma unroll
        for (int n = 0; n < 16; ++n) kv[n] = p[(size_t)n * 8192];
        float st = 0.f;
#pragma unroll
        for (int n = 0; n < 16; ++n) { const float t = kv[n]; kv[n] = st; st = st * cd + t; }
        car[seg * 64 + el] = st; LDS_WAIT(); __syncthreads();
        float cin = 0.f, cd16 = cd; cd16 *= cd16; cd16 *= cd16; cd16 *= cd16; cd16 *= cd16;
#pragma unroll 1
        for (int s2 = 0; s2 < seg; ++s2) cin = cin * cd16 + car[s2 * 64 + el];
        float f = 1.f;
#pragma unroll
        for (int n = 0; n < 16; ++n) { p[(size_t)n * 8192] = kv[n] + cin * f; f *= cd; }
        __syncthreads(); }
}
__device__ __forceinline__ void mix_r3_item(const Frame& F, const float* retn, int h, int n) {
    LAS unsigned short* Qs = (LAS unsigned short*)(F.lds);
    LAS unsigned short* Ks = (LAS unsigned short*)(F.lds + 18432);
    LAS unsigned short* VT = (LAS unsigned short*)(F.lds + 36864);
    LAS unsigned short* PT = (LAS unsigned short*)(F.lds + 71680);
    LAS unsigned short* strip = (LAS unsigned short*)(F.lds + 90112) + F.wave * (16 * PT128);
    const bf16* QKR = (const bf16*)(F.ws + WS_QKR); const bf16* VR = (const bf16*)(F.ws + WS_VR); const bf16* GR = (const bf16*)(F.ws + WS_GR); bf16* OR = (bf16*)(F.ws + WS_OBR);
    const float* KV = (const float*)(F.ws + WS_KVST) + ((size_t)h * 128 + n) * 8192;
    int lane_ = lane_id();
    const int r0 = n * 128, lane = lane_, w = F.wave, tid = w * 64 + lane, fr = lane & 15, fq = lane >> 4; const float lg2 = log2_gamma(h);
    { const int s = tid >> 2, d0 = (tid & 3) * 16; const bf16* src = QKR + (size_t)(r0 + s) * 768 + h * 64 + d0;
#pragma unroll
        for (int q = 0; q < 2; ++q) { *(LAS v4u*)(Qs + s * PT64 + d0 + 8 * q) = *(const v4u*)(src + 8 * q); *(LAS v4u*)(Ks + s * PT64 + d0 + 8 * q) = *(const v4u*)(src + 384 + 8 * q); } }
    { const int s = tid >> 2, v0 = (tid & 3) * 32;
#pragma unroll
        for (int q = 0; q < 4; ++q) { const v4u x = *(const v4u*)(VR + (size_t)(r0 + s) * 768 + h * 128 + v0 + 8 * q);
            const unsigned xs[4] = {x.x, x.y, x.z, x.w};
#pragma unroll
            for (int j = 0; j < 4; ++j) { VT[(v0 + 8 * q + 2 * j) * PT128 + s] = (unsigned short)(xs[j] & 0xffffu); VT[(v0 + 8 * q + 2 * j + 1) * PT128 + s] = (unsigned short)(xs[j] >> 16); } } }
    { const int v = tid >> 2, d0 = (tid & 3) * 16; const float* src = KV + v * 64 + d0;
#pragma unroll
        for (int q = 0; q < 2; ++q) *(LAS v4u*)(PT + v * PT64 + d0 + 8 * q) = pack8bf(*(const f32x4*)(src + 8 * q), *(const f32x4*)(src + 8 * q + 4)); }
    LDS_WAIT(); __syncthreads();
    const bf16x8 qa0 = ldsfrag(Qs, 16 * w + fr, PT64, 8 * fq), qa1 = ldsfrag(Qs, 16 * w + fr, PT64, 32 + 8 * fq);
    f32x4 acc[8];
#pragma unroll
    for (int cb = 0; cb < 8; ++cb) { acc[cb] = zero4();
        acc[cb] = MFMA16(qa0, ldsfrag(PT, 16 * cb + fr, PT64, 8 * fq), acc[cb]); acc[cb] = MFMA16(qa1, ldsfrag(PT, 16 * cb + fr, PT64, 32 + 8 * fq), acc[cb]); }
#pragma unroll
    for (int reg = 0; reg < 4; ++reg) { const float f = 0.125f * __builtin_amdgcn_exp2f((float)(16 * w + 4 * fq + reg + 1) * lg2);
#pragma unroll
        for (int cb = 0; cb < 8; ++cb) acc[cb][reg] *= f; }
    const int nb = (w | 1) + 1;
#pragma unroll 1
    for (int cb = 0; cb < nb; ++cb) { f32x4 sa = zero4();
        sa = MFMA16(qa0, ldsfrag(Ks, 16 * cb + fr, PT64, 8 * fq), sa); sa = MFMA16(qa1, ldsfrag(Ks, 16 * cb + fr, PT64, 32 + 8 * fq), sa);
        const int s = 16 * cb + fr;
#pragma unroll
        for (int reg = 0; reg < 4; ++reg) { const int t = 16 * w + 4 * fq + reg; const float p = (s <= t) ? sa[reg] * 0.125f * __builtin_amdgcn_exp2f((float)(t - s) * lg2) : 0.f;
            strip[(4 * fq + reg) * PT128 + s] = (unsigned short)f2bf(p); } }
    LDS_WAIT(); asm volatile("" ::: "memory");
    const int nks = (w >> 1) + 1;
#pragma unroll 1
    for (int ks = 0; ks < nks; ++ks) { const bf16x8 a = ldsfrag(strip, fr, PT128, 32 * ks + 8 * fq);
#pragma unroll
        for (int cb = 0; cb < 8; ++cb) acc[cb] = MFMA16(a, ldsfrag(VT, 16 * cb + fr, PT128, 32 * ks + 8 * fq), acc[cb]); }
    LDS_WAIT(); asm volatile("" ::: "memory");
#pragma unroll
    for (int reg = 0; reg < 4; ++reg) { float sum = 0.f;
#pragma unroll
        for (int cb = 0; cb < 8; ++cb) sum += acc[cb][reg];
        sum += __shfl_xor(sum, 1); sum += __shfl_xor(sum, 2); sum += __shfl_xor(sum, 4); sum += __shfl_xor(sum, 8);
        const float mu = sum * (1.0f / 128.0f); float q = 0.f;
#pragma unroll
        for (int cb = 0; cb < 8; ++cb) { const float d = acc[cb][reg] - mu; q += d * d; }
        q += __shfl_xor(q, 1); q += __shfl_xor(q, 2); q += __shfl_xor(q, 4); q += __shfl_xor(q, 8);
        const float rsd = 1.0f / sqrtf(q * (1.0f / 128.0f) + EPS);
#pragma unroll
        for (int cb = 0; cb < 8; ++cb) strip[(4 * fq + reg) * PT128 + 16 * cb + fr] = (unsigned short)f2bf((acc[cb][reg] - mu) * rsd); }
    LDS_WAIT(); asm volatile("" ::: "memory");
#pragma unroll
    for (int i = 0; i < 4; ++i) { const int c = lane + 64 * i, row = c >> 4, col = (c & 15) * 8; const size_t r = (size_t)(r0 + 16 * w + row);
        const v4u y = *(const LAS v4u*)(strip + row * PT128 + col); const v4u gg = *(const v4u*)(GR + r * 768 + h * 128 + col); float fy[8], fg[8]; unpack8(y, fy); unpack8(gg, fg);
        const f32x4 na = *(const f32x4*)(retn + h * 128 + col), nb2 = *(const f32x4*)(retn + h * 128 + col + 4); const float nn[8] = {na[0], na[1], na[2], na[3], nb2[0], nb2[1], nb2[2], nb2[3]};
#pragma unroll
        for (int j = 0; j < 8; ++j) fy[j] = fy[j] * nn[j] * fg[j];
        *(v4u*)(OR + r * 768 + h * 128 + col) = pack8f(fy); }
    __syncthreads();
}
__device__ __forceinline__ void p_mix2(Frame& F0, const Args& a, int l) {
    Frame F = F0; { GAS unsigned char* wsg_ = (GAS unsigned char*)F.ws; F.tid = F.wave * 64 + lane_id(); asm volatile("" : "+v"(F.tid), "+s"(wsg_), "+s"(F.vcu), "+s"(F.G)); F.lane = F.tid & 63; F.ws = (unsigned char*)wsg_; }
    const float* sgn = (const float*)a.in[10] + (size_t)l * 512; const float* sgw = (const float*)a.in[11] + (size_t)l * 4 * 128 * 128; const float* sgb = (const float*)a.in[12] + (size_t)l * 512;
#pragma unroll 1
    for (int rp = 0, nr = rep_count(PROBE_SGR1); rp < nr; ++rp) {
#pragma unroll 1
    for (int it = F.vcu; it < 512; it += F.G) mix_sg_item(F, sgn, sgw, sgb, it >> 2, it & 3);
#pragma unroll 1
    for (int it = F.vcu; it < 768; it += F.G) mix_r1_item(F, it % 6, it / 6);
    }
#pragma unroll 1
    for (int rp = 0, nr = rep_count(PROBE_IDX); rp < nr; ++rp)
#pragma unroll 1
    for (int pq = F.vcu; pq < 256; pq += F.G) {
#pragma unroll 1
        for (int hh = 0; hh < 2; ++hh) idx::item(F, hh ? 511 - pq : pq); }
}
__device__ __forceinline__ void p_mix3(Frame& F0) {
    Frame F = F0; { GAS unsigned char* wsg_ = (GAS unsigned char*)F.ws; F.tid = F.wave * 64 + lane_id(); asm volatile("" : "+v"(F.tid), "+s"(wsg_), "+s"(F.vcu), "+s"(F.G)); F.lane = F.tid & 63; F.ws = (unsigned char*)wsg_; }
    mix_r2(F);
}
__device__ __forceinline__ void p_mix4(Frame& F0, const Args& a, int l) {
    Frame F = F0; { GAS unsigned char* wsg_ = (GAS unsigned char*)F.ws; F.tid = F.wave * 64 + lane_id(); asm volatile("" : "+v"(F.tid), "+s"(wsg_), "+s"(F.vcu), "+s"(F.G)); F.lane = F.tid & 63; F.ws = (unsigned char*)wsg_; }
    const float* retn = (const float*)a.in[9] + (size_t)l * 768;
#pragma unroll 1
    for (int rp = 0, nr = rep_count(PROBE_R3); rp < nr; ++rp)
#pragma unroll 1
    for (int it = F.vcu; it < 768; it += F.G) mix_r3_item(F, retn, it % 6, it / 6);
}
#ifndef PROBE_GU
#define PROBE_GU 1
#endif
#ifndef PROBE_GU_SKIP
#define PROBE_GU_SKIP 0
#endif
#ifndef PROBE_BARS
#define PROBE_BARS 0
#endif
#ifndef PROBE_RS
#define PROBE_RS 0
#endif
#ifndef WGM_GU
#define WGM_GU 4
#endif
#ifndef WGM_DOWN
#define WGM_DOWN 4
#endif
#ifndef WGM_PROJ
#define WGM_PROJ 8
#endif
#ifndef WGM_OUT
#define WGM_OUT 4
#endif
#ifndef WGM_MERGE
#define WGM_MERGE 4
#endif
#ifndef OUT_SPLIT
#define OUT_SPLIT 1
#endif
#ifndef DOWN_SEAM
#define DOWN_SEAM 0
#endif
#ifndef DOWN_REV
#define DOWN_REV 0
#endif
#ifndef DOWN_SPLIT
#define DOWN_SPLIT 2
#endif
#ifndef FFN_PARTS
#define FFN_PARTS 2
#endif
constexpr int FROWS = MTOK / FFN_PARTS;
#ifndef PROBE_PROJ_SKIP
#define PROBE_PROJ_SKIP 0
#endif
#ifndef PROBE_DOWN_SKIP
#define PROBE_DOWN_SKIP 0
#endif
#ifndef PROBE_DOWN
#define PROBE_DOWN 1
#endif
#ifndef PROBE_PROJ
#define PROBE_PROJ 1
#endif
#ifndef PROBE_MIX2
#define PROBE_MIX2 1
#endif
#ifndef PROBE_MIX4
#define PROBE_MIX4 1
#endif
#ifndef PROBE_MERGE
#define PROBE_MERGE 1
#endif
#ifndef PROBE_CONV
#define PROBE_CONV 1
#endif
#define REP(K) _Pragma("unroll 1") for (int rep_ = 0, nrep_ = rep_count(K); rep_ < nrep_; ++rep_)
#ifndef EN_GU
#define EN_GU 1
#endif
#ifndef EN_DOWN
#define EN_DOWN 1
#endif
#ifndef EN_PROJ
#define EN_PROJ 1
#endif
#ifndef EN_MERGE
#define EN_MERGE 1
#endif
#ifndef EN_OUT
#define EN_OUT 1
#endif

#ifndef PG8_SP2
#define PG8_SP2 true
#endif
#ifndef PG8_ALIGN
#define PG8_ALIGN true
#endif
__global__ void __launch_bounds__(NTHR, 2) mega_fwd(Args args) {
    extern __shared__ __attribute__((aligned(16))) unsigned char lds[];
    Frame F;
    F.lds = (LAS unsigned char*)lds; F.MISC = (volatile LAS unsigned*)(F.lds + MISC_OFF);
    F.tid = threadIdx.x; F.lane = F.tid & 63; F.wave = __builtin_amdgcn_readfirstlane(F.tid >> 6);
    F.G = gridDim.x; { const int bx = blockIdx.x; F.vcu = (F.G % 8 == 0) ? (bx % 8) * (F.G / 8) + bx / 8 : bx; }
    F.ws = args.ws; F.ctl = (gu32*)(args.ws + WS_CTL);
    F.xin = (const float*)args.in[0]; F.pos = (const int*)args.in[1]; F.rel = (const float*)args.in[2]; F.X = args.out;
    for (int u = F.tid; u < (LDS_BYTES - LDSCTL_OFF) / 4; u += NTHR) ((LAS unsigned*)(F.lds + LDSCTL_OFF))[u] = 0u;
    __syncthreads();
    XcdBarrier bar; bar.bar = (unsigned*)(F.ctl + CW_BAR); bar.x = 0; bar.st = nullptr;
    if (!MK_PER_PHASE) bar = xcd_barrier_post((unsigned*)(F.ctl + CW_BAR), F.MISC + 8);
    const int lo = args.ph_lo, hi = args.ph_hi; int ph = 0;
#define IN() (lo <= ph && ph < hi)
#define SEAM() do { if (!MK_PER_PHASE && lo <= ph && ph + 1 < hi) xcd_barrier(bar, F.wave); ++ph; } while (0)
#define SITE_PTRS() GAS unsigned char* wsg_ = (GAS unsigned char*)args.ws; int sG_ = F.G, sB_ = (int)blockIdx.x; asm volatile("" : "+s"(wsg_), "+s"(sG_), "+s"(sB_)); unsigned char* ws = (unsigned char*)wsg_; float* const part = (float*)(ws + WS_PART); const float* const rstd = (const float*)(ws + WS_RSTD); bf16* const XB = (bf16*)(ws + WS_XB); (void)part; (void)rstd; (void)XB

    if (IN()) p_prologue(F);
    SEAM();
#pragma unroll 1
    for (int l = 0; l < DEPTH; ++l) {
        if (IN()) REP(PROBE_CONV) p_convert(F, args, l);
#pragma unroll 1
        for (int s = 0; s < 3; ++s) {
            if (IN()) p_rowstat(F);
            SEAM();
            if (s != 1) {
#pragma unroll 1
                for (int h = 0; h < FFN_PARTS; ++h) {
                    const size_t r0 = (size_t)h * FROWS;
                    if (IN()) { SITE_PTRS(); const bf16* Wgu = (const bf16*)(ws + (s ? WS_WGU2 : WS_WGU1)); pg8::Gemm g{XB + r0 * DM, Wgu, FROWS, 2 * DFF, DM}; pg8::StaticOrder S; S.init(FROWS, 2 * DFF, sG_, sB_, WGM_GU);
#if EN_GU
                        REP(PROBE_GU) { EpiSwiGLU E{(bf16*)(ws + WS_HID), rstd + r0, (PROBE_GU_SKIP && rep_ + 1 < nrep_) ? 1 : 0};
                        if (PROBE_GU_SKIP == 2 && rep_ + 1 < nrep_) g.kmul = 0; else g.kmul = 1;
                        pg8::gemm_phase<EpiSwiGLU, pg8::StaticOrder, PG8_ALIGN, PG8_SP2>(F.lds + RING_OFF, g, S, E, F.wave); }
#endif
                    }
                    SEAM();
#pragma unroll 1
                    for (int dp = 0; dp < DOWN_SPLIT; ++dp) {
                    const int dq = DOWN_REV ? DOWN_SPLIT - 1 - dp : dp;
                    const size_t rd = r0 + (size_t)dq * (FROWS / DOWN_SPLIT), rl = (size_t)dq * (FROWS / DOWN_SPLIT);
                    if (IN()) { SITE_PTRS(); const bf16* Wd = (const bf16*)(ws + (s ? WS_WD2 : WS_WD1)); pg8::Gemm g{(const bf16*)(ws + WS_HID) + rl * DFF, Wd, FROWS / DOWN_SPLIT, DM, DFF}; pg8::StaticOrder S; S.init(FROWS / DOWN_SPLIT, DM, sG_, sB_, WGM_DOWN);
                        const float* base = (l == 0 && s == 0) ? F.xin : (RESID_BF16 ? (const float*)nullptr : (const float*)F.X);
#if EN_DOWN
                        REP(PROBE_DOWN) { EpiResid E{base ? base + rd * DM : base, F.X + rd * DM, XB + rd * DM, part + rd * 32, rep_ + 1 == nrep_ ? 0.5f : 0.0f, (PROBE_DOWN_SKIP && rep_ + 1 < nrep_) ? 1 : 0};
                        pg8::gemm_phase<EpiResid, pg8::StaticOrder, PG8_ALIGN, PG8_SP2, HID_BLK != 0>(F.lds + RING_OFF, g, S, E, F.wave); }
#endif
                    }
                    if (dp + 1 == DOWN_SPLIT) SEAM(); else if (DOWN_SEAM) SEAM();
                    }
                }
            } else {
#pragma unroll 1
                for (int b = 0; b < BATCH; ++b) {
                    const size_t r0 = (size_t)b * HROWS;
                    if (IN()) { SITE_PTRS(); pg8::Gemm g{XB + r0 * DM, (const bf16*)(ws + WS_WIN), HROWS, NPROJ, DM}; pg8::StaticOrder S; S.init(HROWS, NPROJ, sG_, sB_, WGM_PROJ);
                        const float* rc = (const float*)(ws + WS_ROPE) + r0 * 32;
                        EpiProj E{rstd + r0, rc, rc + (size_t)MTOK * 32, (bf16*)(ws + WS_QKR), (bf16*)(ws + WS_VR), (bf16*)(ws + WS_GR), (bf16*)(ws + WS_QA), (bf16*)(ws + WS_KA), (bf16*)(ws + WS_VA),
                                  (bf16*)(ws + WS_US), (bf16*)(ws + WS_VS), (bf16*)(ws + WS_GATE), (unsigned short*)(ws + WS_QI), (unsigned short*)(ws + WS_KI), (float*)(ws + WS_WI)};
#if EN_PROJ
                        REP(PROBE_PROJ) { E.skip = (PROBE_PROJ_SKIP && rep_ + 1 < nrep_) ? 1 : 0;
                        pg8::gemm_phase<EpiProj, pg8::StaticOrder, PG8_ALIGN, PG8_SP2>(F.lds + RING_OFF, g, S, E, F.wave); }
#endif
                    }
                    SEAM();
                    if (IN()) REP(PROBE_MIX2) p_mix2(F, args, l);
                    SEAM();
                    if (IN()) p_mix3(F);
                    SEAM();
                    if (IN()) REP(PROBE_MIX4) { p_mix4(F, args, l); p_attn(F, b); }
                    SEAM();
                    if (IN()) p_attn_combine(F);
                    SEAM();
                    if (IN()) { SITE_PTRS(); pg8::Gemm g{(const bf16*)(ws + WS_OBR), (const bf16*)(ws + WS_WBR), 3 * HROWS, 3 * DM, 768}; MergeOrder S; S.init(sG_, sB_, WGM_MERGE);
                        EpiMerge E{(const bf16*)(ws + WS_GATE), (bf16*)(ws + WS_MRG)};
#if EN_MERGE
                        REP(PROBE_MERGE)
                        pg8::gemm_phase<EpiMerge, MergeOrder, PG8_ALIGN, PG8_SP2>(F.lds + RING_OFF, g, S, E, F.wave);
#endif
                    }
                    SEAM();
#pragma unroll 1
                    for (int op = 0; op < OUT_SPLIT; ++op) {
                    const size_t ro = r0 + (size_t)op * (HROWS / OUT_SPLIT), rl = (size_t)op * (HROWS / OUT_SPLIT);
                    if (IN()) { SITE_PTRS(); pg8::Gemm g{(const bf16*)(ws + WS_MRG) + rl * DM, (const bf16*)(ws + WS_WOUT), HROWS / OUT_SPLIT, DM, DM}; pg8::StaticOrder S; S.init(HROWS / OUT_SPLIT, DM, sG_, sB_, WGM_OUT);
                        EpiResid E{RESID_BF16 ? (const float*)nullptr : (const float*)(F.X + ro * DM), F.X + ro * DM, XB + ro * DM, part + ro * 32, 1.0f};
#if EN_OUT
                        pg8::gemm_phase<EpiResid, pg8::StaticOrder, PG8_ALIGN, PG8_SP2>(F.lds + RING_OFF, g, S, E, F.wave);
#endif
                    }
                    SEAM();
                    }
                }
            }
        }
    }
#if PROBE_BARS
    if (!MK_PER_PHASE) {
#pragma unroll 1
        for (int rp = 0, nr = rep_count(PROBE_BARS); rp < nr; ++rp) xcd_barrier(bar, F.wave); }
#endif
#if PROBE_RS
#pragma unroll 1
    for (int rp = 0, nr = rep_count(PROBE_RS); rp < nr; ++rp) if (lo == 0) { p_rowstat(F); xcd_barrier(bar, F.wave); }
#endif
    if (IN()) p_final(F, (const float*)args.in[21]);
#undef IN
#undef SEAM
}
constexpr int N_PHASES = 1 + DEPTH * (3 + 2 * (1 + (DOWN_SEAM ? DOWN_SPLIT : 1)) * FFN_PARTS + BATCH * (6 + OUT_SPLIT)) + 1;

extern "C" void kernel_launch(void* const* d_in, const int* in_sizes, int n_in, void* d_out, int out_size, void* d_ws, size_t ws_size, hipStream_t stream) {
    static int grid = 0;
    if (grid == 0) {
        if (n_in != 22 || in_sizes[0] != MTOK * DM || out_size != MTOK * DM || ws_size < WS_END) { fprintf(stderr, "kernel_launch: unexpected shapes (n_in %d, in0 %d, out %d, ws %zu)\n", n_in, n_in > 0 ? in_sizes[0] : -1, out_size, ws_size); grid = -1; return; }
        int dev = 0, cus = 0, per_cu = 0;
        if (hipGetDevice(&dev) != hipSuccess || hipDeviceGetAttribute(&cus, hipDeviceAttributeMultiprocessorCount, dev) != hipSuccess) { grid = -1; return; }
        if (hipFuncSetAttribute((const void*)mega_fwd, hipFuncAttributeMaxDynamicSharedMemorySize, LDS_BYTES) != hipSuccess) { fprintf(stderr, "kernel_launch: hipFuncSetAttribute failed\n"); grid = -1; return; }
        if (hipOccupancyMaxActiveBlocksPerMultiprocessor(&per_cu, (const void*)mega_fwd, NTHR, LDS_BYTES) != hipSuccess || per_cu < 1) fprintf(stderr, "kernel_launch: occupancy query says %d\n", per_cu);
        (void)hipGetLastError();
        grid = cus;
    }
    if (grid < 0) return;
    if (hipMemsetAsync((char*)d_ws + WS_CTL, 0, CTL_ZERO_BYTES, stream) != hipSuccess) return;
    Args a{};
    for (int i = 0; i < 22; ++i) a.in[i] = d_in[i];
    a.out = (float*)d_out; a.ws = (unsigned char*)d_ws;
#if MK_PER_PHASE
    for (int p = 0; p < N_PHASES; ++p) { a.ph_lo = p; a.ph_hi = p + 1; hipLaunchKernelGGL(mega_fwd, dim3(grid), dim3(NTHR), LDS_BYTES, stream, a); }
#else
    a.ph_lo = 0; a.ph_hi = N_PHASES; hipLaunchKernelGGL(mega_fwd, dim3(grid), dim3(NTHR), LDS_BYTES, stream, a);
#endif
}
```
